# Optimizing an MI355X kernel written in HIP

```python
import numpy as np
import jax, jax.numpy as jnp
from jax import lax

D_MODEL = 2048
BATCH = 2
SEQ = 8192
DEPTH = 1

NSA_HEADS = 8
NSA_KV_GROUPS = 2
NSA_HG = NSA_HEADS // NSA_KV_GROUPS
NSA_DK = 128
NSA_WIDTH = NSA_HEADS * NSA_DK
KV_W = NSA_KV_GROUPS * NSA_DK
CMP_BLOCK = 32
CMP_STRIDE = 16
SEL_BLOCK = 64
SEL_TOPN = 16
WINDOW = 512
Q_BLOCK = 128
FORCE = 1e4
NEG = -1e30
RET_HEADS = 4
RET_DK = 256
RET_DV = 256
RET_WIDTH = RET_HEADS * RET_DV
RET_CHUNK = 128
ROPE_BASE = 10000.0
GN_EPS = 1e-6
MIX_WIDTH = NSA_WIDTH + RET_WIDTH
T5_BUCKETS = 32
T5_MAX_DIST = 128
D_FF = 4 * D_MODEL
NORM_EPS = 1e-6
IN_SIZES = [NSA_WIDTH, 6 * KV_W, 3 * NSA_HEADS, RET_HEADS * RET_DK, RET_HEADS * RET_DK, RET_WIDTH, RET_WIDTH]
D_IN = sum(IN_SIZES)
IN_OFFSETS = np.cumsum(IN_SIZES)[:-1].tolist()

kernel_name = "hymba_nsa_retention_sandwich_block"


def rms_norm(x, g):
    xf = x.astype(jnp.float32)
    y = xf * lax.rsqrt(jnp.mean(xf * xf, axis=-1, keepdims=True) + NORM_EPS)
    return (y * g.astype(jnp.float32)).astype(x.dtype)


def t5_bucket(rel):
    n = jnp.maximum(rel, 0)
    max_exact = T5_BUCKETS // 2
    nf = jnp.maximum(n, 1).astype(jnp.float32)
    large = max_exact + (jnp.log(nf / max_exact) / np.log(T5_MAX_DIST / max_exact)
                         * (T5_BUCKETS - max_exact)).astype(jnp.int32)
    large = jnp.minimum(large, T5_BUCKETS - 1)
    return jnp.where(n < max_exact, n, large)


def rope(x, pos):
    d = x.shape[-1]
    inv_freq = ROPE_BASE ** (-jnp.arange(0, d, 2, dtype=jnp.float32) / d)
    ang = pos.astype(jnp.float32)[:, None] * inv_freq[None, :]
    cos = jnp.cos(ang)[None, :, None, :]
    sin = jnp.sin(ang)[None, :, None, :]
    xf = x.astype(jnp.float32)
    x1, x2 = xf[..., : d // 2], xf[..., d // 2:]
    return jnp.concatenate([x1 * cos - x2 * sin, x2 * cos + x1 * sin], axis=-1).astype(x.dtype)


def compress_kv(kv, pe, w1, b1, w2):
    B, S, G, dk = kv.shape
    n_cmp = (S - CMP_BLOCK) // CMP_STRIDE + 1
    idx = jnp.arange(n_cmp)[:, None] * CMP_STRIDE + jnp.arange(CMP_BLOCK)[None, :]
    blocks = kv[:, idx] + pe[None, None, :, None, :]
    flat = blocks.transpose(0, 1, 3, 2, 4).reshape(B, n_cmp, G, CMP_BLOCK * dk)
    hid = jax.nn.gelu(flat @ w1 + b1)
    return hid @ w2


def nsa_attention(q, k_cmp, v_cmp, k_slc, v_slc, k_win, v_win, gates, t5_table):
    B, S, H, dk = q.shape
    G, Hg = NSA_KV_GROUPS, NSA_HG
    n_cmp = k_cmp.shape[1]
    n_sel = S // SEL_BLOCK
    top_n = min(SEL_TOPN, n_sel)
    scale = dk ** -0.5
    cmp_end = jnp.arange(n_cmp) * CMP_STRIDE + CMP_BLOCK - 1
    cs = np.arange(n_cmp) * CMP_STRIDE
    ss = np.arange(n_sel) * SEL_BLOCK
    overlap = (cs[:, None] <= ss[None, :] + SEL_BLOCK - 1) & (cs[:, None] + CMP_BLOCK - 1 >= ss[None, :])
    m_sel = jnp.asarray(overlap, jnp.float32)
    tbl = t5_table.astype(jnp.float32).reshape(T5_BUCKETS, G, Hg)
    ks_blocks = k_slc.reshape(B, n_sel, SEL_BLOCK, G, dk).transpose(0, 3, 1, 2, 4)
    vs_blocks = v_slc.reshape(B, n_sel, SEL_BLOCK, G, dk).transpose(0, 3, 1, 2, 4)
    kw_pad = jnp.pad(k_win, ((0, 0), (WINDOW, 0), (0, 0), (0, 0)))
    vw_pad = jnp.pad(v_win, ((0, 0), (WINDOW, 0), (0, 0), (0, 0)))
    qg = q.reshape(B, S, G, Hg, dk)
    gg = gates.reshape(B, S, G, Hg, 3)
    b_idx = jnp.arange(B)[:, None, None, None]
    g_idx = jnp.arange(G)[None, :, None, None]
    g_idx5 = jnp.arange(G)[None, :, None, None, None]
    jblk = jnp.arange(n_sel)

    def block(c):
        s0 = c * Q_BLOCK
        qc = lax.dynamic_slice_in_dim(qg, s0, Q_BLOCK, axis=1)
        tq = s0 + jnp.arange(Q_BLOCK)
        rel = tq[:, None] - cmp_end[None, :]
        s = jnp.einsum('bqghd,bngd->bghqn', qc, k_cmp).astype(jnp.float32) * scale
        s = s + tbl[t5_bucket(rel)].transpose(2, 3, 0, 1)[None]
        valid = rel >= 0
        p = jax.nn.softmax(jnp.where(valid, s, NEG), axis=-1)
        p = jnp.where(valid, p, 0.0)
        o_cmp = jnp.einsum('bghqn,bngd->bqghd', p.astype(v_cmp.dtype), v_cmp)
        imp = jnp.einsum('bghqn,nj->bgqj', p, m_sel)
        cur = tq // SEL_BLOCK
        blk_valid = jblk[None, :] * SEL_BLOCK <= tq[:, None]
        forced = (jblk[None, :] == 0) | (jblk[None, :] == cur[:, None]) | (jblk[None, :] == cur[:, None] - 1)
        imp = jnp.where(blk_valid, jnp.where(forced, FORCE, imp), -1.0)
        top_val, top_idx = lax.top_k(imp, top_n)
        ksel = ks_blocks[b_idx, g_idx, top_idx]
        vsel = vs_blocks[b_idx, g_idx, top_idx]
        kpos = top_idx[..., None] * SEL_BLOCK + jnp.arange(SEL_BLOCK)
        rel = tq[None, None, :, None, None] - kpos
        s = jnp.einsum('bqghd,bgqnld->bghqnl', qc, ksel).astype(jnp.float32) * scale
        s = s + tbl[t5_bucket(rel), g_idx5].transpose(0, 1, 5, 2, 3, 4)
        valid = ((rel >= 0) & (top_val >= 0)[..., None])[:, :, None]
        s = jnp.where(valid, s, NEG).reshape(B, G, Hg, Q_BLOCK, top_n * SEL_BLOCK)
        p = jax.nn.softmax(s, axis=-1).reshape(B, G, Hg, Q_BLOCK, top_n, SEL_BLOCK)
        o_slc = jnp.einsum('bghqnl,bgqnld->bqghd', p.astype(vsel.dtype), vsel)
        kw = lax.dynamic_slice_in_dim(kw_pad, s0, WINDOW + Q_BLOCK, axis=1)
        vw = lax.dynamic_slice_in_dim(vw_pad, s0, WINDOW + Q_BLOCK, axis=1)
        kpos = s0 - WINDOW + jnp.arange(WINDOW + Q_BLOCK)
        rel = tq[:, None] - kpos[None, :]
        valid = (rel >= 0) & (rel < WINDOW) & (kpos[None, :] >= 0)
        s = jnp.einsum('bqghd,bkgd->bghqk', qc, kw).astype(jnp.float32) * scale
        s = s + tbl[t5_bucket(rel)].transpose(2, 3, 0, 1)[None]
        p = jax.nn.softmax(jnp.where(valid, s, NEG), axis=-1)
        o_win = jnp.einsum('bghqk,bkgd->bqghd', p.astype(vw.dtype), vw)
        gc = lax.dynamic_slice_in_dim(gg, s0, Q_BLOCK, axis=1)
        o = gc[..., 0:1] * o_cmp + gc[..., 1:2] * o_slc + gc[..., 2:3] * o_win
        return o.reshape(B, Q_BLOCK, H * dk)

    out = lax.map(block, jnp.arange(S // Q_BLOCK))
    return out.transpose(1, 0, 2, 3).reshape(B, S, H * dk)


def retention(q, k, v, log_gamma):
    B, S, H, dk = q.shape
    dv = v.shape[-1]
    C = RET_CHUNK
    N = S // C
    k = k * (dk ** -0.5)
    qc = q.reshape(B, N, C, H, dk).transpose(1, 0, 3, 2, 4)
    kc = k.reshape(B, N, C, H, dk).transpose(1, 0, 3, 2, 4)
    vc = v.reshape(B, N, C, H, dv).transpose(1, 0, 3, 2, 4)
    idx = jnp.arange(C, dtype=jnp.float32)
    diff = idx[:, None] - idx[None, :]
    decay = jnp.where(diff[None] >= 0, jnp.exp(jnp.maximum(diff, 0.0)[None] * log_gamma[:, None, None]), 0.0)
    xi = jnp.exp((idx + 1.0)[None, :] * log_gamma[:, None])
    zeta = jnp.exp((C - 1.0 - idx)[None, :] * log_gamma[:, None])
    g_c = jnp.exp(C * log_gamma)
    inner = jnp.einsum('nbhcd,nbhmd->nbhcm', qc, kc).astype(jnp.float32) * decay
    inner = jnp.einsum('nbhcm,nbhme->nbhce', inner, vc.astype(jnp.float32))

    def step(R, xs):
        q_n, k_n, v_n = xs
        cross = jnp.einsum('bhcd,bhde->bhce', q_n.astype(jnp.float32), R) * xi[None, :, :, None]
        R = R * g_c[None, :, None, None] + jnp.einsum(
            'bhcd,bhce->bhde', k_n.astype(jnp.float32) * zeta[None, :, :, None], v_n.astype(jnp.float32))
        return R, cross

    R0 = jnp.zeros((B, H, dk, dv), jnp.float32)
    _, cross = lax.scan(step, R0, (qc, kc, vc))
    o = (inner + cross).transpose(1, 0, 3, 2, 4).reshape(B, S, H, dv)
    mu = jnp.mean(o, axis=-1, keepdims=True)
    var = jnp.mean(jnp.square(o - mu), axis=-1, keepdims=True)
    return (o - mu) * lax.rsqrt(var + GN_EPS)


def setup_inputs(seed: int = 0) -> dict:
    key = jax.random.key(seed)
    ks = jax.random.split(key, 20)
    f32 = jnp.float32

    def nrm(k, shape, scale):
        return jax.random.normal(k, shape, f32) * scale

    def gain(k):
        return 1.0 + nrm(k, (DEPTH, D_MODEL), 0.05)

    LDK = CMP_BLOCK * NSA_DK
    return {
        "x": nrm(ks[0], (BATCH, SEQ, D_MODEL), 1.0),
        "norm_mix_pre": gain(ks[1]),
        "w_in": nrm(ks[2], (DEPTH, D_MODEL, D_IN), D_MODEL ** -0.5),
        "cmp_pe_k": nrm(ks[3], (DEPTH, CMP_BLOCK, NSA_DK), 0.1),
        "cmp_w1_k": nrm(ks[4], (DEPTH, LDK, NSA_DK), LDK ** -0.5),
        "cmp_b1_k": nrm(ks[5], (DEPTH, NSA_DK), 0.02),
        "cmp_w2_k": nrm(ks[6], (DEPTH, NSA_DK, NSA_DK), NSA_DK ** -0.5),
        "cmp_pe_v": nrm(ks[7], (DEPTH, CMP_BLOCK, NSA_DK), 0.1),
        "cmp_w1_v": nrm(ks[8], (DEPTH, LDK, NSA_DK), LDK ** -0.5),
        "cmp_b1_v": nrm(ks[9], (DEPTH, NSA_DK), 0.02),
        "cmp_w2_v": nrm(ks[10], (DEPTH, NSA_DK, NSA_DK), NSA_DK ** -0.5),
        "t5_bias": nrm(ks[11], (T5_BUCKETS, NSA_HEADS), 0.2),
        "w_out": nrm(ks[12], (DEPTH, MIX_WIDTH, D_MODEL), MIX_WIDTH ** -0.5),
        "norm_mix_post": gain(ks[13]),
        "norm_mlp_pre": gain(ks[14]),
        "w_up": nrm(ks[15], (DEPTH, D_MODEL, D_FF), D_MODEL ** -0.5),
        "w_down": nrm(ks[16], (DEPTH, D_FF, D_MODEL), D_FF ** -0.5),
        "norm_mlp_post": gain(ks[17]),
    }


def reference(x, norm_mix_pre, w_in, cmp_pe_k, cmp_w1_k, cmp_b1_k, cmp_w2_k, cmp_pe_v, cmp_w1_v,
              cmp_b1_v, cmp_w2_v, t5_bias, w_out, norm_mix_post, norm_mlp_pre, w_up, w_down,
              norm_mlp_post):
    B, S, _ = x.shape
    pos = jnp.arange(S)
    log_gamma = jnp.log(1.0 - jnp.exp2(-5.0 - jnp.arange(RET_HEADS, dtype=jnp.float32)))
    for l in range(DEPTH):
        h = rms_norm(x, norm_mix_pre[l])
        proj = h @ w_in[l]
        q_a, kv_a, gate_a, q_r, k_r, v_r, g_r = jnp.split(proj, IN_OFFSETS, axis=-1)
        q_a = q_a.reshape(B, S, NSA_HEADS, NSA_DK)
        kv6 = kv_a.reshape(B, S, 6, NSA_KV_GROUPS, NSA_DK)
        k_cmp = compress_kv(kv6[:, :, 0], cmp_pe_k[l], cmp_w1_k[l], cmp_b1_k[l], cmp_w2_k[l])
        v_cmp = compress_kv(kv6[:, :, 1], cmp_pe_v[l], cmp_w1_v[l], cmp_b1_v[l], cmp_w2_v[l])
        gates = jax.nn.sigmoid(gate_a.reshape(B, S, NSA_HEADS, 3))
        o_a = nsa_attention(q_a, k_cmp, v_cmp, kv6[:, :, 2], kv6[:, :, 3], kv6[:, :, 4], kv6[:, :, 5],
                            gates, t5_bias)
        q_r = rope(q_r.reshape(B, S, RET_HEADS, RET_DK), pos)
        k_r = rope(k_r.reshape(B, S, RET_HEADS, RET_DK), pos)
        o_r = retention(q_r, k_r, v_r.reshape(B, S, RET_HEADS, RET_DV), log_gamma)
        o_r = (jax.nn.silu(g_r.astype(jnp.float32)) * o_r.reshape(B, S, RET_WIDTH)).astype(x.dtype)
        mix = jnp.concatenate([o_a.astype(x.dtype), o_r], axis=-1) @ w_out[l]
        x = x + rms_norm(mix, norm_mix_post[l])
        h = rms_norm(x, norm_mlp_pre[l])
        u = jnp.square(jax.nn.relu(h @ w_up[l]))
        x = x + rms_norm(u @ w_down[l], norm_mlp_post[l])
    return x
```

```cpp
#include <hip/hip_runtime.h>
#include <hip/hip_cooperative_groups.h>
#include <cstdio>
#include <cmath>
namespace pg8 {
#define PG8_LAS __attribute__((address_space(3)))
typedef unsigned short bf16_t;
typedef short bf16x8 __attribute__((ext_vector_type(8)));
typedef float f32x4 __attribute__((ext_vector_type(4)));
typedef unsigned u32x4 __attribute__((ext_vector_type(4)));
constexpr int BM = 256, BK = 64, HALF = 128, HTB = HALF * BK * 2  , STAGE_BYTES = 8 * HTB, NXCD = 8, WGM = 8;

__host__ __device__ __forceinline__ int lds_byte(int r, int c) { const int st = (r >> 4) * 2 + (c >> 5), rr = r & 15, cc = c & 31, ob = rr * 64 + cc * 2; return st * 1024 + (ob ^ (((ob >> 9) & 1) << 5)); }
__host__ __device__ __forceinline__ void stage_rc(int b, int& R, int& C) { const int st = b / 1024, sb = b % 1024, swz = sb ^ (((sb >> 9) & 1) << 5); R = (st >> 1) * 16 + swz / 64; C = (st & 1) * 32 + (swz % 64) / 2; }
__host__ __device__ __forceinline__ int perm32(int rho) { const int n = rho >> 4, i = rho & 15; return 8 * (i >> 2) + 4 * n + (i & 3); }

struct Unit { int pm, pn; };
struct Gemm { const bf16_t* A; const bf16_t* Bt; int M, N, K; };

struct StaticOrder {
    int nM, nN, nwg, G, c, wgm;
    __host__ __device__ void init(int M, int N, int G_, int c_, int wgm_ = WGM) { nM = M / BM; nN = N / BM; nwg = nM * nN; G = G_; c = c_; wgm = wgm_; }
    __host__ __device__ bool next(int i, Unit& u) const {
        const long L = (long)i * G + c; if (L >= nwg) return false;
        int wgid = (int)L; { const int q = nwg / NXCD, r = nwg % NXCD, xcd = wgid % NXCD, off = wgid / NXCD; wgid = (xcd < r ? xcd * (q + 1) : r * (q + 1) + (xcd - r) * q) + off; }
        const int nig = wgm * nN, gid = wgid / nig, fm = gid * wgm, gsz = (nM - fm) < wgm ? (nM - fm) : wgm;
        u.pm = fm + ((wgid % nig) % gsz); u.pn = (wgid % nig) / gsz; return true;
    }
    __device__ __forceinline__ void a_ready(const Unit&) const {}
    __device__ __forceinline__ void done(const Unit&) const {}
};
typedef float f32x2 __attribute__((ext_vector_type(2)));
typedef __bf16 bf16x2_nat __attribute__((ext_vector_type(2)));
__device__ __forceinline__ unsigned cvt_pk_bf16(float lo, float hi) { const f32x2 v = {lo, hi}; return __builtin_bit_cast(unsigned, __builtin_convertvector(v, bf16x2_nat)); }
struct EpiF32 {
    static constexpr bool PERM = false, AFTER_DRAIN = false;
    float* C; int ldc; const float* bias;
    __device__ __forceinline__ void operator()(const f32x4 (&acc)[2][2][4][2], const Unit& u, int wr, int wc, int fr, int fq) const {
        const int row0 = u.pm * BM + wr * 64 + fr, col0 = u.pn * BM + wc * 32 + 4 * fq;
        f32x4 bv[2][2];
#pragma unroll
        for (int bj = 0; bj < 2; ++bj)
#pragma unroll
            for (int n = 0; n < 2; ++n) bv[bj][n] = bias ? *(const f32x4*)(bias + col0 + bj * HALF + n * 16) : (f32x4){0.f, 0.f, 0.f, 0.f};
#pragma unroll
        for (int ai = 0; ai < 2; ++ai)
#pragma unroll
            for (int m = 0; m < 4; ++m) { float* rowp = C + (size_t)(row0 + ai * HALF + m * 16) * ldc + col0;
#pragma unroll
                for (int bj = 0; bj < 2; ++bj)
#pragma unroll
                    for (int n = 0; n < 2; ++n) *(f32x4*)(rowp + bj * HALF + n * 16) = acc[ai][bj][m][n] + bv[bj][n]; }
    }
};
template <class Epi, class Sched, bool ALIGN_EPI = false, bool SP2 = false>
__device__ __forceinline__ void gemm_phase(PG8_LAS unsigned char* lds, const Gemm g, const Sched& S, const Epi& E) {
    int tid_o = threadIdx.x; asm volatile("" : "+v"(tid_o));
    const int tid = tid_o, wid = __builtin_amdgcn_readfirstlane(tid >> 6), lane = tid & 63, wr = wid >> 2, wc = wid & 3, fr = lane & 15, fq = lane >> 4;
    const int K = g.K, nt = K / BK;
    unsigned voffA[2], voffB[2];
#pragma unroll
    for (int i = 0; i < 2; ++i) { int R, C; stage_rc(tid * 16 + i * 8192, R, C); const int Rb = Epi::PERM ? ((R & ~31) + perm32(R & 31)) : R;
        voffA[i] = (unsigned)(R * K + C) * 2u; voffB[i] = (unsigned)(Rb * K + C) * 2u; }
    const size_t kstep = (size_t)(BK * 2);
    const size_t hstep = (size_t)HALF * K * 2;
    const size_t tstep = 2 * hstep;
    const unsigned ldsw = (unsigned)wid * 1024u;
    const int aoff = lds_byte(wr * 64 + fr, fq * 8), boff = lds_byte(wc * 32 + fr, fq * 8);
#define PG8_SA(b, h) (((b) * 2 + (h)) * HTB)
#define PG8_SB(b, h) ((4 + (b) * 2 + (h)) * HTB)
#define PG8_STAGE(bufoff, gbase, voff) do { _Pragma("unroll") for (int _i = 0; _i < 2; ++_i) \
        __builtin_amdgcn_global_load_lds((const unsigned*)((const char*)(gbase) + (voff)[_i]), (PG8_LAS unsigned*)(lds + (bufoff) + ldsw + _i * 8192), 16, 0, 0); } while (0)
#define PG8_LDA(dst, b, h) do { _Pragma("unroll") for (int m = 0; m < 4; ++m) _Pragma("unroll") for (int k = 0; k < 2; ++k) dst[m][k] = *(const PG8_LAS bf16x8*)(lds + PG8_SA(b, h) + aoff + m * 2048 + k * 1024); } while (0)
#define PG8_LDB(dst, b, h) do { _Pragma("unroll") for (int n = 0; n < 2; ++n) _Pragma("unroll") for (int k = 0; k < 2; ++k) dst[n][k] = *(const PG8_LAS bf16x8*)(lds + PG8_SB(b, h) + boff + n * 2048 + k * 1024); } while (0)
#define PG8_MMA(ai, bj, At, Bt) do { __builtin_amdgcn_s_setprio(1); _Pragma("unroll") for (int m = 0; m < 4; ++m) _Pragma("unroll") for (int n = 0; n < 2; ++n) _Pragma("unroll") for (int k = 0; k < 2; ++k) \
        acc[ai][bj][m][n] = __builtin_amdgcn_mfma_f32_16x16x32_bf16(Bt[n][k], At[m][k], acc[ai][bj][m][n], 0, 0, 0); __builtin_amdgcn_s_setprio(0); } while (0)
#define PG8_WAIT_V(n) asm volatile("s_waitcnt vmcnt(" #n ")" ::: "memory")
#define PG8_WAIT_L(n) asm volatile("s_waitcnt lgkmcnt(" #n ")" ::: "memory")
#define PG8_BAR __builtin_amdgcn_s_barrier()
#define PG8_SCHED __builtin_amdgcn_sched_barrier(0)
    Unit cur, nxt; int ui = 0;
    if (!S.next(0, cur)) return;
    f32x4 acc[2][2][4][2];
#pragma unroll
    for (int a = 0; a < 2; ++a)
#pragma unroll
        for (int b = 0; b < 2; ++b)
#pragma unroll
            for (int m = 0; m < 4; ++m)
#pragma unroll
                for (int n = 0; n < 2; ++n) acc[a][b][m][n] = (f32x4){0.f, 0.f, 0.f, 0.f};
    bf16x8 At[4][2], B0[2][2], B1[2][2];
    const char* cA = (const char*)g.A + (size_t)cur.pm * tstep; const char* cB = (const char*)g.Bt + (size_t)cur.pn * tstep;
    S.a_ready(cur);
    if constexpr (SP2) {
        PG8_STAGE(PG8_SB(0, 0), cB, voffB); PG8_STAGE(PG8_SB(0, 1), cB + hstep, voffB); PG8_STAGE(PG8_SA(0, 0), cA, voffA); PG8_STAGE(PG8_SA(0, 1), cA + hstep, voffA);
        if (wr == 1) PG8_BAR;
        PG8_WAIT_V(2); PG8_BAR;
        PG8_STAGE(PG8_SB(1, 0), cB + kstep, voffB); PG8_STAGE(PG8_SA(1, 0), cA + kstep, voffA); PG8_STAGE(PG8_SB(1, 1), cB + hstep + kstep, voffB);
        PG8_WAIT_V(6); PG8_BAR;
    } else {
        PG8_STAGE(PG8_SB(0, 0), cB, voffB); PG8_STAGE(PG8_SA(0, 0), cA, voffA); PG8_STAGE(PG8_SB(0, 1), cB + hstep, voffB); PG8_STAGE(PG8_SA(0, 1), cA + hstep, voffA);
        if (wr == 1) PG8_BAR;
        PG8_WAIT_V(4); PG8_BAR;
        PG8_STAGE(PG8_SB(1, 0), cB + kstep, voffB); PG8_STAGE(PG8_SA(1, 0), cA + kstep, voffA); PG8_STAGE(PG8_SB(1, 1), cB + hstep + kstep, voffB);
        PG8_WAIT_V(6); PG8_BAR;
    }
    for (;;) {
        const bool has_next = S.next(ui + 1, nxt);
        const char* nA = has_next ? (const char*)g.A + (size_t)nxt.pm * tstep : cA; const char* nB = has_next ? (const char*)g.Bt + (size_t)nxt.pn * tstep : cB;
        for (int t = 0; t < nt; t += 2) {
            const bool last = (t == nt - 2);
            const char* a1 = cA + (size_t)(t + 1) * kstep;
            const char* a2 = last ? nA : cA + (size_t)(t + 2) * kstep; const char* b2 = last ? nB : cB + (size_t)(t + 2) * kstep;
            const char* a3 = a2 + kstep; const char* b3 = b2 + kstep;
            if (last && has_next) S.a_ready(nxt);
            if constexpr (SP2) {
            PG8_LDB(B0, 0, 0); PG8_LDB(B1, 0, 1); PG8_SCHED; PG8_LDA(At, 0, 0); PG8_STAGE(PG8_SA(1, 1), a1 + hstep, voffA);
            PG8_WAIT_V(8); PG8_WAIT_L(0); PG8_BAR; PG8_MMA(0, 0, At, B0); PG8_MMA(0, 1, At, B1); PG8_BAR; PG8_SCHED;
            PG8_LDA(At, 0, 1); PG8_STAGE(PG8_SB(0, 0), b2, voffB); PG8_STAGE(PG8_SB(0, 1), b2 + hstep, voffB); PG8_STAGE(PG8_SA(0, 0), a2, voffA);
            PG8_WAIT_V(8); PG8_WAIT_L(0); PG8_BAR; PG8_MMA(1, 0, At, B0); PG8_MMA(1, 1, At, B1); PG8_BAR; PG8_SCHED;
            PG8_LDB(B0, 1, 0); PG8_LDB(B1, 1, 1); PG8_SCHED; PG8_LDA(At, 1, 0); PG8_STAGE(PG8_SA(0, 1), a2 + hstep, voffA);
            PG8_WAIT_V(8); PG8_WAIT_L(0); PG8_BAR; PG8_MMA(0, 0, At, B0); PG8_MMA(0, 1, At, B1); PG8_BAR; PG8_SCHED;
            PG8_LDA(At, 1, 1); PG8_STAGE(PG8_SB(1, 0), b3, voffB); PG8_STAGE(PG8_SB(1, 1), b3 + hstep, voffB); PG8_STAGE(PG8_SA(1, 0), a3, voffA);
            PG8_WAIT_V(8); PG8_WAIT_L(0); PG8_BAR; PG8_MMA(1, 0, At, B0); PG8_MMA(1, 1, At, B1); PG8_BAR; PG8_SCHED;
            } else {
            PG8_LDB(B0, 0, 0); PG8_SCHED; PG8_LDA(At, 0, 0); PG8_STAGE(PG8_SA(1, 1), a1 + hstep, voffA);
            PG8_WAIT_L(8); PG8_BAR; PG8_WAIT_L(0); PG8_MMA(0, 0, At, B0); PG8_BAR; PG8_SCHED;
            PG8_LDB(B1, 0, 1); PG8_STAGE(PG8_SB(0, 0), b2, voffB);
            PG8_BAR; PG8_WAIT_L(0); PG8_MMA(0, 1, At, B1); PG8_BAR;
            PG8_LDA(At, 0, 1); PG8_STAGE(PG8_SA(0, 0), a2, voffA);
            PG8_BAR; PG8_WAIT_L(0); PG8_MMA(1, 0, At, B0); PG8_BAR; PG8_SCHED;
            PG8_STAGE(PG8_SB(0, 1), b2 + hstep, voffB);
            PG8_WAIT_V(6); PG8_BAR; PG8_MMA(1, 1, At, B1); PG8_BAR;
            PG8_LDB(B0, 1, 0); PG8_SCHED; PG8_LDA(At, 1, 0); PG8_STAGE(PG8_SA(0, 1), a2 + hstep, voffA);
            PG8_WAIT_L(8); PG8_BAR; PG8_WAIT_L(0); PG8_MMA(0, 0, At, B0); PG8_BAR; PG8_SCHED;
            PG8_LDB(B1, 1, 1); PG8_STAGE(PG8_SB(1, 0), b3, voffB);
            PG8_BAR; PG8_WAIT_L(0); PG8_MMA(0, 1, At, B1); PG8_BAR;
            PG8_LDA(At, 1, 1); PG8_STAGE(PG8_SA(1, 0), a3, voffA);
            PG8_BAR; PG8_WAIT_L(0); PG8_MMA(1, 0, At, B0); PG8_BAR; PG8_SCHED;
            PG8_STAGE(PG8_SB(1, 1), b3 + hstep, voffB);
            PG8_WAIT_V(6); PG8_BAR; PG8_MMA(1, 1, At, B1); PG8_BAR;
            }
        }
        if constexpr (ALIGN_EPI) { if (wr == 0) PG8_BAR; }
        if constexpr (!Epi::AFTER_DRAIN) { E(acc, cur, wr, wc, fr, fq); S.done(cur); }
        if (!has_next) break;
#pragma unroll
        for (int a = 0; a < 2; ++a)
#pragma unroll
            for (int b = 0; b < 2; ++b)
#pragma unroll
                for (int m = 0; m < 4; ++m)
#pragma unroll
                    for (int n = 0; n < 2; ++n) acc[a][b][m][n] = (f32x4){0.f, 0.f, 0.f, 0.f};
        cur = nxt; cA = nA; cB = nB; ++ui;
        if constexpr (ALIGN_EPI) { if (wr == 1) PG8_BAR; }
    }
    PG8_WAIT_V(0);
    if constexpr (!ALIGN_EPI) { if (wr == 0) PG8_BAR; }
    PG8_BAR;
    if constexpr (Epi::AFTER_DRAIN) { E.fused(acc, cur, wr, wc, fr, fq, lds, wid, lane); S.done(cur); }
#undef PG8_SA
#undef PG8_SB
#undef PG8_STAGE
#undef PG8_LDA
#undef PG8_LDB
#undef PG8_MMA
#undef PG8_WAIT_V
#undef PG8_WAIT_L
#undef PG8_BAR
#undef PG8_SCHED
}
}
constexpr int T_DN_TAIL = 2696;

namespace mk {
namespace cg = cooperative_groups;
using pg8::bf16_t; using pg8::bf16x8; using pg8::f32x4; using pg8::u32x4; using pg8::cvt_pk_bf16;
#define LAS __attribute__((address_space(3)))
constexpr int BATCH = 2, SEQ = 8192, DM = 2048, MTOK = BATCH * SEQ, DFF = 8192;
constexpr int DIN = 6680, NIN = 6912;
constexpr int C_GATE = 2560, C_QR = 2584;
constexpr int NCMP = 511, NCMPP = 512;
constexpr float NORM_EPS = 1e-6f, GN_EPS = 1e-6f, NEGV = -1e30f;
constexpr size_t MiB = 1u << 20;
constexpr size_t WS_BAR = 16384;
constexpr size_t WS_RSTD0 = 256 * 1024;
constexpr size_t WS_RSTD2 = 384 * 1024;
constexpr size_t XB_OFF = 64 * MiB;
constexpr size_t WS_CB = 1 * MiB - 8192;
constexpr size_t WS_CW2T = 1 * MiB + 4096;
constexpr size_t WS_CW1T = 2 * MiB;
constexpr size_t WS_KC = 4 * MiB;
constexpr size_t WS_VCT = 5 * MiB;
constexpr size_t WS_GATES = 6 * MiB;
constexpr size_t WS_ROPE = 8 * MiB;
constexpr size_t WS_WDNT = 16 * MiB;
constexpr size_t WS_WINT = 48 * MiB;
constexpr size_t WS_WOUTT = 76 * MiB;
constexpr size_t WS_WUPT = 84 * MiB;
constexpr size_t WS_H = 116 * MiB;
constexpr size_t WS_QA = 180 * MiB;
constexpr size_t WS_KV6 = 212 * MiB;
constexpr size_t WS_QR = 260 * MiB;
constexpr size_t WS_KR = 292 * MiB;
constexpr size_t WS_VR = 324 * MiB;
constexpr size_t WS_GR = 356 * MiB;
constexpr size_t WS_MIX = 180 * MiB;
constexpr size_t WS_UM = 180 * MiB;
constexpr size_t WS_Y = 48 * MiB;
constexpr size_t WS_RT = 436 * MiB;
constexpr size_t WS_X1 = 436 * MiB;
constexpr size_t WS_NEED = 500 * MiB;
#ifndef GEMM_SP2
#define GEMM_SP2 true
#endif
#ifndef GEMM_ALIGN
#define GEMM_ALIGN true
#endif
#ifndef WGM_IN
#define WGM_IN 4
#endif
#ifndef WGM_OUT
#define WGM_OUT 4
#endif
#ifndef WGM_UP
#define WGM_UP 4
#endif
#ifndef WGM_DN
#define WGM_DN 4
#endif
constexpr int LDS_BYTES = 147456;

struct Params { const float* in[18]; float* out; unsigned char* ws; int ph_lo, ph_hi; float lg[4]; double invf[128]; };

__device__ __forceinline__ float bf2f(unsigned v) { return __uint_as_float(v << 16); }
typedef unsigned u32x2_t __attribute__((ext_vector_type(2)));
__device__ __forceinline__ u32x4 ldnt16(const void* p) { return __builtin_nontemporal_load((const u32x4*)p); }
__device__ __forceinline__ uint2 ldnt8(const void* p) { const u32x2_t t = __builtin_nontemporal_load((const u32x2_t*)p); return make_uint2(t[0], t[1]); }
__device__ __forceinline__ float wave_sum(float v) {
#pragma unroll
    for (int o = 1; o < 64; o <<= 1) v += __shfl_xor(v, o);
    return v;
}
__device__ __forceinline__ float wave_max(float v) {
#pragma unroll
    for (int o = 1; o < 64; o <<= 1) v = fmaxf(v, __shfl_xor(v, o));
    return v;
}
#define LDS_WAIT() asm volatile("s_waitcnt lgkmcnt(0)" ::: "memory")
__device__ __forceinline__ int opaque_tid() { int x = threadIdx.x; asm volatile("" : "+v"(x)); return x; }

__device__ __forceinline__ int win_src(int n) { return n < 2560 ? n : (n < 6656 ? n + 24 : (n < 6680 ? n - 4096 : -1)); }
template <bool WIN, bool GAIN = false, bool FAR = false>
__device__ __forceinline__ void transpose_pair(const float* W, int ld, int K, int Nout, bf16_t* WT, LAS float* scr, int q, int lane, const float* G = nullptr) {
    const int nblk = Nout / 32, item = 2 * q, kb = item / nblk, nb = item % nblk, k0 = 64 * kb, n0 = 32 * nb;
    const int np0 = n0 + (lane & 31), np1 = np0 + 32, src0 = WIN ? win_src(np0) : np0, src1 = WIN ? win_src(np1) : np1;
    float va[32], vb[32];
#pragma unroll
    for (int i = 0; i < 32; ++i) { const int kk = 2 * i + (lane >> 5); const float* rowp = W + (size_t)(k0 + kk) * ld;
        va[i] = src0 >= 0 ? __builtin_nontemporal_load(rowp + src0) : 0.f; vb[i] = src1 >= 0 ? __builtin_nontemporal_load(rowp + src1) : 0.f;
        if (GAIN) { const float gk = G[k0 + kk]; va[i] *= gk; vb[i] *= gk; } }
    const int c = lane & 7;
#pragma unroll
    for (int half = 0; half < 2; ++half) {
#pragma unroll
        for (int i = 0; i < 32; ++i) { const int kk = 2 * i + (lane >> 5); scr[kk * 33 + (lane & 31)] = half ? vb[i] : va[i]; }
        LDS_WAIT();
#pragma unroll
        for (int j = 0; j < 4; ++j) { const int n = (lane >> 3) + 8 * j; const LAS float* sp = scr + (8 * c) * 33 + n;
            u32x4 o; o.x = cvt_pk_bf16(sp[0 * 33], sp[1 * 33]); o.y = cvt_pk_bf16(sp[2 * 33], sp[3 * 33]); o.z = cvt_pk_bf16(sp[4 * 33], sp[5 * 33]); o.w = cvt_pk_bf16(sp[6 * 33], sp[7 * 33]);
            if (FAR) __builtin_nontemporal_store(o, (u32x4*)(WT + (size_t)(n0 + 32 * half + n) * K + k0 + 8 * c)); else *(u32x4*)(WT + (size_t)(n0 + 32 * half + n) * K + k0 + 8 * c) = o; }
        LDS_WAIT();
    }
}
__device__ __forceinline__ void sincos_d(double r, double& s, double& c) {
    const double r2 = r * r;
    double ts = 1.0, tc = 1.0, term_s = 1.0, term_c = 1.0;
#pragma unroll
    for (int k = 1; k <= 13; ++k) {
        constexpr double one = 1.0;
        const double ic = -one / (double)((2 * k - 1) * (2 * k)), is = -one / (double)((2 * k) * (2 * k + 1));
        term_c *= r2 * ic; tc += term_c;
        term_s *= r2 * is; ts += term_s;
    }
    s = r * ts; c = tc;
}
__device__ __forceinline__ void p0_prologue(const Params& p, LAS unsigned char* lds, int wave_, int lane_, int gw_, int NGW) {
    const int tid = opaque_tid(), lane = tid & 63, wave = __builtin_amdgcn_readfirstlane(tid >> 6), gw = blockIdx.x * 8 + wave; (void)wave_; (void)lane_; (void)gw_;
    unsigned char* ws = p.ws;
    LAS float* scr = (LAS float*)(lds + wave * 16384);
    constexpr int T_IN = (DM / 64) * (NIN / 32) / 2, T_OUT = (DM / 64) * (DM / 32) / 2, T_UP = (DM / 64) * (DFF / 32) / 2, T_DN = (DFF / 64) * (DM / 32) / 2, T_C1 = (4096 / 64) * (128 / 32) / 2, T_C2 = (128 / 64) * (128 / 32) / 2;
    constexpr int T_DN0 = T_DN - T_DN_TAIL;
    constexpr int NT = T_IN + T_OUT + T_UP + T_DN0 + 2 * T_C1 + 2 * T_C2;
    for (int it = gw; it < NT; it += NGW) {
        int r = it;
        if (r < T_IN) { transpose_pair<true, true>(p.in[2], DIN, DM, NIN, (bf16_t*)(ws + WS_WINT), scr, r, lane, p.in[1]); continue; } r -= T_IN;
        if (r < T_OUT) { transpose_pair<false, false, true>(p.in[12], DM, DM, DM, (bf16_t*)(ws + WS_WOUTT), scr, r, lane); continue; } r -= T_OUT;
        if (r < T_UP) { transpose_pair<false, true, true>(p.in[15], DFF, DM, DFF, (bf16_t*)(ws + WS_WUPT), scr, r, lane, p.in[14]); continue; } r -= T_UP;
        if (r < T_DN0) { transpose_pair<false, false, true>(p.in[16], DM, DFF, DM, (bf16_t*)(ws + WS_WDNT), scr, r, lane); continue; } r -= T_DN0;
        if (r < T_C1) { transpose_pair<false>(p.in[4], 128, 4096, 128, (bf16_t*)(ws + WS_CW1T), scr, r, lane); continue; } r -= T_C1;
        if (r < T_C1) { transpose_pair<false>(p.in[8], 128, 4096, 128, (bf16_t*)(ws + WS_CW1T) + 128 * 4096, scr, r, lane); continue; } r -= T_C1;
        if (r < T_C2) { transpose_pair<false>(p.in[6], 128, 128, 128, (bf16_t*)(ws + WS_CW2T), scr, r, lane); continue; } r -= T_C2;
        transpose_pair<false>(p.in[10], 128, 128, 128, (bf16_t*)(ws + WS_CW2T) + 128 * 128, scr, r, lane);
    }
    const float* x = p.in[0]; bf16_t* XB = (bf16_t*)((unsigned char*)p.out + XB_OFF); float* RS0 = (float*)(ws + WS_RSTD0);
    {
        for (int row0 = gw; row0 < MTOK; row0 += 4 * NGW) {
            float4 v[4][8];
#pragma unroll
            for (int r = 0; r < 4; ++r) { const int row = row0 + r * NGW;
                if (row < MTOK) {
#pragma unroll
                    for (int j = 0; j < 8; ++j) { const f32x4 t_ = __builtin_nontemporal_load((const f32x4*)(x + (size_t)row * DM) + lane + 64 * j); v[r][j] = make_float4(t_[0], t_[1], t_[2], t_[3]); }
                } }
#pragma unroll
            for (int r = 0; r < 4; ++r) { const int row = row0 + r * NGW;
                if (row < MTOK) {
                    float s = 0.f;
#pragma unroll
                    for (int j = 0; j < 8; ++j) s += v[r][j].x * v[r][j].x + v[r][j].y * v[r][j].y + v[r][j].z * v[r][j].z + v[r][j].w * v[r][j].w;
                    const float rstd = rsqrtf(wave_sum(s) * (1.0f / DM) + NORM_EPS);
                    if (lane == 0) RS0[row] = 1.0f / rstd;
                    uint2* o = (uint2*)(XB + (size_t)row * DM) + lane;
#pragma unroll
                    for (int j = 0; j < 8; ++j) { uint2 w; w.x = cvt_pk_bf16(v[r][j].x * rstd, v[r][j].y * rstd); w.y = cvt_pk_bf16(v[r][j].z * rstd, v[r][j].w * rstd); o[64 * j] = w; }
                } }
        }
    }
    float2* tab = (float2*)(ws + WS_ROPE);
    for (int idx = gw * 64 + lane; idx < SEQ * 128; idx += NGW * 64) {
        const int pos = idx >> 7, i = idx & 127;
        const float angf = (float)pos * (float)p.invf[i];
        const double ang = (double)angf, twopi = 6.283185307179586476925286766559;
        const double k = rint(ang * 0.15915494309189533576888376337251), r = ang - k * twopi;
        double s, c; sincos_d(r, s, c);
        tab[idx] = make_float2((float)c, (float)s);
    }
    float* CB = (float*)(ws + WS_CB);
    for (int o = gw; o < 8 * 256; o += NGW) {
        const int sl = o >> 8, oc = o & 255, kind = oc >> 7, c = oc & 127;
        const float* pe = kind ? p.in[7] : p.in[3]; const float* w1 = kind ? p.in[8] : p.in[4]; const float* b1 = kind ? p.in[9] : p.in[5];
        float s = 0.f;
#pragma unroll
        for (int i = 0; i < 8; ++i) { const int k = 512 * sl + 64 * i + lane; s += pe[k] * w1[(size_t)k * 128 + c]; }
        s = wave_sum(s);
        if (lane == 0) CB[o] = s + (sl == 0 ? b1[c] : 0.f);
    }
}

__device__ __forceinline__ void p1_tail_weights(const Params& p, LAS unsigned char* lds, int tw, int ntw) {
    const int tid = opaque_tid(), lane = tid & 63, wave = __builtin_amdgcn_readfirstlane(tid >> 6);
    LAS float* scr = (LAS float*)(lds + wave * 16384);
    constexpr int T_DN = (DFF / 64) * (DM / 32) / 2;
    for (int it = T_DN - T_DN_TAIL + tw; it < T_DN; it += ntw) transpose_pair<false, false, true>(p.in[16], DM, DFF, DM, (bf16_t*)(p.ws + WS_WDNT), scr, it, lane);
}

struct EpiInProj {
    static constexpr bool PERM = true, AFTER_DRAIN = false;
    bf16_t *QA, *KV6, *QR, *KR, *VR, *GR; float* GATES; const float2* rope; float lg0, lg1, lg2, lg3;
    __device__ __forceinline__ void operator()(const f32x4 (&acc)[2][2][4][2], const pg8::Unit& u, int wr, int wc, int fr, int fq) const {
        const int pn = u.pn, row0 = u.pm * 256 + wr * 64 + fr, cl0 = wc * 32 + 8 * fq;
        if (pn < 10 || (pn >= 18 && pn < 26)) {
            bf16_t* base; int ld;
            if (pn < 4) { base = QA + pn * 256; ld = 1024; }
            else if (pn < 10) { base = KV6 + (size_t)(pn - 4) * MTOK * 256; ld = 256; }
            else if (pn < 22) { base = VR + (pn - 18) * 256; ld = 1024; }
            else { base = GR + (pn - 22) * 256; ld = 1024; }
#pragma unroll
            for (int ai = 0; ai < 2; ++ai)
#pragma unroll
                for (int m = 0; m < 4; ++m) { bf16_t* rowp = base + (size_t)(row0 + ai * 128 + m * 16) * ld + cl0;
#pragma unroll
                    for (int bj = 0; bj < 2; ++bj) { f32x4 v0 = acc[ai][bj][m][0], v1 = acc[ai][bj][m][1];
                        u32x4 w; w.x = cvt_pk_bf16(v0[0], v0[1]); w.y = cvt_pk_bf16(v0[2], v0[3]); w.z = cvt_pk_bf16(v1[0], v1[1]); w.w = cvt_pk_bf16(v1[2], v1[3]);
                        *(u32x4*)(rowp + bj * 128) = w; } }
        } else if (pn < 18) {
            const bool isk = pn >= 14; const int hh = (pn - 10) & 3; bf16_t* base = (isk ? KR : QR) + hh * 256;
            const float lgh = hh == 0 ? lg0 : (hh == 1 ? lg1 : (hh == 2 ? lg2 : lg3));
#pragma unroll
            for (int ai = 0; ai < 2; ++ai)
#pragma unroll
                for (int m = 0; m < 4; ++m) { const int row = row0 + ai * 128 + m * 16, pos = row & (SEQ - 1);
                    const float ef = (float)((pos & 127) + 1) * lgh; const float sc = isk ? 0.0625f * __expf(-ef) : __expf(ef);
                    const float4* t4 = (const float4*)(rope + (size_t)pos * 128 + cl0);
                    const float4 ta = t4[0], tb = t4[1], tc = t4[2], td = t4[3];
                    const f32x4 a0 = acc[ai][0][m][0], a1 = acc[ai][0][m][1], b0 = acc[ai][1][m][0], b1 = acc[ai][1][m][1];
                    float o1[8], o2[8];
                    o1[0] = a0[0] * ta.x - b0[0] * ta.y; o2[0] = b0[0] * ta.x + a0[0] * ta.y;
                    o1[1] = a0[1] * ta.z - b0[1] * ta.w; o2[1] = b0[1] * ta.z + a0[1] * ta.w;
                    o1[2] = a0[2] * tb.x - b0[2] * tb.y; o2[2] = b0[2] * tb.x + a0[2] * tb.y;
                    o1[3] = a0[3] * tb.z - b0[3] * tb.w; o2[3] = b0[3] * tb.z + a0[3] * tb.w;
                    o1[4] = a1[0] * tc.x - b1[0] * tc.y; o2[4] = b1[0] * tc.x + a1[0] * tc.y;
                    o1[5] = a1[1] * tc.z - b1[1] * tc.w; o2[5] = b1[1] * tc.z + a1[1] * tc.w;
                    o1[6] = a1[2] * td.x - b1[2] * td.y; o2[6] = b1[2] * td.x + a1[2] * td.y;
                    o1[7] = a1[3] * td.z - b1[3] * td.w; o2[7] = b1[3] * td.z + a1[3] * td.w;
                    u32x4 w1, w2;
                    w1.x = cvt_pk_bf16(o1[0] * sc, o1[1] * sc); w1.y = cvt_pk_bf16(o1[2] * sc, o1[3] * sc); w1.z = cvt_pk_bf16(o1[4] * sc, o1[5] * sc); w1.w = cvt_pk_bf16(o1[6] * sc, o1[7] * sc);
                    w2.x = cvt_pk_bf16(o2[0] * sc, o2[1] * sc); w2.y = cvt_pk_bf16(o2[2] * sc, o2[3] * sc); w2.z = cvt_pk_bf16(o2[4] * sc, o2[5] * sc); w2.w = cvt_pk_bf16(o2[6] * sc, o2[7] * sc);
                    bf16_t* rowp = base + (size_t)row * 1024 + cl0;
                    *(u32x4*)(rowp) = w1; *(u32x4*)(rowp + 128) = w2; }
        } else {
            if (wc == 0 && fq < 3) {
#pragma unroll
                for (int ai = 0; ai < 2; ++ai)
#pragma unroll
                    for (int m = 0; m < 4; ++m) { const int row = row0 + ai * 128 + m * 16; float* gp = GATES + (size_t)row * 24 + 8 * fq;
                        f32x4 v0 = acc[ai][0][m][0], v1 = acc[ai][0][m][1];
                        *(f32x4*)gp = v0; *(f32x4*)(gp + 4) = v1; }
            }
        }
    }
};
struct RevOrder : pg8::StaticOrder {
    __device__ bool next(int i, pg8::Unit& u) const { const bool ok = pg8::StaticOrder::next(i, u); if (ok) u.pm = nM - 1 - u.pm; return ok; }
};
struct EpiBf16Plain {
    static constexpr bool PERM = true, AFTER_DRAIN = false;
    bf16_t* O; int ldc;
    __device__ __forceinline__ void operator()(const f32x4 (&acc)[2][2][4][2], const pg8::Unit& u, int wr, int wc, int fr, int fq) const {
        const int row0 = u.pm * 256 + wr * 64 + fr, col0 = u.pn * 256 + wc * 32 + 8 * fq;
#pragma unroll
        for (int ai = 0; ai < 2; ++ai)
#pragma unroll
            for (int m = 0; m < 4; ++m) { bf16_t* rowp = O + (size_t)(row0 + ai * 128 + m * 16) * ldc + col0;
#pragma unroll
                for (int bj = 0; bj < 2; ++bj) { const f32x4 v0 = acc[ai][bj][m][0], v1 = acc[ai][bj][m][1];
                    u32x4 w; w.x = cvt_pk_bf16(v0[0], v0[1]); w.y = cvt_pk_bf16(v0[2], v0[3]); w.z = cvt_pk_bf16(v1[0], v1[1]); w.w = cvt_pk_bf16(v1[2], v1[3]);
                    *(u32x4*)(rowp + bj * 128) = w; } }
    }
};
struct EpiRelu2 {
    static constexpr bool PERM = true, AFTER_DRAIN = false;
    bf16_t* O; int ldc;
    __device__ __forceinline__ void operator()(const f32x4 (&acc)[2][2][4][2], const pg8::Unit& u, int wr, int wc, int fr, int fq) const {
        const int row0 = u.pm * 256 + wr * 64 + fr, col0 = u.pn * 256 + wc * 32 + 8 * fq;
#pragma unroll
        for (int ai = 0; ai < 2; ++ai)
#pragma unroll
            for (int m = 0; m < 4; ++m) { bf16_t* rowp = O + (size_t)(row0 + ai * 128 + m * 16) * ldc + col0;
#pragma unroll
                for (int bj = 0; bj < 2; ++bj) { f32x4 v0 = acc[ai][bj][m][0], v1 = acc[ai][bj][m][1];
#pragma unroll
                    for (int e = 0; e < 4; ++e) { const float a = fmaxf(v0[e], 0.f), b = fmaxf(v1[e], 0.f); v0[e] = a * a; v1[e] = b * b; }
                    u32x4 w; w.x = cvt_pk_bf16(v0[0], v0[1]); w.y = cvt_pk_bf16(v0[2], v0[3]); w.z = cvt_pk_bf16(v1[0], v1[1]); w.w = cvt_pk_bf16(v1[2], v1[3]);
                    *(u32x4*)(rowp + bj * 128) = w; } }
    }
};

__device__ __forceinline__ void p6_resnorm(const Params& p, LAS unsigned char* lds, int NGW) {
    const int tid = opaque_tid(), lane = tid & 63, gw = blockIdx.x * 8 + __builtin_amdgcn_readfirstlane(tid >> 6);
    const bf16_t* xb = (const bf16_t*)((const unsigned char*)p.out + XB_OFF); const bf16_t* mix = (const bf16_t*)(p.ws + WS_MIX);
    float* RS2 = (float*)(p.ws + WS_RSTD2); const float* RS0 = (const float*)(p.ws + WS_RSTD0);
    LAS f32x4* gl1 = (LAS f32x4*)lds;
    __syncthreads();
    gl1[tid] = ((const f32x4*)p.in[13])[tid];
    __syncthreads();
    for (int row0 = gw; row0 < MTOK; row0 += 4 * NGW) {
        uint2 cm[4][8], cx[4][8];
#pragma unroll
        for (int r = 0; r < 4; ++r) { const int row = row0 + r * NGW;
            if (row < MTOK) {
#pragma unroll
                for (int j = 0; j < 8; ++j) { cm[r][j] = ldnt8((const uint2*)(mix + (size_t)row * DM) + lane + 64 * j); cx[r][j] = ldnt8((const uint2*)(xb + (size_t)row * DM) + lane + 64 * j); }
            } }
#pragma unroll
        for (int r = 0; r < 4; ++r) { const int row = row0 + r * NGW;
            if (row < MTOK) {
                float4 v[8]; float s = 0.f;
#pragma unroll
                for (int j = 0; j < 8; ++j) { v[j] = make_float4(bf2f(cm[r][j].x & 0xffffu), bf2f(cm[r][j].x >> 16), bf2f(cm[r][j].y & 0xffffu), bf2f(cm[r][j].y >> 16));
                    s += v[j].x * v[j].x + v[j].y * v[j].y + v[j].z * v[j].z + v[j].w * v[j].w; }
                const float rstd = rsqrtf(wave_sum(s) * (1.0f / DM) + NORM_EPS), rms0 = RS0[row];
                float s2 = 0.f; uint2* orow = (uint2*)((bf16_t*)(p.ws + WS_X1) + (size_t)row * DM) + lane;
#pragma unroll
                for (int j = 0; j < 8; ++j) { const f32x4 g = gl1[lane + 64 * j]; const uint2 xw0 = cx[r][j];
                    v[j].x = bf2f(xw0.x & 0xffffu) * rms0 + v[j].x * rstd * g[0]; v[j].y = bf2f(xw0.x >> 16) * rms0 + v[j].y * rstd * g[1]; v[j].z = bf2f(xw0.y & 0xffffu) * rms0 + v[j].z * rstd * g[2]; v[j].w = bf2f(xw0.y >> 16) * rms0 + v[j].w * rstd * g[3];
                    s2 += v[j].x * v[j].x + v[j].y * v[j].y + v[j].z * v[j].z + v[j].w * v[j].w; }
                const float rstd2 = rsqrtf(wave_sum(s2) * (1.0f / DM) + NORM_EPS);
                if (lane == 0) RS2[row] = 1.0f / rstd2;
#pragma unroll
                for (int j = 0; j < 8; ++j) { uint2 xw; xw.x = cvt_pk_bf16(v[j].x * rstd2, v[j].y * rstd2); xw.y = cvt_pk_bf16(v[j].z * rstd2, v[j].w * rstd2); orow[64 * j] = xw; }
            } }
    }
}
__device__ __forceinline__ void p9_final(const Params& p, LAS unsigned char* lds, int NGW) {
    const int tid = opaque_tid(), lane = tid & 63, gw = blockIdx.x * 8 + __builtin_amdgcn_readfirstlane(tid >> 6);
    const bf16_t* y = (const bf16_t*)(p.ws + WS_Y);
    LAS f32x4* gl = (LAS f32x4*)lds;
    __syncthreads();
    gl[tid] = ((const f32x4*)p.in[17])[tid];
    __syncthreads();
    for (int row0 = gw; row0 < MTOK; row0 += 3 * NGW) {
        uint2 cy[3][8], co[3][8];
#pragma unroll
        for (int r = 0; r < 3; ++r) { const int row = row0 + r * NGW;
            if (row < MTOK) {
#pragma unroll
                for (int j = 0; j < 8; ++j) { cy[r][j] = ldnt8((const uint2*)(y + (size_t)row * DM) + lane + 64 * j); co[r][j] = ldnt8((const uint2*)((const bf16_t*)(p.ws + WS_X1) + (size_t)row * DM) + lane + 64 * j); }
            } }
#pragma unroll
        for (int r = 0; r < 3; ++r) { const int row = row0 + r * NGW;
            if (row < MTOK) {
                float4 v[8]; float s = 0.f;
#pragma unroll
                for (int j = 0; j < 8; ++j) { v[j] = make_float4(bf2f(cy[r][j].x & 0xffffu), bf2f(cy[r][j].x >> 16), bf2f(cy[r][j].y & 0xffffu), bf2f(cy[r][j].y >> 16));
                    s += v[j].x * v[j].x + v[j].y * v[j].y + v[j].z * v[j].z + v[j].w * v[j].w; }
                const float rstd = rsqrtf(wave_sum(s) * (1.0f / DM) + NORM_EPS), rms2 = ((const float*)(p.ws + WS_RSTD2))[row];
                float4* orow = (float4*)(p.out + (size_t)row * DM) + lane;
#pragma unroll
                for (int j = 0; j < 8; ++j) { const f32x4 g = gl[lane + 64 * j]; const uint2 xw = co[r][j]; float4 o;
                    o.x = bf2f(xw.x & 0xffffu) * rms2 + v[j].x * rstd * g[0]; o.y = bf2f(xw.x >> 16) * rms2 + v[j].y * rstd * g[1]; o.z = bf2f(xw.y & 0xffffu) * rms2 + v[j].z * rstd * g[2]; o.w = bf2f(xw.y >> 16) * rms2 + v[j].w * rstd * g[3];
                    __builtin_nontemporal_store(o.x, &((float*)(orow + 64 * j))[0]); __builtin_nontemporal_store(o.y, &((float*)(orow + 64 * j))[1]); __builtin_nontemporal_store(o.z, &((float*)(orow + 64 * j))[2]); __builtin_nontemporal_store(o.w, &((float*)(orow + 64 * j))[3]); }
            } }
    }
}

__device__ __forceinline__ int t5_bucket(int rel) {
    const int n = rel > 0 ? rel : 0;
    if (n < 16) return n;
    const float nf = (float)n;
    int large = 16 + (int)(logf(nf / 16.0f) / 2.0794415416798357f * 16.0f);
    return large < 31 ? large : 31;
}

typedef short v4s __attribute__((ext_vector_type(4)));
__device__ __forceinline__ f32x4 mfma16(bf16x8 a, bf16x8 b, f32x4 c) { return __builtin_amdgcn_mfma_f32_16x16x32_bf16(a, b, c, 0, 0, 0); }
__device__ __forceinline__ bf16x8 tr_frag(const LAS bf16_t* X, int ld, int c0, int n0, int lane) {
    const int fq = lane >> 4, q = (lane & 15) >> 2, pq = lane & 3;
    const LAS bf16_t* a0 = X + (c0 + 4 * fq + q) * ld + n0 + 4 * pq;
    const v4s lo = __builtin_amdgcn_ds_read_tr16_b64_v4i16((LAS v4s*)a0);
    const v4s hi = __builtin_amdgcn_ds_read_tr16_b64_v4i16((LAS v4s*)(a0 + 16 * ld));
    return (bf16x8){lo[0], lo[1], lo[2], lo[3], hi[0], hi[1], hi[2], hi[3]};
}
__device__ __forceinline__ bf16x8 pack8(f32x4 a, f32x4 b) {
    u32x4 w; w.x = cvt_pk_bf16(a[0], a[1]); w.y = cvt_pk_bf16(a[2], a[3]); w.z = cvt_pk_bf16(b[0], b[1]); w.w = cvt_pk_bf16(b[2], b[3]);
    return __builtin_bit_cast(bf16x8, w);
}
__device__ __forceinline__ void swap16(unsigned& a, unsigned& b) { const auto r = __builtin_amdgcn_permlane16_swap(a, b, false, false); a = r[0]; b = r[1]; }
__device__ __forceinline__ void swap16f(float& a, float& b) { unsigned x = __float_as_uint(a), y = __float_as_uint(b); swap16(x, y); a = __uint_as_float(x); b = __uint_as_float(y); }
constexpr int RLD = 272;

__device__ __forceinline__ void stage_128x256(const bf16_t* g, LAS bf16_t* X, int tid) {
#pragma unroll
    for (int k = 0; k < 8; ++k) { const int pc = tid + 512 * k, r = pc >> 5, c8 = pc & 31;
        const u32x4 v = ldnt16(g + (size_t)r * 1024 + 8 * c8);
        *(LAS u32x4*)(X + r * RLD + 8 * c8) = v; }
}
__device__ __forceinline__ void mf_ret_u_items(const Params& p, int first, int stride, LAS unsigned char* lds) {
    const int tid = opaque_tid(), lane = tid & 63, wave = __builtin_amdgcn_readfirstlane(tid >> 6);
    unsigned char* ws = p.ws;
    LAS bf16_t* Kl = (LAS bf16_t*)lds; LAS bf16_t* Vl = Kl + 128 * RLD;
    const int wr = wave >> 1, wc = wave & 1, fr = lane & 15, fq = lane >> 4;
    u32x4 kst[8], vst[8];
#define RU_LOAD(bhn_) do { const int n_ = (bhn_) & 63, bh_ = (bhn_) >> 6; const size_t row0_ = (size_t)(bh_ >> 2) * SEQ + n_ * 128; \
        const bf16_t* kg_ = (const bf16_t*)(ws + WS_KR) + row0_ * 1024 + (bh_ & 3) * 256; const bf16_t* vg_ = (const bf16_t*)(ws + WS_VR) + row0_ * 1024 + (bh_ & 3) * 256; \
        _Pragma("unroll") for (int k_ = 0; k_ < 8; ++k_) { const int pc_ = tid + 512 * k_, r_ = pc_ >> 5, c8_ = pc_ & 31; \
            kst[k_] = *(const u32x4*)(kg_ + (size_t)r_ * 1024 + 8 * c8_); vst[k_] = *(const u32x4*)(vg_ + (size_t)r_ * 1024 + 8 * c8_); } } while (0)
    if (first < 512) RU_LOAD(first);
#pragma unroll 1
    for (int bhn = first; bhn < 512; bhn += stride) {
#pragma unroll
        for (int k = 0; k < 8; ++k) { const int pc = tid + 512 * k, r = pc >> 5, c8 = pc & 31; *(LAS u32x4*)(Kl + r * RLD + 8 * c8) = kst[k]; *(LAS u32x4*)(Vl + r * RLD + 8 * c8) = vst[k]; }
        __syncthreads();
        if (bhn + stride < 512) RU_LOAD(bhn + stride);
        bf16_t* UT = (bf16_t*)p.out + (size_t)bhn * 65536;
#pragma unroll 1
        for (int hf = 0; hf < 2; ++hf) {
            const int dk0 = 128 * wc + 64 * hf;
            f32x4 acc[4][4];
#pragma unroll
            for (int m = 0; m < 4; ++m)
#pragma unroll
                for (int nn = 0; nn < 4; ++nn) acc[m][nn] = (f32x4){0.f, 0.f, 0.f, 0.f};
#pragma unroll
            for (int kc = 0; kc < 4; ++kc) {
                bf16x8 a[4], bb[4];
#pragma unroll
                for (int m = 0; m < 4; ++m) a[m] = tr_frag(Vl, RLD, 32 * kc, 64 * wr + 16 * m, lane);
#pragma unroll
                for (int nn = 0; nn < 4; ++nn) bb[nn] = tr_frag(Kl, RLD, 32 * kc, dk0 + 16 * nn, lane);
#pragma unroll
                for (int m = 0; m < 4; ++m)
#pragma unroll
                    for (int nn = 0; nn < 4; ++nn) acc[m][nn] = mfma16(bb[nn], a[m], acc[m][nn]);
            }
#pragma unroll
            for (int m = 0; m < 4; ++m)
#pragma unroll
                for (int P = 0; P < 2; ++P) {
                    unsigned ax = cvt_pk_bf16(acc[m][2 * P][0], acc[m][2 * P][1]), ay = cvt_pk_bf16(acc[m][2 * P][2], acc[m][2 * P][3]);
                    unsigned bx = cvt_pk_bf16(acc[m][2 * P + 1][0], acc[m][2 * P + 1][1]), by = cvt_pk_bf16(acc[m][2 * P + 1][2], acc[m][2 * P + 1][3]);
                    swap16(ax, bx); swap16(ay, by);
                    *(u32x4*)(UT + (size_t)(64 * wr + 16 * m + fr) * 256 + dk0 + 32 * P + 16 * (fq & 1) + 8 * (fq >> 1)) = (u32x4){ax, ay, bx, by};
                }
        }
        __syncthreads();
    }
#undef RU_LOAD
}
__device__ __forceinline__ void mf_ret_scan(const Params& p, int gtid, int gthreads) {
    const bf16_t* UT = (const bf16_t*)p.out; bf16_t* RT = (bf16_t*)(p.ws + WS_RT);
    for (int e4 = gtid; e4 < 8 * 16384; e4 += gthreads) {
        const int bh = e4 >> 14, el = (e4 & 16383) * 4, h = bh & 3;
        const float gc = __expf(128.0f * p.lg[h]);
        float4 r = make_float4(0.f, 0.f, 0.f, 0.f);
        const bf16_t* up = UT + (size_t)bh * 64 * 65536 + el; bf16_t* rp = RT + (size_t)bh * 64 * 65536 + el;
#pragma unroll 8
        for (int n = 0; n < 64; ++n) {
            const uint2 uw = ldnt8(up + (size_t)n * 65536);
            const float4 u = make_float4(bf2f(uw.x & 0xffffu), bf2f(uw.x >> 16), bf2f(uw.y & 0xffffu), bf2f(uw.y >> 16));
            uint2 w; w.x = cvt_pk_bf16(r.x, r.y); w.y = cvt_pk_bf16(r.z, r.w); *(uint2*)(rp + (size_t)n * 65536) = w;
            r.x = gc * (r.x + u.x); r.y = gc * (r.y + u.y); r.z = gc * (r.z + u.z); r.w = gc * (r.w + u.w);
        }
    }
}
constexpr int RO_RT = 128 * RLD * 2;
__device__ __forceinline__ void mf_ret_out(const Params& p, int bhn, LAS unsigned char* lds, int tid_, int wave_, int lane_) {
    const int tid = opaque_tid(), lane = tid & 63, wave = __builtin_amdgcn_readfirstlane(tid >> 6); (void)tid_; (void)wave_; (void)lane_;
    unsigned char* ws = p.ws;
    const int n = bhn & 63, bh = bhn >> 6, b = bh >> 2, h = bh & 3;
    const size_t row0 = (size_t)b * SEQ + n * 128;
    LAS bf16_t* Vl = (LAS bf16_t*)lds;
    const bf16_t* Rg = (const bf16_t*)(ws + WS_RT) + (size_t)bhn * 65536;
    const int srow = tid >> 4, sch = tid & 15;
    const int fr = lane & 15, fq = lane >> 4;
    const bf16_t* Qg = (const bf16_t*)(ws + WS_QR) + (row0 + 16 * wave + fr) * 1024 + h * 256 + 8 * fq;
    bf16x8 qf[8];
#pragma unroll
    for (int kc = 0; kc < 8; ++kc) qf[kc] = __builtin_bit_cast(bf16x8, ldnt16(Qg + 32 * kc));
    u32x4 rstg[8];
    { const bf16_t* Kt = (const bf16_t*)(ws + WS_KR) + row0 * 1024 + h * 256;
#pragma unroll
      for (int k = 0; k < 8; ++k) { const int pc = tid + 512 * k, r = pc >> 5, c8 = pc & 31; rstg[k] = ldnt16(Kt + (size_t)r * 1024 + 8 * c8); } }
    stage_128x256((const bf16_t*)(ws + WS_VR) + row0 * 1024 + h * 256, Vl, tid);
#pragma unroll
    for (int k = 0; k < 8; ++k) { const int pc = tid + 512 * k, r = pc >> 5, c8 = pc & 31; *(LAS u32x4*)(lds + RO_RT + r * 512 + (((c8 & 16) | ((c8 ^ r) & 15)) << 4)) = rstg[k]; }
#pragma unroll
    for (int k = 0; k < 8; ++k) rstg[k] = ldnt16(Rg + (size_t)(srow + 32 * k) * 256 + 8 * sch);
    __syncthreads();
    f32x4 st[8];
#pragma unroll
    for (int jt = 0; jt < 8; ++jt) {
        st[jt] = (f32x4){0.f, 0.f, 0.f, 0.f};
        if (jt <= wave) {
            bf16x8 kfr[8];
#pragma unroll
            for (int kc = 0; kc < 8; ++kc) { const int ch = 4 * kc + fq; kfr[kc] = *(const LAS bf16x8*)(lds + RO_RT + (16 * jt + fr) * 512 + (((ch & 16) | ((ch ^ fr) & 15)) << 4)); }
#pragma unroll
            for (int kc = 0; kc < 8; ++kc) st[jt] = mfma16(kfr[kc], qf[kc], st[jt]);
            if (jt == wave) {
#pragma unroll
                for (int r = 0; r < 4; ++r) if (4 * fq + r > fr) st[jt][r] = 0.f;
            }
        }
    }
    __syncthreads();
#pragma unroll
    for (int k = 0; k < 8; ++k) { const int r = srow + 32 * k; *(LAS u32x4*)(lds + RO_RT + r * 256 + ((sch ^ (r & 15)) << 4)) = rstg[k]; }
#pragma unroll
    for (int k = 0; k < 8; ++k) rstg[k] = ldnt16(Rg + (size_t)(srow + 32 * k) * 256 + 128 + 8 * sch);
    const bf16_t* Gg = (const bf16_t*)(ws + WS_GR) + (row0 + 16 * wave + fr) * 1024 + h * 256 + 8 * (fq >> 1) + 16 * (fq & 1);
    u32x4 gwv[8];
#pragma unroll
    for (int P = 0; P < 8; ++P) gwv[P] = ldnt16(Gg + 32 * P);
    f32x4 acc[16];
#pragma unroll
    for (int dt = 0; dt < 16; ++dt) acc[dt] = (f32x4){0.f, 0.f, 0.f, 0.f};
#pragma unroll
    for (int C = 0; C < 4; ++C) {
        if (2 * C <= wave) {
            const bf16x8 pb = pack8(st[2 * C], st[2 * C + 1]);
#pragma unroll
            for (int dt = 0; dt < 16; ++dt) acc[dt] = mfma16(tr_frag(Vl, RLD, 32 * C, 16 * dt, lane), pb, acc[dt]);
        }
    }
    __syncthreads();
    const unsigned rbase = (unsigned)(RO_RT + fr * 256);
#pragma unroll 1
    for (int hf = 0; hf < 2; ++hf) {
        if (hf == 1) {
            __syncthreads();
#pragma unroll
            for (int k = 0; k < 8; ++k) { const int r = srow + 32 * k; *(LAS u32x4*)(lds + RO_RT + r * 256 + ((sch ^ (r & 15)) << 4)) = rstg[k]; }
            __syncthreads();
        }
#pragma unroll
        for (int kc = 0; kc < 4; ++kc) {
            const unsigned coff = (unsigned)(((4 * kc + fq) ^ fr) << 4);
            const bf16x8 qv = hf ? qf[4 + kc] : qf[kc];
#pragma unroll
            for (int dt = 0; dt < 16; ++dt) acc[dt] = mfma16(*(const LAS bf16x8*)(lds + rbase + dt * 4096 + coff), qv, acc[dt]);
        }
    }
    float s = 0.f;
#pragma unroll
    for (int dt = 0; dt < 16; ++dt) s += (acc[dt][0] + acc[dt][1]) + (acc[dt][2] + acc[dt][3]);
    s += __shfl_xor(s, 16); s += __shfl_xor(s, 32);
    const float mu = s * (1.0f / 256.0f);
    float q = 0.f;
#pragma unroll
    for (int dt = 0; dt < 16; ++dt)
#pragma unroll
        for (int r = 0; r < 4; ++r) { const float d = acc[dt][r] - mu; q += d * d; }
    q += __shfl_xor(q, 16); q += __shfl_xor(q, 32);
    const float rstd = rsqrtf(q * (1.0f / 256.0f) + GN_EPS);
    bf16_t* Og = (bf16_t*)(ws + WS_H) + (row0 + 16 * wave + fr) * 2048 + 1024 + h * 256 + 8 * (fq >> 1) + 16 * (fq & 1);
#pragma unroll
    for (int P = 0; P < 8; ++P) {
        float v[8];
#pragma unroll
        for (int r = 0; r < 4; ++r) { float a_ = acc[2 * P][r], b_ = acc[2 * P + 1][r]; swap16f(a_, b_); v[r] = (a_ - mu) * rstd; v[4 + r] = (b_ - mu) * rstd; }
        const u32x4 gw = gwv[P];
        const unsigned gwd[4] = {gw.x, gw.y, gw.z, gw.w};
        unsigned wd[4];
#pragma unroll
        for (int k = 0; k < 4; ++k) {
            const float g0 = bf2f(gwd[k] & 0xffffu), g1 = bf2f(gwd[k] >> 16);
            wd[k] = cvt_pk_bf16(g0 * __builtin_amdgcn_rcpf(1.0f + __expf(-g0)) * v[2 * k], g1 * __builtin_amdgcn_rcpf(1.0f + __expf(-g1)) * v[2 * k + 1]);
        }
        *(u32x4*)(Og + 32 * P) = (u32x4){wd[0], wd[1], wd[2], wd[3]};
    }
    __syncthreads();
}
__device__ __forceinline__ void mf_compress(const Params& p, int item, LAS unsigned char* lds, int tid_, int wave_, int lane_) {
    const int tid = opaque_tid(), lane = tid & 63, wave = __builtin_amdgcn_readfirstlane(tid >> 6); (void)tid_; (void)wave_; (void)lane_;
    unsigned char* ws = p.ws;
    const int T = item & 31, g = (item >> 5) & 1, b = (item >> 6) & 1, kind = item >> 7;
    const int fr = lane & 15, fq = lane >> 4;
    const bf16_t* KV = (const bf16_t*)(ws + WS_KV6) + (size_t)kind * MTOK * 256;
    const bf16_t* W1T = (const bf16_t*)(ws + WS_CW1T) + (size_t)kind * 128 * 4096;
    const bf16_t* W2T = (const bf16_t*)(ws + WS_CW2T) + (size_t)kind * 128 * 128;
    const float* CB = (const float*)(ws + WS_CB) + kind * 128;
    LAS float* red = (LAS float*)lds;
    LAS bf16_t* hid = (LAS bf16_t*)(lds + 65536);
    f32x4 acc[8];
#pragma unroll
    for (int ct = 0; ct < 8; ++ct) acc[ct] = (f32x4){0.f, 0.f, 0.f, 0.f};
    const int nblk = 16 * T + fr;
#pragma unroll
    for (int ll = 0; ll < 4; ++ll) {
        const int l = 4 * wave + ll;
        int tok = 16 * nblk + l; tok = tok < SEQ ? tok : SEQ - 1;
        const bf16_t* Ag = KV + ((size_t)b * SEQ + tok) * 256 + g * 128 + 8 * fq;
#pragma unroll
        for (int kc = 0; kc < 4; ++kc) {
            const bf16x8 a = *(const bf16x8*)(Ag + 32 * kc);
#pragma unroll
            for (int ct = 0; ct < 8; ++ct) acc[ct] = mfma16(a, *(const bf16x8*)(W1T + (size_t)(16 * ct + fr) * 4096 + l * 128 + 32 * kc + 8 * fq), acc[ct]);
        }
    }
#pragma unroll
    for (int ct = 0; ct < 8; ++ct)
#pragma unroll
        for (int r = 0; r < 4; ++r) red[(wave * 16 + 4 * fq + r) * 128 + 16 * ct + fr] = acc[ct][r];
    __syncthreads();
    for (int idx = tid; idx < 2048; idx += 512) {
        const int nn = idx >> 7, c = idx & 127; float hsum = 0.f;
#pragma unroll
        for (int sl = 0; sl < 8; ++sl) hsum += CB[sl * 256 + c];
#pragma unroll
        for (int w = 0; w < 8; ++w) hsum += red[(w * 16 + nn) * 128 + c];
        const float x3 = hsum * hsum * hsum;
        hsum = 0.5f * hsum * (1.0f + tanhf(0.7978845608028654f * (hsum + 0.044715f * x3)));
        hid[nn * 136 + c] = (bf16_t)(cvt_pk_bf16(hsum, 0.f) & 0xffffu);
    }
    __syncthreads();
    f32x4 o = (f32x4){0.f, 0.f, 0.f, 0.f};
#pragma unroll
    for (int kc = 0; kc < 4; ++kc)
        o = mfma16(*(const LAS bf16x8*)(hid + fr * 136 + 32 * kc + 8 * fq), *(const bf16x8*)(W2T + (size_t)(16 * wave + fr) * 128 + 32 * kc + 8 * fq), o);
    {
        bf16_t* OC = (bf16_t*)(ws + (kind == 0 ? WS_KC : WS_VCT)) + ((size_t)(b * 2 + g) * NCMPP + 16 * T) * 128 + 16 * wave + fr;
#pragma unroll
        for (int r = 0; r < 4; ++r) OC[(4 * fq + r) * 128] = (bf16_t)(cvt_pk_bf16(o[r], 0.f) & 0xffffu);
    }
    __syncthreads();
}


constexpr int ALD = 144;
constexpr int A_KV = 0, A_KVBUF = 32768, A_VOFF = 16384, A_SEL = 98304, A_BIAS = 99328, A_IMP = 103424, IMPLD = 129;
constexpr float QK_SCALE = 0.08838834764831845f;

__device__ __forceinline__ u32x4 ldg16(const void* ubase, unsigned voff) { return *(const u32x4*)((const char*)ubase + voff); }
__device__ __forceinline__ bf16x8 ldg_frag(const void* ubase, unsigned voff) { return __builtin_bit_cast(bf16x8, *(const u32x4*)((const char*)ubase + voff)); }
__device__ __forceinline__ bf16x8 lds_frag(LAS unsigned char* lds, unsigned off) { return *(const LAS bf16x8*)(lds + off); }
__device__ __forceinline__ bf16x8 tr_frag_b(LAS unsigned char* lds, unsigned off, unsigned hi16) {
    const v4s lo = __builtin_amdgcn_ds_read_tr16_b64_v4i16((LAS v4s*)(lds + off));
    const v4s hi = __builtin_amdgcn_ds_read_tr16_b64_v4i16((LAS v4s*)(lds + off + hi16));
    return (bf16x8){lo[0], lo[1], lo[2], lo[3], hi[0], hi[1], hi[2], hi[3]};
}
constexpr float LOG2E = 1.4426950408889634f, C1 = QK_SCALE * LOG2E, RESCALE_THR = 8.0f;
__device__ __forceinline__ float ex2(float x) { return __builtin_amdgcn_exp2f(x); }
__device__ __forceinline__ void lds_addfix(LAS unsigned* pz, float v) { (void)__hip_atomic_fetch_add(pz, (unsigned)__float2uint_rn(v * 67108864.0f), __ATOMIC_RELAXED, __HIP_MEMORY_SCOPE_WORKGROUP); }
__device__ __forceinline__ int sum8_dpp(int v) {
    v += __builtin_amdgcn_mov_dpp(v, 0xB1, 0xf, 0xf, true);
    v += __builtin_amdgcn_mov_dpp(v, 0x4E, 0xf, 0xf, true);
    v += __builtin_amdgcn_mov_dpp(v, 0x141, 0xf, 0xf, true);
    return v;
}
__device__ __forceinline__ float max16(const f32x4& a, const f32x4& b, const f32x4& c, const f32x4& d) {
    return fmaxf(fmaxf(fmaxf(fmaxf(a[0], a[1]), fmaxf(a[2], a[3])), fmaxf(fmaxf(b[0], b[1]), fmaxf(b[2], b[3]))),
                 fmaxf(fmaxf(fmaxf(c[0], c[1]), fmaxf(c[2], c[3])), fmaxf(fmaxf(d[0], d[1]), fmaxf(d[2], d[3]))));
}
typedef int v2i __attribute__((ext_vector_type(2)));
#define TR_READ_ASM(dst, addr, off) asm volatile("ds_read_b64_tr_b16 %0, %1 offset:%2" : "=v"(dst) : "v"(addr), "i"(off))
__device__ __forceinline__ bf16x8 ldg_qfrag(const void* ubase, unsigned voff) {
    const u32x4 v = ldnt16((const char*)ubase + voff); u32x4 w;
    w.x = cvt_pk_bf16(bf2f(v.x & 0xffffu) * C1, bf2f(v.x >> 16) * C1); w.y = cvt_pk_bf16(bf2f(v.y & 0xffffu) * C1, bf2f(v.y >> 16) * C1);
    w.z = cvt_pk_bf16(bf2f(v.z & 0xffffu) * C1, bf2f(v.z >> 16) * C1); w.w = cvt_pk_bf16(bf2f(v.w & 0xffffu) * C1, bf2f(v.w >> 16) * C1);
    return __builtin_bit_cast(bf16x8, w);
}
__device__ __forceinline__ void mf_nsa(const Params& p, int bg, int c, LAS unsigned char* lds, int tid_, int wave_, int lane_) {
    const int tid = opaque_tid(), lane = tid & 63, wave = __builtin_amdgcn_readfirstlane(tid >> 6); (void)tid_; (void)wave_; (void)lane_;
    unsigned char* ws = p.ws;
    const int b = bg >> 1, g = bg & 1, fr = lane & 15, fq = lane >> 4, hg = wave >> 1, th = wave & 1, h = 4 * g + hg;
    LAS unsigned* imp = (LAS unsigned*)(lds + A_IMP); LAS unsigned* sel = (LAS unsigned*)(lds + A_SEL); LAS float* biasT = (LAS float*)(lds + A_BIAS);
    const float* t5 = p.in[11];
    for (int i = tid; i < 64 * IMPLD; i += 512) imp[i] = 0u;
    if (tid < 256) sel[tid] = 0u;
    const float b31 = t5[31 * 8 + h] * LOG2E;
    const int tl0 = 32 * th + fr;
    const size_t row0 = (size_t)b * SEQ + 64 * c;
    const bf16_t* Qu = (const bf16_t*)(ws + WS_QA) + row0 * 1024 + h * 128;     const unsigned qoff = (unsigned)(tl0 * 1024 + 8 * fq) * 2u;
    const float* Gu = (const float*)(ws + WS_GATES) + row0 * 24 + h * 3;          const unsigned goff = (unsigned)(tl0 * 24) * 4u;
    bf16_t* Ou = (bf16_t*)(ws + WS_H) + row0 * 2048 + h * 128;                    const unsigned ooffw = (unsigned)(tl0 * 2048 + 8 * (fq >> 1) + 16 * (fq & 1)) * 2u;
    __syncthreads();
    const bf16_t* KVs = (const bf16_t*)(ws + WS_KV6) + (size_t)b * SEQ * 256 + g * 128;
    const int dr0 = 8 * wave + (lane >> 4);
    unsigned dslot[4];
    { const int r1 = dr0 + 4, sl = lane & 15;
      dslot[0] = (unsigned)((sl ^ (dr0 & 15)) << 4); dslot[1] = (unsigned)((sl ^ (r1 & 15)) << 4);
      dslot[2] = (unsigned)((sl ^ ((dr0 & 7) << 1)) << 4); dslot[3] = (unsigned)((sl ^ ((r1 & 7) << 1)) << 4); }
#define NSA_DMA_T(kb_, vb_, rp_, bi_) do { const unsigned ro0_ = (unsigned)dr0 * (rp_), ro1_ = ro0_ + 4u * (rp_); \
        LAS unsigned char* d_ = lds + A_KV + (bi_) * A_KVBUF + wave * 2048; \
        __builtin_amdgcn_global_load_lds((const unsigned*)((kb_) + ro0_ + dslot[0]), (LAS unsigned*)(d_), 16, 0, 0); \
        __builtin_amdgcn_global_load_lds((const unsigned*)((kb_) + ro1_ + dslot[1]), (LAS unsigned*)(d_ + 1024), 16, 0, 0); \
        __builtin_amdgcn_global_load_lds((const unsigned*)((vb_) + ro0_ + dslot[2]), (LAS unsigned*)(d_ + A_VOFF), 16, 0, 0); \
        __builtin_amdgcn_global_load_lds((const unsigned*)((vb_) + ro1_ + dslot[3]), (LAS unsigned*)(d_ + A_VOFF + 1024), 16, 0, 0); } while (0)
    const int nslc_ = c + 1;
#define NSA_TILE_J(sn) ((sn) < nslc_ ? (sn) : (c < 8 ? (sn) - nslc_ : ((sn) - nslc_ == 8 ? c - 8 : c - 7 + ((sn) - nslc_))))
#define NSA_DMA(sn) do { const bool win_ = (sn) >= nslc_; const int j_ = NSA_TILE_J(sn); \
        const char* kbq_ = (const char*)(KVs + ((size_t)(win_ ? 4 : 2) * MTOK + 64 * j_) * 256); NSA_DMA_T(kbq_, kbq_ + (size_t)MTOK * 512, 512u, (sn) % 3); } while (0)
    const int vq = 4 * fq + ((lane & 15) >> 2), vp = lane & 3;
    const unsigned vrow = (unsigned)(A_VOFF + vq * 256 + (vp >> 1) * 16 + (vp & 1) * 8), vx = (unsigned)((vq & 7) << 5);

    bf16x8 qf[2][4];
#pragma unroll
    for (int qb = 0; qb < 2; ++qb)
#pragma unroll
        for (int kc = 0; kc < 4; ++kc) qf[qb][kc] = ldg_qfrag(Qu + (size_t)qb * 16 * 1024 + 32 * kc, qoff);
    {
        const int nmax = 4 * c + 2 < NCMP - 1 ? 4 * c + 2 : NCMP - 1, NCT = nmax / 64 + 1, CS = 2 * NCT;
        const char* KCb = (const char*)((const bf16_t*)(ws + WS_KC) + (size_t)(b * 2 + g) * NCMPP * 128);
        const char* VCb = (const char*)((const bf16_t*)(ws + WS_VCT) + (size_t)(b * 2 + g) * NCMPP * 128);
#define NSA_DMA_C(un) do { const int T_ = (un) < NCT ? (un) : (un) - NCT; NSA_DMA_T(KCb + (size_t)T_ * 64 * 256, VCb + (size_t)T_ * 64 * 256, 256u, (un) % 3); } while (0)
        NSA_DMA_C(0); NSA_DMA_C(1);
        f32x4 oc[2][8], lacc[2];
        float m2[2] = {0.f, 0.f}, inv_l[2] = {0.f, 0.f};
        const bf16x8 ones8 = (bf16x8){0x3f80, 0x3f80, 0x3f80, 0x3f80, 0x3f80, 0x3f80, 0x3f80, 0x3f80};
#pragma unroll
        for (int qb = 0; qb < 2; ++qb) { lacc[qb] = (f32x4){0.f, 0.f, 0.f, 0.f};
#pragma unroll
            for (int dt = 0; dt < 8; ++dt) oc[qb][dt] = (f32x4){0.f, 0.f, 0.f, 0.f}; }
        unsigned koff[4];
#pragma unroll
        for (int kc = 0; kc < 4; ++kc) koff[kc] = (unsigned)(fr * 256 + (((4 * kc + fq) ^ fr) << 4));
        asm volatile("s_waitcnt vmcnt(0)" ::: "memory");
#pragma unroll 1
        for (int u = 0; u < CS; ++u) {
            const bool p1 = u >= NCT; const int T = p1 ? u - NCT : u;
            if (u > 0) { if (u + 1 < CS) asm volatile("s_waitcnt vmcnt(4)" ::: "memory"); else asm volatile("s_waitcnt vmcnt(0)" ::: "memory"); }
            __builtin_amdgcn_s_barrier(); asm volatile("" ::: "memory");
            if (u + 2 < CS) NSA_DMA_C(u + 2);
            unsigned vxl = vx, vrowl = vrow; asm volatile("" : "+v"(vxl), "+v"(vrowl));
            const unsigned kbuf = (unsigned)(A_KV + (u % 3) * A_KVBUF);
#pragma unroll
            for (int C = 0; C < 2; ++C) {
                f32x4 st[2][2];
                if (64 * c - 1024 * T - 512 * C < 655) {
#pragma unroll
                    for (int qb = 0; qb < 2; ++qb) {
                        const int relb = 64 * c + tl0 + 16 * qb - 31 - 16 * (64 * T + 32 * C + 4 * fq);
#pragma unroll
                        for (int t = 0; t < 2; ++t)
#pragma unroll
                            for (int r = 0; r < 4; ++r) { int rel = relb - 256 * t - 16 * r; rel = rel > 191 ? 191 : (rel < -64 ? -64 : rel);
                                st[t][qb][r] = biasT[hg * 256 + 191 - rel] - m2[qb]; }
                    }
                } else {
                    const float bl0 = b31 - m2[0], bl1 = b31 - m2[1];
#pragma unroll
                    for (int t = 0; t < 2; ++t) { st[t][0] = (f32x4){bl0, bl0, bl0, bl0}; st[t][1] = (f32x4){bl1, bl1, bl1, bl1}; }
                }
#pragma unroll
                for (int t = 0; t < 2; ++t) {
                    bf16x8 kf[4];
#pragma unroll
                    for (int kc = 0; kc < 4; ++kc) kf[kc] = lds_frag(lds, kbuf + koff[kc] + (2 * C + t) * 4096);
#pragma unroll
                    for (int kc = 0; kc < 4; ++kc) { st[t][0] = mfma16(kf[kc], qf[0][kc], st[t][0]); st[t][1] = mfma16(kf[kc], qf[1][kc], st[t][1]); }
                }
                bf16x8 pb[2];
                if (!p1) {
                    int imx = __float_as_int(st[0][0][0]);
#pragma unroll
                    for (int qb = 0; qb < 2; ++qb)
#pragma unroll
                        for (int t = 0; t < 2; ++t)
#pragma unroll
                            for (int r = 0; r < 4; ++r) imx = max(imx, __float_as_int(st[t][qb][r]));
                    const bool first = u == 0 && C == 0;
                    if (first || __any(imx > __float_as_int(RESCALE_THR))) {
#pragma unroll
                        for (int qb = 0; qb < 2; ++qb) {
                            float mx = fmaxf(fmaxf(fmaxf(st[0][qb][0], st[0][qb][1]), fmaxf(st[0][qb][2], st[0][qb][3])), fmaxf(fmaxf(st[1][qb][0], st[1][qb][1]), fmaxf(st[1][qb][2], st[1][qb][3])));
                            mx = fmaxf(mx, __shfl_xor(mx, 16)); mx = fmaxf(mx, __shfl_xor(mx, 32));
                            const float d = first ? mx : fmaxf(mx, 0.f), al = first ? 1.0f : ex2(-d);
                            m2[qb] += d; lacc[qb] = lacc[qb] * al;
#pragma unroll
                            for (int t = 0; t < 2; ++t)
#pragma unroll
                                for (int r = 0; r < 4; ++r) st[t][qb][r] -= d;
                        }
                    }
#pragma unroll
                    for (int qb = 0; qb < 2; ++qb) {
#pragma unroll
                        for (int t = 0; t < 2; ++t)
#pragma unroll
                            for (int r = 0; r < 4; ++r) st[t][qb][r] = ex2(st[t][qb][r]);
                        pb[qb] = pack8(st[0][qb], st[1][qb]);
                    }
                    lacc[0] = mfma16(ones8, pb[0], lacc[0]); lacc[1] = mfma16(ones8, pb[1], lacc[1]);
                } else {
                    v2i vlo[8], vhi[8];
#pragma unroll
                    for (int dt = 0; dt < 8; ++dt) { const unsigned va = (unsigned)(size_t)lds + kbuf + vrowl + (((unsigned)(dt << 5)) ^ vxl);
                        if (C == 0) { TR_READ_ASM(vlo[dt], va, 0); TR_READ_ASM(vhi[dt], va, 4096); } else { TR_READ_ASM(vlo[dt], va, 8192); TR_READ_ASM(vhi[dt], va, 12288); } }
#pragma unroll
                    for (int qb = 0; qb < 2; ++qb) {
#pragma unroll
                        for (int t = 0; t < 2; ++t)
#pragma unroll
                            for (int r = 0; r < 4; ++r) st[t][qb][r] = ex2(st[t][qb][r]) * inv_l[qb];
                        LAS unsigned* ip = imp + (tl0 + 16 * qb) * IMPLD + 16 * T + 8 * C + fq;
#pragma unroll
                        for (int t = 0; t < 2; ++t) {
                            lds_addfix(ip + 4 * t, (st[t][qb][0] + st[t][qb][1]) + (st[t][qb][2] + st[t][qb][3]));
                            if (16 * T + 8 * C + 4 * t + fq + 1 < 128) lds_addfix(ip + 4 * t + 1, st[t][qb][3]);
                        }
                        pb[qb] = pack8(st[0][qb], st[1][qb]);
                    }
                    asm volatile("s_waitcnt lgkmcnt(0)" : "+v"(vlo[0]), "+v"(vlo[1]), "+v"(vlo[2]), "+v"(vlo[3]), "+v"(vlo[4]), "+v"(vlo[5]), "+v"(vlo[6]), "+v"(vlo[7]),
                                 "+v"(vhi[0]), "+v"(vhi[1]), "+v"(vhi[2]), "+v"(vhi[3]), "+v"(vhi[4]), "+v"(vhi[5]), "+v"(vhi[6]), "+v"(vhi[7]) :: "memory");
                    __builtin_amdgcn_sched_barrier(0);
#pragma unroll
                    for (int dt = 0; dt < 8; ++dt) { const bf16x8 vfr = __builtin_bit_cast(bf16x8, (u32x4){(unsigned)vlo[dt][0], (unsigned)vlo[dt][1], (unsigned)vhi[dt][0], (unsigned)vhi[dt][1]});
                        oc[0][dt] = mfma16(vfr, pb[0], oc[0][dt]); oc[1][dt] = mfma16(vfr, pb[1], oc[1][dt]); }
                }
            }
            if (u == NCT - 1) {
#pragma unroll
                for (int qb = 0; qb < 2; ++qb) inv_l[qb] = (64 * c + tl0 + 16 * qb >= 31) ? 1.0f / lacc[qb][0] : 0.f;
            }
        }
#undef NSA_DMA_C
#pragma unroll
        for (int qb = 0; qb < 2; ++qb) {
            const float gzr = *(const float*)((const char*)(Gu + qb * 16 * 24 + 0) + goff), gz = 1.0f / (1.0f + __expf(-gzr));
#pragma unroll
            for (int P = 0; P < 4; ++P) {
                unsigned ax = cvt_pk_bf16(oc[qb][2 * P][0] * gz, oc[qb][2 * P][1] * gz), ay = cvt_pk_bf16(oc[qb][2 * P][2] * gz, oc[qb][2 * P][3] * gz);
                unsigned bx = cvt_pk_bf16(oc[qb][2 * P + 1][0] * gz, oc[qb][2 * P + 1][1] * gz), by = cvt_pk_bf16(oc[qb][2 * P + 1][2] * gz, oc[qb][2 * P + 1][3] * gz);
                swap16(ax, bx); swap16(ay, by);
                *(u32x4*)((char*)(Ou + (size_t)qb * 16 * 2048 + 32 * P) + ooffw) = (u32x4){ax, ay, bx, by}; }
        }
    }
    __syncthreads();
    NSA_DMA(0); NSA_DMA(1);
    {
        const int tk = tid >> 3, k = tid & 7;
        unsigned bits = 0u;
        if (c < 16) {
#pragma unroll
            for (int jj = 0; jj < 16; ++jj) bits |= (16 * k + jj <= c ? 1u : 0u) << jj;
        } else {
            unsigned v[16];
#pragma unroll
            for (int jj = 0; jj < 16; ++jj) { const int j = 16 * k + jj; v[jj] = (j >= 1 && j <= c - 2) ? imp[tk * IMPLD + j] : 0u; }
            unsigned T = 0u;
#pragma unroll 1
            for (int bit = 30; bit >= 0; --bit) {
                const unsigned trial = T | (1u << bit);
                int cnt = 0;
#pragma unroll
                for (int jj = 0; jj < 16; ++jj) cnt += v[jj] >= trial ? 1 : 0;
                cnt = sum8_dpp(cnt);
                if (cnt >= 13) T = trial;
            }
            int ngt = 0, neq = 0;
#pragma unroll
            for (int jj = 0; jj < 16; ++jj) { const int j = 16 * k + jj; const bool cand = j >= 1 && j <= c - 2; ngt += (cand && v[jj] > T) ? 1 : 0; neq += (cand && v[jj] == T) ? 1 : 0; }
            const int tgt = sum8_dpp(ngt);
            int pre = 0;
#pragma unroll
            for (int kk = 0; kk < 8; ++kk) { const int o = __shfl(neq, (lane & ~7) | kk); pre += kk < k ? o : 0; }
            int room = 13 - tgt - pre;
#pragma unroll
            for (int jj = 0; jj < 16; ++jj) { const int j = 16 * k + jj; const bool cand = j >= 1 && j <= c - 2;
                bool s1 = (j == 0) || (j == c) || (j == c - 1) || (cand && v[jj] > T);
                if (cand && v[jj] == T) { if (room > 0) s1 = true; --room; }
                bits |= (s1 ? 1u : 0u) << jj; }
        }
        atomicOr((unsigned*)(sel + tk * 4 + (k >> 1)), bits << (16 * (k & 1)));
    }
    __syncthreads();
    {
        const int nslc = c + 1, nwin = (c < 8 ? c : 8) + 1, nsteps = nslc + nwin;
        f32x4 oacc[2][8], lacc[2];
        float m2[2];
        const bf16x8 ones8 = (bf16x8){0x3f80, 0x3f80, 0x3f80, 0x3f80, 0x3f80, 0x3f80, 0x3f80, 0x3f80};
#pragma unroll
        for (int qb = 0; qb < 2; ++qb) { m2[qb] = 0.f; lacc[qb] = (f32x4){0.f, 0.f, 0.f, 0.f};
#pragma unroll
            for (int dt = 0; dt < 8; ++dt) oacc[qb][dt] = (f32x4){0.f, 0.f, 0.f, 0.f}; }
        unsigned koff[4];
#pragma unroll
        for (int kc = 0; kc < 4; ++kc) koff[kc] = (unsigned)(fr * 256 + (((4 * kc + fq) ^ fr) << 4));
        asm volatile("s_waitcnt vmcnt(0)" ::: "memory");
#pragma unroll 1
        for (int s = 0; s < nsteps; ++s) {
            const bool win = s >= nslc; const int j = NSA_TILE_J(s), dlt = c - j;
            if (s > 0) { if (s + 1 < nsteps) asm volatile("s_waitcnt vmcnt(4)" ::: "memory"); else asm volatile("s_waitcnt vmcnt(0)" ::: "memory"); }
            __builtin_amdgcn_s_barrier(); asm volatile("" ::: "memory");
            if (s + 2 < nsteps) NSA_DMA(s + 2);
            unsigned selw[2] = {0xffffffffu, 0xffffffffu};
            if (!win) { selw[0] = sel[tl0 * 4 + (j >> 5)]; selw[1] = sel[(tl0 + 16) * 4 + (j >> 5)]; }
            const unsigned kbuf = (unsigned)(A_KV + (s % 3) * A_KVBUF);
            const bool on0 = ((selw[0] >> (j & 31)) & 1u) != 0u, on1 = ((selw[1] >> (j & 31)) & 1u) != 0u;
#pragma unroll
            for (int C = 0; C < 2; ++C) {
                bf16x8 kf[2][4];
#pragma unroll
                for (int t = 0; t < 2; ++t)
#pragma unroll
                    for (int kc = 0; kc < 4; ++kc) kf[t][kc] = lds_frag(lds, kbuf + koff[kc] + (2 * C + t) * 4096);
                f32x4 st[2][2];
                if (dlt <= 2) {
#pragma unroll
                    for (int qb = 0; qb < 2; ++qb) {
                        const int tlq = tl0 + 16 * qb; const bool on = qb ? on1 : on0;
                        const LAS float* bt = biasT + hg * 256 + (191 - 64 * dlt - tlq + 4 * fq) + 32 * C;
#pragma unroll
                        for (int t = 0; t < 2; ++t)
#pragma unroll
                            for (int r = 0; r < 4; ++r) { const float tv = bt[16 * t + r] - m2[qb]; st[t][qb][r] = on ? tv : -1e30f; }
                    }
                } else {
                    const float bl0 = on0 ? b31 - m2[0] : -1e30f, bl1 = on1 ? b31 - m2[1] : -1e30f;
#pragma unroll
                    for (int t = 0; t < 2; ++t) { st[t][0] = (f32x4){bl0, bl0, bl0, bl0}; st[t][1] = (f32x4){bl1, bl1, bl1, bl1}; }
                    if (win && dlt == 8) {
#pragma unroll
                        for (int qb = 0; qb < 2; ++qb)
#pragma unroll
                            for (int t = 0; t < 2; ++t)
#pragma unroll
                                for (int r = 0; r < 4; ++r) st[t][qb][r] = (32 * C + 16 * t + 4 * fq + r > tl0 + 16 * qb) ? st[t][qb][r] : -1e30f;
                    }
                }
#pragma unroll
                for (int t = 0; t < 2; ++t)
#pragma unroll
                    for (int kc = 0; kc < 4; ++kc) { st[t][0] = mfma16(kf[t][kc], qf[0][kc], st[t][0]); st[t][1] = mfma16(kf[t][kc], qf[1][kc], st[t][1]); }
                v2i vlo[8], vhi[8];
#pragma unroll
                for (int dt = 0; dt < 8; ++dt) { const unsigned va = (unsigned)(size_t)lds + kbuf + vrow + (((unsigned)(dt << 5)) ^ vx);
                    if (C == 0) { TR_READ_ASM(vlo[dt], va, 0); TR_READ_ASM(vhi[dt], va, 4096); } else { TR_READ_ASM(vlo[dt], va, 8192); TR_READ_ASM(vhi[dt], va, 12288); } }
                int imx = __float_as_int(st[0][0][0]);
#pragma unroll
                for (int qb = 0; qb < 2; ++qb)
#pragma unroll
                    for (int t = 0; t < 2; ++t)
#pragma unroll
                        for (int r = 0; r < 4; ++r) imx = max(imx, __float_as_int(st[t][qb][r]));
                const bool first = (s == 0 || s == nslc) && C == 0;
                if (first || __any(imx > __float_as_int(RESCALE_THR))) {
#pragma unroll
                    for (int qb = 0; qb < 2; ++qb) {
                        float mx = fmaxf(fmaxf(fmaxf(st[0][qb][0], st[0][qb][1]), fmaxf(st[0][qb][2], st[0][qb][3])), fmaxf(fmaxf(st[1][qb][0], st[1][qb][1]), fmaxf(st[1][qb][2], st[1][qb][3])));
                        mx = fmaxf(mx, __shfl_xor(mx, 16)); mx = fmaxf(mx, __shfl_xor(mx, 32));
                        const float d = first ? mx : fmaxf(mx, 0.f), al = first ? 1.0f : ex2(-d);
                        m2[qb] += d; lacc[qb] = lacc[qb] * al;
#pragma unroll
                        for (int dt = 0; dt < 8; ++dt) oacc[qb][dt] = oacc[qb][dt] * al;
#pragma unroll
                        for (int t = 0; t < 2; ++t)
#pragma unroll
                            for (int r = 0; r < 4; ++r) st[t][qb][r] -= d;
                    }
                }
                bf16x8 pb[2];
#pragma unroll
                for (int qb = 0; qb < 2; ++qb) {
#pragma unroll
                    for (int t = 0; t < 2; ++t)
#pragma unroll
                        for (int r = 0; r < 4; ++r) st[t][qb][r] = ex2(st[t][qb][r]);
                    pb[qb] = pack8(st[0][qb], st[1][qb]);
                }
                asm volatile("s_waitcnt lgkmcnt(0)" : "+v"(vlo[0]), "+v"(vlo[1]), "+v"(vlo[2]), "+v"(vlo[3]), "+v"(vlo[4]), "+v"(vlo[5]), "+v"(vlo[6]), "+v"(vlo[7]),
                             "+v"(vhi[0]), "+v"(vhi[1]), "+v"(vhi[2]), "+v"(vhi[3]), "+v"(vhi[4]), "+v"(vhi[5]), "+v"(vhi[6]), "+v"(vhi[7]) :: "memory");
                __builtin_amdgcn_sched_barrier(0);
#pragma unroll
                for (int dt = 0; dt < 8; ++dt) { const bf16x8 vfr = __builtin_bit_cast(bf16x8, (u32x4){(unsigned)vlo[dt][0], (unsigned)vlo[dt][1], (unsigned)vhi[dt][0], (unsigned)vhi[dt][1]});
                    oacc[0][dt] = mfma16(vfr, pb[0], oacc[0][dt]); oacc[1][dt] = mfma16(vfr, pb[1], oacc[1][dt]); }
                lacc[0] = mfma16(ones8, pb[0], lacc[0]); lacc[1] = mfma16(ones8, pb[1], lacc[1]);
            }
            if (s == nslc - 1 || s == nsteps - 1) {
                u32x4 old[2][4];
#pragma unroll
                for (int qb = 0; qb < 2; ++qb)
#pragma unroll
                    for (int P = 0; P < 4; ++P) old[qb][P] = *(const u32x4*)((const char*)(Ou + (size_t)qb * 16 * 2048 + 32 * P) + ooffw);
                const float g0r = *(const float*)((const char*)(Gu + (win ? 2 : 1)) + goff), g1r = *(const float*)((const char*)(Gu + 16 * 24 + (win ? 2 : 1)) + goff);
                const float g0 = 1.0f / (1.0f + __expf(-g0r)), g1 = 1.0f / (1.0f + __expf(-g1r));
#pragma unroll
                for (int qb = 0; qb < 2; ++qb)
#pragma unroll
                    for (int P = 0; P < 4; ++P)
#pragma unroll
                        for (int r = 0; r < 4; ++r) { float a_ = oacc[qb][2 * P][r], b_ = oacc[qb][2 * P + 1][r]; swap16f(a_, b_); oacc[qb][2 * P][r] = a_; oacc[qb][2 * P + 1][r] = b_; }
                asm volatile("s_waitcnt vmcnt(0)" ::: "memory");
#pragma unroll
                for (int qb = 0; qb < 2; ++qb) {
                    const float gz = (qb ? g1 : g0) / lacc[qb][0];
                    char* Op = (char*)(Ou + (size_t)qb * 16 * 2048) + ooffw;
#pragma unroll
                    for (int P = 0; P < 4; ++P) {
                        const u32x4 o4 = old[qb][P]; const f32x4 a = oacc[qb][2 * P], b = oacc[qb][2 * P + 1];
                        u32x4 w; w.x = cvt_pk_bf16(bf2f(o4.x & 0xffffu) + a[0] * gz, bf2f(o4.x >> 16) + a[1] * gz); w.y = cvt_pk_bf16(bf2f(o4.y & 0xffffu) + a[2] * gz, bf2f(o4.y >> 16) + a[3] * gz);
                        w.z = cvt_pk_bf16(bf2f(o4.z & 0xffffu) + b[0] * gz, bf2f(o4.z >> 16) + b[1] * gz); w.w = cvt_pk_bf16(bf2f(o4.w & 0xffffu) + b[2] * gz, bf2f(o4.w >> 16) + b[3] * gz);
                        *(u32x4*)(Op + 64 * P) = w;
                        oacc[qb][2 * P] = (f32x4){0.f, 0.f, 0.f, 0.f}; oacc[qb][2 * P + 1] = (f32x4){0.f, 0.f, 0.f, 0.f};
                    }
                    m2[qb] = 0.f; lacc[qb] = (f32x4){0.f, 0.f, 0.f, 0.f};
                }
                asm volatile("s_waitcnt vmcnt(0)" ::: "memory");
            }
        }
        __syncthreads();
    }
#undef NSA_DMA
#undef NSA_TILE_J
}

#define XB_TMO      128
#define XB_XCNT(j)  (256  + 64 * (j))
#define XB_XSUB(j)  (1280 + 64 * (j))
#define XB_XGEN(j)  (2304 + 64 * (j))
#define XB_TOP      3328
#define XB_TOPGEN   3392
#define XCD_BAR_WORDS 3456
#define XB_SPIN_CAP (1u << 18)

__device__ __forceinline__ unsigned xb_ld(unsigned* p)              { return __hip_atomic_load(p, __ATOMIC_RELAXED, __HIP_MEMORY_SCOPE_AGENT); }
__device__ __forceinline__ unsigned xb_add(unsigned* p, unsigned v) { return __hip_atomic_fetch_add(p, v, __ATOMIC_RELAXED, __HIP_MEMORY_SCOPE_AGENT); }
__device__ __forceinline__ unsigned xb_xcc_id() { return (unsigned)__builtin_amdgcn_s_getreg((3 << 11) | 20) & 0xFu; }
#define XB_SPIN(cond, bar) do { unsigned _sp = 0; while (cond) { __builtin_amdgcn_s_sleep(1); \
    if ((++_sp & 255u) == 0u) { if (xb_ld(&(bar)[XB_TMO])) break; if (_sp > XB_SPIN_CAP) { atomicAdd(&(bar)[XB_TMO], 1u); break; } } } } while (0)

struct XcdBarrier {
    unsigned* bar; unsigned x;
    volatile LAS unsigned* st;
};

__device__ __forceinline__ XcdBarrier xcd_barrier_post(unsigned* bar, volatile LAS unsigned* st) {
    XcdBarrier b; b.bar = bar; b.x = xb_xcc_id(); b.st = st;
    if (threadIdx.x == 0) (void)xb_add(&bar[XB_XCNT(b.x)], 1u);
    return b;
}
__device__ __forceinline__ void xcd_barrier_complete(unsigned* bar, unsigned x, unsigned& nloc, unsigned& nx) {
    const unsigned G = gridDim.x * gridDim.y * gridDim.z;
    unsigned sum, cnt, mine, sp = 0u;
    for (;;) {
        sum = 0u; cnt = 0u; mine = 0u;
#pragma unroll
        for (unsigned j = 0; j < 16; ++j) { const unsigned c = xb_ld(&bar[XB_XCNT(j)]); sum += c; cnt += (c > 0u) ? 1u : 0u; mine = (j == x) ? c : mine; }
        if (sum == G) break;
        __builtin_amdgcn_s_sleep(1);
        if ((++sp & 255u) == 0u) { if (xb_ld(&bar[XB_TMO])) break; if (sp > XB_SPIN_CAP) { atomicAdd(&bar[XB_TMO], 1u); break; } }
    }
    nloc = mine > 0u ? mine : 1u; nx = cnt > 0u ? cnt : 1u;
}

__device__ __forceinline__ void xcd_barrier(const XcdBarrier& b) {
    asm volatile("s_waitcnt vmcnt(0)" ::: "memory");
    __syncthreads();
    if (threadIdx.x == 0) {
        unsigned* bar = b.bar;
        __builtin_amdgcn_s_waitcnt(0);
        unsigned nloc = b.st[0], nx = b.st[1];
        if (nloc == 0u) { xcd_barrier_complete(bar, b.x, nloc, nx); b.st[0] = nloc; b.st[1] = nx; }
        const unsigned old = xb_add(&bar[XB_XSUB(b.x)], 1u);
        const unsigned gen = old / nloc;
        if (old + 1u == (gen + 1u) * nloc) {
            __builtin_amdgcn_fence(__ATOMIC_RELEASE, "agent");
            asm volatile("s_waitcnt vmcnt(0)" ::: "memory");
            const unsigned og = xb_add(&bar[XB_TOP], 1u);
            const unsigned tg = og / nx;
            if (og + 1u == (tg + 1u) * nx) xb_add(&bar[XB_TOPGEN], 1u);
            else XB_SPIN(xb_ld(&bar[XB_TOPGEN]) == tg, bar);
            __builtin_amdgcn_fence(__ATOMIC_ACQUIRE, "agent");
            xb_add(&bar[XB_XGEN(b.x)], 1u);
            asm volatile("s_waitcnt vmcnt(0)" ::: "memory");
        } else {
            XB_SPIN(xb_ld(&bar[XB_XGEN(b.x)]) == gen, bar);
            __builtin_amdgcn_fence(__ATOMIC_ACQUIRE, "agent");
            asm volatile("s_waitcnt vmcnt(0)" ::: "memory");
        }
    }
    __syncthreads();
}

__global__ void __launch_bounds__(512, 2) mega(Params p) {
    extern __shared__ __attribute__((aligned(16))) unsigned char lds_raw[];
    LAS unsigned char* lds = (LAS unsigned char*)lds_raw;
    cg::grid_group grid = cg::this_grid();
    const int tid = threadIdx.x, lane = tid & 63, wave = __builtin_amdgcn_readfirstlane(tid >> 6);
    const int G = gridDim.x, gw = blockIdx.x * 8 + wave, NGW = G * 8;
    unsigned char* ws = p.ws;
    const int lo = p.ph_lo, hi = p.ph_hi;
    volatile LAS unsigned* bst = (volatile LAS unsigned*)(lds + LDS_BYTES - 64);
    if (tid < 2) bst[tid] = 0u;
    __syncthreads();
    const XcdBarrier xbar = xcd_barrier_post((unsigned*)(ws + WS_BAR), bst);
#define IN(k) (lo <= (k) && (k) < hi)
#define SEAM(k) do { if (IN(k) && IN((k) + 1)) { if (hi > 1000) grid.sync(); else xcd_barrier(xbar); } } while (0)
    if (IN(0)) { p0_prologue(p, lds, wave, lane, gw, NGW); }
    SEAM(0);
    if (IN(1)) {
        pg8::Gemm g{(const bf16_t*)((const unsigned char*)p.out + XB_OFF), (const bf16_t*)(ws + WS_WINT), MTOK, NIN, DM}; pg8::StaticOrder S; S.init(MTOK, NIN, G, (int)blockIdx.x, WGM_IN);
        EpiInProj E{(bf16_t*)(ws + WS_QA), (bf16_t*)(ws + WS_KV6), (bf16_t*)(ws + WS_QR), (bf16_t*)(ws + WS_KR), (bf16_t*)(ws + WS_VR), (bf16_t*)(ws + WS_GR), (float*)(ws + WS_GATES), (const float2*)(ws + WS_ROPE), p.lg[0], p.lg[1], p.lg[2], p.lg[3]};
        pg8::gemm_phase<EpiInProj, pg8::StaticOrder, GEMM_ALIGN, GEMM_SP2>(lds, g, S, E);
        { const int U = (MTOK / 256) * (NIN / 256), rounds = (U + G - 1) / G, nfull = U - (rounds - 1) * G, nidle = G - nfull;
          __syncthreads();
          if (nidle == 0) p1_tail_weights(p, lds, gw, NGW);
          else if ((int)blockIdx.x >= nfull) p1_tail_weights(p, lds, ((int)blockIdx.x - nfull) * 8 + wave, nidle * 8); }
    }
    SEAM(1);
    if (IN(2)) {
        for (int it = blockIdx.x; it < 256; it += G) mf_compress(p, it, lds, tid, wave, lane);
        mf_ret_u_items(p, (int)blockIdx.x, G, lds);
    }
    SEAM(2);
    if (IN(3)) { mf_ret_scan(p, blockIdx.x * 512 + opaque_tid(), G * 512); }
    SEAM(3);
    if (IN(4)) {
        for (int it = blockIdx.x; it < 256; it += G) { const int bgi = it & 3, pr = it >> 2;
            __syncthreads();
            for (int i = tid; i < 4 * 256; i += 512) { const int hh = i >> 8, rel = 191 - (i & 255);
                ((LAS float*)(lds + A_BIAS))[i] = rel >= 0 ? p.in[11][t5_bucket(rel) * 8 + 4 * (bgi & 1) + hh] * LOG2E : -1e30f; }
            mf_nsa(p, bgi, 127 - pr, lds, tid, wave, lane); mf_nsa(p, bgi, pr, lds, tid, wave, lane); }
        for (int it = blockIdx.x; it < 512; it += G) mf_ret_out(p, it, lds, tid, wave, lane);
    }
    SEAM(4);
    if (IN(5)) {
        pg8::Gemm g{(const bf16_t*)(ws + WS_H), (const bf16_t*)(ws + WS_WOUTT), MTOK, DM, DM}; pg8::StaticOrder S; S.init(MTOK, DM, G, (int)blockIdx.x, WGM_OUT);
        EpiBf16Plain E{(bf16_t*)(ws + WS_MIX), DM};
        pg8::gemm_phase<EpiBf16Plain, pg8::StaticOrder, GEMM_ALIGN, GEMM_SP2>(lds, g, S, E);
    }
    SEAM(5);
    if (IN(6)) { p6_resnorm(p, lds, NGW); }
    SEAM(6);
    if (IN(7)) {
        pg8::Gemm g{(const bf16_t*)(ws + WS_X1), (const bf16_t*)(ws + WS_WUPT), MTOK, DFF, DM}; pg8::StaticOrder S; S.init(MTOK, DFF, G, (int)blockIdx.x, WGM_UP);
        EpiRelu2 E{(bf16_t*)(ws + WS_UM), DFF};
        pg8::gemm_phase<EpiRelu2, pg8::StaticOrder, GEMM_ALIGN, GEMM_SP2>(lds, g, S, E);
    }
    SEAM(7);
    if (IN(8)) {
        pg8::Gemm g{(const bf16_t*)(ws + WS_UM), (const bf16_t*)(ws + WS_WDNT), MTOK, DM, DFF}; RevOrder S; S.init(MTOK, DM, G, (int)blockIdx.x, WGM_DN);
        EpiBf16Plain E{(bf16_t*)(ws + WS_Y), DM};
        pg8::gemm_phase<EpiBf16Plain, RevOrder, GEMM_ALIGN, GEMM_SP2>(lds, g, S, E);
    }
    SEAM(8);
    if (IN(9)) { p9_final(p, lds, NGW); }
#undef IN
#undef SEAM
}
}

extern "C" void kernel_launch(void* const* d_in, const int* in_sizes, int n_in, void* d_out, int out_size, void* d_ws, size_t ws_size, hipStream_t stream) {
    using namespace mk;
    static int grid = 0;
    if (n_in != 18 || out_size != MTOK * DM || ws_size < WS_NEED) { fprintf(stderr, "kernel_launch: unexpected shapes (n_in %d out %d ws %zu)\n", n_in, out_size, ws_size); return; }
    if (!grid) {
        int dev = 0, cus = 0, per_cu = 0;
        hipGetDevice(&dev); hipDeviceGetAttribute(&cus, hipDeviceAttributeMultiprocessorCount, dev);
        hipFuncSetAttribute((const void*)mega, hipFuncAttributeMaxDynamicSharedMemorySize, LDS_BYTES);
        hipOccupancyMaxActiveBlocksPerMultiprocessor(&per_cu, (const void*)mega, 512, LDS_BYTES);
        if (per_cu < 1) { fprintf(stderr, "kernel_launch: occupancy query says %d blocks per CU\n", per_cu); per_cu = 1; }
        grid = cus * per_cu;
        fprintf(stderr, "kernel_launch: grid %d (%d CUs x %d)\n", grid, cus, per_cu);
    }
    Params p{};
    for (int i = 0; i < 18; ++i) p.in[i] = (const float*)d_in[i];
    p.out = (float*)d_out; p.ws = (unsigned char*)d_ws;
    for (int h = 0; h < 4; ++h) p.lg[h] = (float)std::log(1.0 - std::exp2(-5.0 - (double)h));
    for (int i = 0; i < 128; ++i) p.invf[i] = (double)std::pow(10000.0f, -(float)(2 * i) / 256.0f);
    auto launch = [&](int lo, int hi) {
        Params q = p; q.ph_lo = lo; q.ph_hi = hi; void* args[] = {&q};
        hipError_t e = hipLaunchCooperativeKernel((const void*)mega, dim3(grid), dim3(512), args, LDS_BYTES, stream);
        if (e != hipSuccess) fprintf(stderr, "cooperative launch [%d,%d) failed: %s (grid %d)\n", lo, hi, hipGetErrorString(e), grid);
    };
    if (hipMemsetAsync(d_ws, 0, 65536, stream) != hipSuccess) fprintf(stderr, "kernel_launch: memset of the control words failed\n");
    launch(0, 10);
}
```

```cpp
#include <hip/hip_runtime.h>
#include <hip/hip_cooperative_groups.h>
#include <cstdio>
#include <cmath>
namespace pg8 {
#define PG8_LAS __attribute__((address_space(3)))
typedef unsigned short bf16_t;
typedef short bf16x8 __attribute__((ext_vector_type(8)));
typedef float f32x4 __attribute__((ext_vector_type(4)));
typedef unsigned u32x4 __attribute__((ext_vector_type(4)));
constexpr int BM = 256, BK = 64, HALF = 128, HTB = HALF * BK * 2  , STAGE_BYTES = 8 * HTB, NXCD = 8, WGM = 8;

__host__ __device__ __forceinline__ int lds_byte(int r, int c) { const int st = (r >> 4) * 2 + (c >> 5), rr = r & 15, cc = c & 31, ob = rr * 64 + cc * 2; return st * 1024 + (ob ^ (((ob >> 9) & 1) << 5)); }
__host__ __device__ __forceinline__ void stage_rc(int b, int& R, int& C) { const int st = b / 1024, sb = b % 1024, swz = sb ^ (((sb >> 9) & 1) << 5); R = (st >> 1) * 16 + swz / 64; C = (st & 1) * 32 + (swz % 64) / 2; }
__host__ __device__ __forceinline__ int perm32(int rho) { const int n = rho >> 4, i = rho & 15; return 8 * (i >> 2) + 4 * n + (i & 3); }

struct Unit { int pm, pn; };
struct Gemm { const bf16_t* A; const bf16_t* Bt; int M, N, K; };

struct StaticOrder {
    int nM, nN, nwg, G, c, wgm;
    __host__ __device__ void init(int M, int N, int G_, int c_, int wgm_ = WGM) { nM = M / BM; nN = N / BM; nwg = nM * nN; G = G_; c = c_; wgm = wgm_; }
    __host__ __device__ bool next(int i, Unit& u) const {
        const long L = (long)i * G + c; if (L >= nwg) return false;
        int wgid = (int)L; { const int q = nwg / NXCD, r = nwg % NXCD, xcd = wgid % NXCD, off = wgid / NXCD; wgid = (xcd < r ? xcd * (q + 1) : r * (q + 1) + (xcd - r) * q) + off; }
        const int nig = wgm * nN, gid = wgid / nig, fm = gid * wgm, gsz = (nM - fm) < wgm ? (nM - fm) : wgm;
        u.pm = fm + ((wgid % nig) % gsz); u.pn = (wgid % nig) / gsz; return true;
    }
    __device__ __forceinline__ void a_ready(const Unit&) const {}
    __device__ __forceinline__ void done(const Unit&) const {}
};
typedef float f32x2 __attribute__((ext_vector_type(2)));
typedef __bf16 bf16x2_nat __attribute__((ext_vector_type(2)));
__device__ __forceinline__ unsigned cvt_pk_bf16(float lo, float hi) { const f32x2 v = {lo, hi}; return __builtin_bit_cast(unsigned, __builtin_convertvector(v, bf16x2_nat)); }
struct EpiF32 {
    static constexpr bool PERM = false, AFTER_DRAIN = false;
    float* C; int ldc; const float* bias;
    __device__ __forceinline__ void operator()(const f32x4 (&acc)[2][2][4][2], const Unit& u, int wr, int wc, int fr, int fq) const {
        const int row0 = u.pm * BM + wr * 64 + fr, col0 = u.pn * BM + wc * 32 + 4 * fq;
        f32x4 bv[2][2];
#pragma unroll
        for (int bj = 0; bj < 2; ++bj)
#pragma unroll
            for (int n = 0; n < 2; ++n) bv[bj][n] = bias ? *(const f32x4*)(bias + col0 + bj * HALF + n * 16) : (f32x4){0.f, 0.f, 0.f, 0.f};
#pragma unroll
        for (int ai = 0; ai < 2; ++ai)
#pragma unroll
            for (int m = 0; m < 4; ++m) { float* rowp = C + (size_t)(row0 + ai * HALF + m * 16) * ldc + col0;
#pragma unroll
                for (int bj = 0; bj < 2; ++bj)
#pragma unroll
                    for (int n = 0; n < 2; ++n) *(f32x4*)(rowp + bj * HALF + n * 16) = acc[ai][bj][m][n] + bv[bj][n]; }
    }
};
template <class Epi, class Sched, bool ALIGN_EPI = false, bool SP2 = false>
__device__ __forceinline__ void gemm_phase(PG8_LAS unsigned char* lds, const Gemm g, const Sched& S, const Epi& E) {
    int tid_o = threadIdx.x; asm volatile("" : "+v"(tid_o));
    const int tid = tid_o, wid = __builtin_amdgcn_readfirstlane(tid >> 6), lane = tid & 63, wr = wid >> 2, wc = wid & 3, fr = lane & 15, fq = lane >> 4;
    const int K = g.K, nt = K / BK;
    unsigned voffA[2], voffB[2];
#pragma unroll
    for (int i = 0; i < 2; ++i) { int R, C; stage_rc(tid * 16 + i * 8192, R, C); const int Rb = Epi::PERM ? ((R & ~31) + perm32(R & 31)) : R;
        voffA[i] = (unsigned)(R * K + C) * 2u; voffB[i] = (unsigned)(Rb * K + C) * 2u; }
    const size_t kstep = (size_t)(BK * 2);
    const size_t hstep = (size_t)HALF * K * 2;
    const size_t tstep = 2 * hstep;
    const unsigned ldsw = (unsigned)wid * 1024u;
    const int aoff = lds_byte(wr * 64 + fr, fq * 8), boff = lds_byte(wc * 32 + fr, fq * 8);
#define PG8_SA(b, h) (((b) * 2 + (h)) * HTB)
#define PG8_SB(b, h) ((4 + (b) * 2 + (h)) * HTB)
#define PG8_STAGE(bufoff, gbase, voff) do { _Pragma("unroll") for (int _i = 0; _i < 2; ++_i) \
        __builtin_amdgcn_global_load_lds((const unsigned*)((const char*)(gbase) + (voff)[_i]), (PG8_LAS unsigned*)(lds + (bufoff) + ldsw + _i * 8192), 16, 0, 0); } while (0)
#define PG8_LDA(dst, b, h) do { _Pragma("unroll") for (int m = 0; m < 4; ++m) _Pragma("unroll") for (int k = 0; k < 2; ++k) dst[m][k] = *(const PG8_LAS bf16x8*)(lds + PG8_SA(b, h) + aoff + m * 2048 + k * 1024); } while (0)
#define PG8_LDB(dst, b, h) do { _Pragma("unroll") for (int n = 0; n < 2; ++n) _Pragma("unroll") for (int k = 0; k < 2; ++k) dst[n][k] = *(const PG8_LAS bf16x8*)(lds + PG8_SB(b, h) + boff + n * 2048 + k * 1024); } while (0)
#define PG8_MMA(ai, bj, At, Bt) do { __builtin_amdgcn_s_setprio(1); _Pragma("unroll") for (int m = 0; m < 4; ++m) _Pragma("unroll") for (int n = 0; n < 2; ++n) _Pragma("unroll") for (int k = 0; k < 2; ++k) \
        acc[ai][bj][m][n] = __builtin_amdgcn_mfma_f32_16x16x32_bf16(Bt[n][k], At[m][k], acc[ai][bj][m][n], 0, 0, 0); __builtin_amdgcn_s_setprio(0); } while (0)
#define PG8_WAIT_V(n) asm volatile("s_waitcnt vmcnt(" #n ")" ::: "memory")
#define PG8_WAIT_L(n) asm volatile("s_waitcnt lgkmcnt(" #n ")" ::: "memory")
#define PG8_BAR __builtin_amdgcn_s_barrier()
#define PG8_SCHED __builtin_amdgcn_sched_barrier(0)
    Unit cur, nxt; int ui = 0;
    if (!S.next(0, cur)) return;
    f32x4 acc[2][2][4][2];
#pragma unroll
    for (int a = 0; a < 2; ++a)
#pragma unroll
        for (int b = 0; b < 2; ++b)
#pragma unroll
            for (int m = 0; m < 4; ++m)
#pragma unroll
                for (int n = 0; n < 2; ++n) acc[a][b][m][n] = (f32x4){0.f, 0.f, 0.f, 0.f};
    bf16x8 At[4][2], B0[2][2], B1[2][2];
    const char* cA = (const char*)g.A + (size_t)cur.pm * tstep; const char* cB = (const char*)g.Bt + (size_t)cur.pn * tstep;
    S.a_ready(cur);
    if constexpr (SP2) {
        PG8_STAGE(PG8_SB(0, 0), cB, voffB); PG8_STAGE(PG8_SB(0, 1), cB + hstep, voffB); PG8_STAGE(PG8_SA(0, 0), cA, voffA); PG8_STAGE(PG8_SA(0, 1), cA + hstep, voffA);
        if (wr == 1) PG8_BAR;
        PG8_WAIT_V(2); PG8_BAR;
        PG8_STAGE(PG8_SB(1, 0), cB + kstep, voffB); PG8_STAGE(PG8_SA(1, 0), cA + kstep, voffA); PG8_STAGE(PG8_SB(1, 1), cB + hstep + kstep, voffB);
        PG8_WAIT_V(6); PG8_BAR;
    } else {
        PG8_STAGE(PG8_SB(0, 0), cB, voffB); PG8_STAGE(PG8_SA(0, 0), cA, voffA); PG8_STAGE(PG8_SB(0, 1), cB + hstep, voffB); PG8_STAGE(PG8_SA(0, 1), cA + hstep, voffA);
        if (wr == 1) PG8_BAR;
        PG8_WAIT_V(4); PG8_BAR;
        PG8_STAGE(PG8_SB(1, 0), cB + kstep, voffB); PG8_STAGE(PG8_SA(1, 0), cA + kstep, voffA); PG8_STAGE(PG8_SB(1, 1), cB + hstep + kstep, voffB);
        PG8_WAIT_V(6); PG8_BAR;
    }
    for (;;) {
        const bool has_next = S.next(ui + 1, nxt);
        const char* nA = has_next ? (const char*)g.A + (size_t)nxt.pm * tstep : cA; const char* nB = has_next ? (const char*)g.Bt + (size_t)nxt.pn * tstep : cB;
        for (int t = 0; t < nt; t += 2) {
            const bool last = (t == nt - 2);
            const char* a1 = cA + (size_t)(t + 1) * kstep;
            const char* a2 = last ? nA : cA + (size_t)(t + 2) * kstep; const char* b2 = last ? nB : cB + (size_t)(t + 2) * kstep;
            const char* a3 = a2 + kstep; const char* b3 = b2 + kstep;
            if (last && has_next) S.a_ready(nxt);
            if constexpr (SP2) {
            PG8_LDB(B0, 0, 0); PG8_LDB(B1, 0, 1); PG8_SCHED; PG8_LDA(At, 0, 0); PG8_STAGE(PG8_SA(1, 1), a1 + hstep, voffA);
            PG8_WAIT_V(8); PG8_WAIT_L(0); PG8_BAR; PG8_MMA(0, 0, At, B0); PG8_MMA(0, 1, At, B1); PG8_BAR; PG8_SCHED;
            PG8_LDA(At, 0, 1); PG8_STAGE(PG8_SB(0, 0), b2, voffB); PG8_STAGE(PG8_SB(0, 1), b2 + hstep, voffB); PG8_STAGE(PG8_SA(0, 0), a2, voffA);
            PG8_WAIT_V(8); PG8_WAIT_L(0); PG8_BAR; PG8_MMA(1, 0, At, B0); PG8_MMA(1, 1, At, B1); PG8_BAR; PG8_SCHED;
            PG8_LDB(B0, 1, 0); PG8_LDB(B1, 1, 1); PG8_SCHED; PG8_LDA(At, 1, 0); PG8_STAGE(PG8_SA(0, 1), a2 + hstep, voffA);
            PG8_WAIT_V(8); PG8_WAIT_L(0); PG8_BAR; PG8_MMA(0, 0, At, B0); PG8_MMA(0, 1, At, B1); PG8_BAR; PG8_SCHED;
            PG8_LDA(At, 1, 1); PG8_STAGE(PG8_SB(1, 0), b3, voffB); PG8_STAGE(PG8_SB(1, 1), b3 + hstep, voffB); PG8_STAGE(PG8_SA(1, 0), a3, voffA);
            PG8_WAIT_V(8); PG8_WAIT_L(0); PG8_BAR; PG8_MMA(1, 0, At, B0); PG8_MMA(1, 1, At, B1); PG8_BAR; PG8_SCHED;
            } else {
            PG8_LDB(B0, 0, 0); PG8_SCHED; PG8_LDA(At, 0, 0); PG8_STAGE(PG8_SA(1, 1), a1 + hstep, voffA);
            PG8_WAIT_L(8); PG8_BAR; PG8_WAIT_L(0); PG8_MMA(0, 0, At, B0); PG8_BAR; PG8_SCHED;
            PG8_LDB(B1, 0, 1); PG8_STAGE(PG8_SB(0, 0), b2, voffB);
            PG8_BAR; PG8_WAIT_L(0); PG8_MMA(0, 1, At, B1); PG8_BAR;
            PG8_LDA(At, 0, 1); PG8_STAGE(PG8_SA(0, 0), a2, voffA);
            PG8_BAR; PG8_WAIT_L(0); PG8_MMA(1, 0, At, B0); PG8_BAR; PG8_SCHED;
            PG8_STAGE(PG8_SB(0, 1), b2 + hstep, voffB);
            PG8_WAIT_V(6); PG8_BAR; PG8_MMA(1, 1, At, B1); PG8_BAR;
            PG8_LDB(B0, 1, 0); PG8_SCHED; PG8_LDA(At, 1, 0); PG8_STAGE(PG8_SA(0, 1), a2 + hstep, voffA);
            PG8_WAIT_L(8); PG8_BAR; PG8_WAIT_L(0); PG8_MMA(0, 0, At, B0); PG8_BAR; PG8_SCHED;
            PG8_LDB(B1, 1, 1); PG8_STAGE(PG8_SB(1, 0), b3, voffB);
            PG8_BAR; PG8_WAIT_L(0); PG8_MMA(0, 1, At, B1); PG8_BAR;
            PG8_LDA(At, 1, 1); PG8_STAGE(PG8_SA(1, 0), a3, voffA);
            PG8_BAR; PG8_WAIT_L(0); PG8_MMA(1, 0, At, B0); PG8_BAR; PG8_SCHED;
            PG8_STAGE(PG8_SB(1, 1), b3 + hstep, voffB);
            PG8_WAIT_V(6); PG8_BAR; PG8_MMA(1, 1, At, B1); PG8_BAR;
            }
        }
        if constexpr (ALIGN_EPI) { if (wr == 0) PG8_BAR; }
        if constexpr (!Epi::AFTER_DRAIN) { E(acc, cur, wr, wc, fr, fq); S.done(cur); }
        if (!has_next) break;
#pragma unroll
        for (int a = 0; a < 2; ++a)
#pragma unroll
            for (int b = 0; b < 2; ++b)
#pragma unroll
                for (int m = 0; m < 4; ++m)
#pragma unroll
                    for (int n = 0; n < 2; ++n) acc[a][b][m][n] = (f32x4){0.f, 0.f, 0.f, 0.f};
        cur = nxt; cA = nA; cB = nB; ++ui;
        if constexpr (ALIGN_EPI) { if (wr == 1) PG8_BAR; }
    }
    PG8_WAIT_V(0);
    if constexpr (!ALIGN_EPI) { if (wr == 0) PG8_BAR; }
    PG8_BAR;
    if constexpr (Epi::AFTER_DRAIN) { E.fused(acc, cur, wr, wc, fr, fq, lds, wid, lane); S.done(cur); }
#undef PG8_SA
#undef PG8_SB
#undef PG8_STAGE
#undef PG8_LDA
#undef PG8_LDB
#undef PG8_MMA
#undef PG8_WAIT_V
#undef PG8_WAIT_L
#undef PG8_BAR
#undef PG8_SCHED
}
}
constexpr int T_DN_TAIL = 2696;

namespace mk {
namespace cg = cooperative_groups;
using pg8::bf16_t; using pg8::bf16x8; using pg8::f32x4; using pg8::u32x4; using pg8::cvt_pk_bf16;
#define LAS __attribute__((address_space(3)))
constexpr int BATCH = 2, SEQ = 8192, DM = 2048, MTOK = BATCH * SEQ, DFF = 8192;
constexpr int DIN = 6680, NIN = 6912;
constexpr int C_GATE = 2560, C_QR = 2584;
constexpr int NCMP = 511, NCMPP = 512;
constexpr float NORM_EPS = 1e-6f, GN_EPS = 1e-6f, NEGV = -1e30f;
constexpr size_t MiB = 1u << 20;
constexpr size_t WS_BAR = 16384;
constexpr size_t WS_RSTD0 = 256 * 1024;
constexpr size_t WS_RSTD2 = 384 * 1024;
constexpr size_t XB_OFF = 64 * MiB;
constexpr size_t WS_CB = 1 * MiB - 8192;
constexpr size_t WS_CW2T = 1 * MiB + 4096;
constexpr size_t WS_CW1T = 2 * MiB;
constexpr size_t WS_KC = 4 * MiB;
constexpr size_t WS_VCT = 5 * MiB;
constexpr size_t WS_GATES = 6 * MiB;
constexpr size_t WS_ROPE = 8 * MiB;
constexpr size_t WS_WDNT = 16 * MiB;
constexpr size_t WS_WINT = 48 * MiB;
constexpr size_t WS_WOUTT = 76 * MiB;
constexpr size_t WS_WUPT = 84 * MiB;
constexpr size_t WS_H = 116 * MiB;
constexpr size_t WS_QA = 180 * MiB;
constexpr size_t WS_KV6 = 212 * MiB;
constexpr size_t WS_QR = 260 * MiB;
constexpr size_t WS_KR = 292 * MiB;
constexpr size_t WS_VR = 324 * MiB;
constexpr size_t WS_GR = 356 * MiB;
constexpr size_t WS_MIX = 180 * MiB;
constexpr size_t WS_UM = 180 * MiB;
constexpr size_t WS_Y = 48 * MiB;
constexpr size_t WS_RT = 436 * MiB;
constexpr size_t WS_X1 = 436 * MiB;
constexpr size_t WS_NEED = 500 * MiB;
#ifndef GEMM_SP2
#define GEMM_SP2 true
#endif
#ifndef GEMM_ALIGN
#define GEMM_ALIGN true
#endif
#ifndef WGM_IN
#define WGM_IN 4
#endif
#ifndef WGM_OUT
#define WGM_OUT 4
#endif
#ifndef WGM_UP
#define WGM_UP 4
#endif
#ifndef WGM_DN
#define WGM_DN 4
#endif
constexpr int LDS_BYTES = 147456;

struct Params { const float* in[18]; float* out; unsigned char* ws; int ph_lo, ph_hi; float lg[4]; double invf[128]; };

__device__ __forceinline__ float bf2f(unsigned v) { return __uint_as_float(v << 16); }
typedef unsigned u32x2_t __attribute__((ext_vector_type(2)));
__device__ __forceinline__ u32x4 ldnt16(const void* p) { return __builtin_nontemporal_load((const u32x4*)p); }
__device__ __forceinline__ uint2 ldnt8(const void* p) { const u32x2_t t = __builtin_nontemporal_load((const u32x2_t*)p); return make_uint2(t[0], t[1]); }
__device__ __forceinline__ float wave_sum(float v) {
#pragma unroll
    for (int o = 1; o < 64; o <<= 1) v += __shfl_xor(v, o);
    return v;
}
__device__ __forceinline__ float wave_max(float v) {
#pragma unroll
    for (int o = 1; o < 64; o <<= 1) v = fmaxf(v, __shfl_xor(v, o));
    return v;
}
#define LDS_WAIT() asm volatile("s_waitcnt lgkmcnt(0)" ::: "memory")
__device__ __forceinline__ int opaque_tid() { int x = threadIdx.x; asm volatile("" : "+v"(x)); return x; }

__device__ __forceinline__ int win_src(int n) { return n < 2560 ? n : (n < 6656 ? n + 24 : (n < 6680 ? n - 4096 : -1)); }
template <bool WIN, bool GAIN = false>
__device__ __forceinline__ void transpose_pair(const float* W, int ld, int K, int Nout, bf16_t* WT, LAS float* scr, int q, int lane, const float* G = nullptr) {
    const int nblk = Nout / 32, item = 2 * q, kb = item / nblk, nb = item % nblk, k0 = 64 * kb, n0 = 32 * nb;
    const int np0 = n0 + (lane & 31), np1 = np0 + 32, src0 = WIN ? win_src(np0) : np0, src1 = WIN ? win_src(np1) : np1;
    float va[32], vb[32];
#pragma unroll
    for (int i = 0; i < 32; ++i) { const int kk = 2 * i + (lane >> 5); const float* rowp = W + (size_t)(k0 + kk) * ld;
        va[i] = src0 >= 0 ? __builtin_nontemporal_load(rowp + src0) : 0.f; vb[i] = src1 >= 0 ? __builtin_nontemporal_load(rowp + src1) : 0.f;
        if (GAIN) { const float gk = G[k0 + kk]; va[i] *= gk; vb[i] *= gk; } }
    const int c = lane & 7;
#pragma unroll
    for (int half = 0; half < 2; ++half) {
#pragma unroll
        for (int i = 0; i < 32; ++i) { const int kk = 2 * i + (lane >> 5); scr[kk * 33 + (lane & 31)] = half ? vb[i] : va[i]; }
        LDS_WAIT();
#pragma unroll
        for (int j = 0; j < 4; ++j) { const int n = (lane >> 3) + 8 * j; const LAS float* sp = scr + (8 * c) * 33 + n;
            u32x4 o; o.x = cvt_pk_bf16(sp[0 * 33], sp[1 * 33]); o.y = cvt_pk_bf16(sp[2 * 33], sp[3 * 33]); o.z = cvt_pk_bf16(sp[4 * 33], sp[5 * 33]); o.w = cvt_pk_bf16(sp[6 * 33], sp[7 * 33]);
            *(u32x4*)(WT + (size_t)(n0 + 32 * half + n) * K + k0 + 8 * c) = o; }
        LDS_WAIT();
    }
}
__device__ __forceinline__ void sincos_d(double r, double& s, double& c) {
    const double r2 = r * r;
    double ts = 1.0, tc = 1.0, term_s = 1.0, term_c = 1.0;
#pragma unroll
    for (int k = 1; k <= 13; ++k) {
        constexpr double one = 1.0;
        const double ic = -one / (double)((2 * k - 1) * (2 * k)), is = -one / (double)((2 * k) * (2 * k + 1));
        term_c *= r2 * ic; tc += term_c;
        term_s *= r2 * is; ts += term_s;
    }
    s = r * ts; c = tc;
}
__device__ __forceinline__ void p0_prologue(const Params& p, LAS unsigned char* lds, int wave_, int lane_, int gw_, int NGW) {
    const int tid = opaque_tid(), lane = tid & 63, wave = __builtin_amdgcn_readfirstlane(tid >> 6), gw = blockIdx.x * 8 + wave; (void)wave_; (void)lane_; (void)gw_;
    unsigned char* ws = p.ws;
    LAS float* scr = (LAS float*)(lds + wave * 16384);
    constexpr int T_IN = (DM / 64) * (NIN / 32) / 2, T_OUT = (DM / 64) * (DM / 32) / 2, T_UP = (DM / 64) * (DFF / 32) / 2, T_DN = (DFF / 64) * (DM / 32) / 2, T_C1 = (4096 / 64) * (128 / 32) / 2, T_C2 = (128 / 64) * (128 / 32) / 2;
    constexpr int T_DN0 = T_DN - T_DN_TAIL;
    constexpr int NT = T_IN + T_OUT + T_UP + T_DN0 + 2 * T_C1 + 2 * T_C2;
    for (int it = gw; it < NT; it += NGW) {
        int r = it;
        if (r < T_IN) { transpose_pair<true, true>(p.in[2], DIN, DM, NIN, (bf16_t*)(ws + WS_WINT), scr, r, lane, p.in[1]); continue; } r -= T_IN;
        if (r < T_OUT) { transpose_pair<false>(p.in[12], DM, DM, DM, (bf16_t*)(ws + WS_WOUTT), scr, r, lane); continue; } r -= T_OUT;
        if (r < T_UP) { transpose_pair<false, true>(p.in[15], DFF, DM, DFF, (bf16_t*)(ws + WS_WUPT), scr, r, lane, p.in[14]); continue; } r -= T_UP;
        if (r < T_DN0) { transpose_pair<false>(p.in[16], DM, DFF, DM, (bf16_t*)(ws + WS_WDNT), scr, r, lane); continue; } r -= T_DN0;
        if (r < T_C1) { transpose_pair<false>(p.in[4], 128, 4096, 128, (bf16_t*)(ws + WS_CW1T), scr, r, lane); continue; } r -= T_C1;
        if (r < T_C1) { transpose_pair<false>(p.in[8], 128, 4096, 128, (bf16_t*)(ws + WS_CW1T) + 128 * 4096, scr, r, lane); continue; } r -= T_C1;
        if (r < T_C2) { transpose_pair<false>(p.in[6], 128, 128, 128, (bf16_t*)(ws + WS_CW2T), scr, r, lane); continue; } r -= T_C2;
        transpose_pair<false>(p.in[10], 128, 128, 128, (bf16_t*)(ws + WS_CW2T) + 128 * 128, scr, r, lane);
    }
    const float* x = p.in[0]; bf16_t* XB = (bf16_t*)((unsigned char*)p.out + XB_OFF); float* RS0 = (float*)(ws + WS_RSTD0);
    {
        for (int row0 = gw; row0 < MTOK; row0 += 4 * NGW) {
            float4 v[4][8];
#pragma unroll
            for (int r = 0; r < 4; ++r) { const int row = row0 + r * NGW;
                if (row < MTOK) {
#pragma unroll
                    for (int j = 0; j < 8; ++j) { const f32x4 t_ = __builtin_nontemporal_load((const f32x4*)(x + (size_t)row * DM) + lane + 64 * j); v[r][j] = make_float4(t_[0], t_[1], t_[2], t_[3]); }
                } }
#pragma unroll
            for (int r = 0; r < 4; ++r) { const int row = row0 + r * NGW;
                if (row < MTOK) {
                    float s = 0.f;
#pragma unroll
                    for (int j = 0; j < 8; ++j) s += v[r][j].x * v[r][j].x + v[r][j].y * v[r][j].y + v[r][j].z * v[r][j].z + v[r][j].w * v[r][j].w;
                    const float rstd = rsqrtf(wave_sum(s) * (1.0f / DM) + NORM_EPS);
                    if (lane == 0) RS0[row] = 1.0f / rstd;
                    uint2* o = (uint2*)(XB + (size_t)row * DM) + lane;
#pragma unroll
                    for (int j = 0; j < 8; ++j) { uint2 w; w.x = cvt_pk_bf16(v[r][j].x * rstd, v[r][j].y * rstd); w.y = cvt_pk_bf16(v[r][j].z * rstd, v[r][j].w * rstd); o[64 * j] = w; }
                } }
        }
    }
    float2* tab = (float2*)(ws + WS_ROPE);
    for (int idx = gw * 64 + lane; idx < SEQ * 128; idx += NGW * 64) {
        const int pos = idx >> 7, i = idx & 127;
        const float angf = (float)pos * (float)p.invf[i];
        const double ang = (double)angf, twopi = 6.283185307179586476925286766559;
        const double k = rint(ang * 0.15915494309189533576888376337251), r = ang - k * twopi;
        double s, c; sincos_d(r, s, c);
        tab[idx] = make_float2((float)c, (float)s);
    }
    float* CB = (float*)(ws + WS_CB);
    for (int o = gw; o < 8 * 256; o += NGW) {
        const int sl = o >> 8, oc = o & 255, kind = oc >> 7, c = oc & 127;
        const float* pe = kind ? p.in[7] : p.in[3]; const float* w1 = kind ? p.in[8] : p.in[4]; const float* b1 = kind ? p.in[9] : p.in[5];
        float s = 0.f;
#pragma unroll
        for (int i = 0; i < 8; ++i) { const int k = 512 * sl + 64 * i + lane; s += pe[k] * w1[(size_t)k * 128 + c]; }
        s = wave_sum(s);
        if (lane == 0) CB[o] = s + (sl == 0 ? b1[c] : 0.f);
    }
}

__device__ __forceinline__ void p1_tail_weights(const Params& p, LAS unsigned char* lds, int tw, int ntw) {
    const int tid = opaque_tid(), lane = tid & 63, wave = __builtin_amdgcn_readfirstlane(tid >> 6);
    LAS float* scr = (LAS float*)(lds + wave * 16384);
    constexpr int T_DN = (DFF / 64) * (DM / 32) / 2;
    for (int it = T_DN - T_DN_TAIL + tw; it < T_DN; it += ntw) transpose_pair<false>(p.in[16], DM, DFF, DM, (bf16_t*)(p.ws + WS_WDNT), scr, it, lane);
}

struct EpiInProj {
    static constexpr bool PERM = true, AFTER_DRAIN = false;
    bf16_t *QA, *KV6, *QR, *KR, *VR, *GR; float* GATES; const float2* rope; float lg0, lg1, lg2, lg3;
    __device__ __forceinline__ void operator()(const f32x4 (&acc)[2][2][4][2], const pg8::Unit& u, int wr, int wc, int fr, int fq) const {
        const int pn = u.pn, row0 = u.pm * 256 + wr * 64 + fr, cl0 = wc * 32 + 8 * fq;
        if (pn < 10 || (pn >= 18 && pn < 26)) {
            bf16_t* base; int ld;
            if (pn < 4) { base = QA + pn * 256; ld = 1024; }
            else if (pn < 10) { base = KV6 + (size_t)(pn - 4) * MTOK * 256; ld = 256; }
            else if (pn < 22) { base = VR + (pn - 18) * 256; ld = 1024; }
            else { base = GR + (pn - 22) * 256; ld = 1024; }
#pragma unroll
            for (int ai = 0; ai < 2; ++ai)
#pragma unroll
                for (int m = 0; m < 4; ++m) { bf16_t* rowp = base + (size_t)(row0 + ai * 128 + m * 16) * ld + cl0;
#pragma unroll
                    for (int bj = 0; bj < 2; ++bj) { f32x4 v0 = acc[ai][bj][m][0], v1 = acc[ai][bj][m][1];
                        u32x4 w; w.x = cvt_pk_bf16(v0[0], v0[1]); w.y = cvt_pk_bf16(v0[2], v0[3]); w.z = cvt_pk_bf16(v1[0], v1[1]); w.w = cvt_pk_bf16(v1[2], v1[3]);
                        *(u32x4*)(rowp + bj * 128) = w; } }
        } else if (pn < 18) {
            const bool isk = pn >= 14; const int hh = (pn - 10) & 3; bf16_t* base = (isk ? KR : QR) + hh * 256;
            const float lgh = hh == 0 ? lg0 : (hh == 1 ? lg1 : (hh == 2 ? lg2 : lg3));
#pragma unroll
            for (int ai = 0; ai < 2; ++ai)
#pragma unroll
                for (int m = 0; m < 4; ++m) { const int row = row0 + ai * 128 + m * 16, pos = row & (SEQ - 1);
                    const float ef = (float)((pos & 127) + 1) * lgh; const float sc = isk ? 0.0625f * __expf(-ef) : __expf(ef);
                    const float4* t4 = (const float4*)(rope + (size_t)pos * 128 + cl0);
                    const float4 ta = t4[0], tb = t4[1], tc = t4[2], td = t4[3];
                    const f32x4 a0 = acc[ai][0][m][0], a1 = acc[ai][0][m][1], b0 = acc[ai][1][m][0], b1 = acc[ai][1][m][1];
                    float o1[8], o2[8];
                    o1[0] = a0[0] * ta.x - b0[0] * ta.y; o2[0] = b0[0] * ta.x + a0[0] * ta.y;
                    o1[1] = a0[1] * ta.z - b0[1] * ta.w; o2[1] = b0[1] * ta.z + a0[1] * ta.w;
                    o1[2] = a0[2] * tb.x - b0[2] * tb.y; o2[2] = b0[2] * tb.x + a0[2] * tb.y;
                    o1[3] = a0[3] * tb.z - b0[3] * tb.w; o2[3] = b0[3] * tb.z + a0[3] * tb.w;
                    o1[4] = a1[0] * tc.x - b1[0] * tc.y; o2[4] = b1[0] * tc.x + a1[0] * tc.y;
                    o1[5] = a1[1] * tc.z - b1[1] * tc.w; o2[5] = b1[1] * tc.z + a1[1] * tc.w;
                    o1[6] = a1[2] * td.x - b1[2] * td.y; o2[6] = b1[2] * td.x + a1[2] * td.y;
                    o1[7] = a1[3] * td.z - b1[3] * td.w; o2[7] = b1[3] * td.z + a1[3] * td.w;
                    u32x4 w1, w2;
                    w1.x = cvt_pk_bf16(o1[0] * sc, o1[1] * sc); w1.y = cvt_pk_bf16(o1[2] * sc, o1[3] * sc); w1.z = cvt_pk_bf16(o1[4] * sc, o1[5] * sc); w1.w = cvt_pk_bf16(o1[6] * sc, o1[7] * sc);
                    w2.x = cvt_pk_bf16(o2[0] * sc, o2[1] * sc); w2.y = cvt_pk_bf16(o2[2] * sc, o2[3] * sc); w2.z = cvt_pk_bf16(o2[4] * sc, o2[5] * sc); w2.w = cvt_pk_bf16(o2[6] * sc, o2[7] * sc);
                    bf16_t* rowp = base + (size_t)row * 1024 + cl0;
                    *(u32x4*)(rowp) = w1; *(u32x4*)(rowp + 128) = w2; }
        } else {
            if (wc == 0 && fq < 3) {
#pragma unroll
                for (int ai = 0; ai < 2; ++ai)
#pragma unroll
                    for (int m = 0; m < 4; ++m) { const int row = row0 + ai * 128 + m * 16; float* gp = GATES + (size_t)row * 24 + 8 * fq;
                        f32x4 v0 = acc[ai][0][m][0], v1 = acc[ai][0][m][1];
                        *(f32x4*)gp = v0; *(f32x4*)(gp + 4) = v1; }
            }
        }
    }
};
struct RevOrder : pg8::StaticOrder {
    __device__ bool next(int i, pg8::Unit& u) const { const bool ok = pg8::StaticOrder::next(i, u); if (ok) u.pm = nM - 1 - u.pm; return ok; }
};
struct EpiBf16Plain {
    static constexpr bool PERM = true, AFTER_DRAIN = false;
    bf16_t* O; int ldc;
    __device__ __forceinline__ void operator()(const f32x4 (&acc)[2][2][4][2], const pg8::Unit& u, int wr, int wc, int fr, int fq) const {
        const int row0 = u.pm * 256 + wr * 64 + fr, col0 = u.pn * 256 + wc * 32 + 8 * fq;
#pragma unroll
        for (int ai = 0; ai < 2; ++ai)
#pragma unroll
            for (int m = 0; m < 4; ++m) { bf16_t* rowp = O + (size_t)(row0 + ai * 128 + m * 16) * ldc + col0;
#pragma unroll
                for (int bj = 0; bj < 2; ++bj) { const f32x4 v0 = acc[ai][bj][m][0], v1 = acc[ai][bj][m][1];
                    u32x4 w; w.x = cvt_pk_bf16(v0[0], v0[1]); w.y = cvt_pk_bf16(v0[2], v0[3]); w.z = cvt_pk_bf16(v1[0], v1[1]); w.w = cvt_pk_bf16(v1[2], v1[3]);
                    *(u32x4*)(rowp + bj * 128) = w; } }
    }
};
struct EpiRelu2 {
    static constexpr bool PERM = true, AFTER_DRAIN = false;
    bf16_t* O; int ldc;
    __device__ __forceinline__ void operator()(const f32x4 (&acc)[2][2][4][2], const pg8::Unit& u, int wr, int wc, int fr, int fq) const {
        const int row0 = u.pm * 256 + wr * 64 + fr, col0 = u.pn * 256 + wc * 32 + 8 * fq;
#pragma unroll
        for (int ai = 0; ai < 2; ++ai)
#pragma unroll
            for (int m = 0; m < 4; ++m) { bf16_t* rowp = O + (size_t)(row0 + ai * 128 + m * 16) * ldc + col0;
#pragma unroll
                for (int bj = 0; bj < 2; ++bj) { f32x4 v0 = acc[ai][bj][m][0], v1 = acc[ai][bj][m][1];
#pragma unroll
                    for (int e = 0; e < 4; ++e) { const float a = fmaxf(v0[e], 0.f), b = fmaxf(v1[e], 0.f); v0[e] = a * a; v1[e] = b * b; }
                    u32x4 w; w.x = cvt_pk_bf16(v0[0], v0[1]); w.y = cvt_pk_bf16(v0[2], v0[3]); w.z = cvt_pk_bf16(v1[0], v1[1]); w.w = cvt_pk_bf16(v1[2], v1[3]);
                    *(u32x4*)(rowp + bj * 128) = w; } }
    }
};

__device__ __forceinline__ void p6_resnorm(const Params& p, LAS unsigned char* lds, int NGW) {
    const int tid = opaque_tid(), lane = tid & 63, gw = blockIdx.x * 8 + __builtin_amdgcn_readfirstlane(tid >> 6);
    const bf16_t* xb = (const bf16_t*)((const unsigned char*)p.out + XB_OFF); const bf16_t* mix = (const bf16_t*)(p.ws + WS_MIX);
    float* RS2 = (float*)(p.ws + WS_RSTD2); const float* RS0 = (const float*)(p.ws + WS_RSTD0);
    LAS f32x4* gl1 = (LAS f32x4*)lds;
    __syncthreads();
    gl1[tid] = ((const f32x4*)p.in[13])[tid];
    __syncthreads();
    for (int row0 = gw; row0 < MTOK; row0 += 4 * NGW) {
        uint2 cm[4][8], cx[4][8];
#pragma unroll
        for (int r = 0; r < 4; ++r) { const int row = row0 + r * NGW;
            if (row < MTOK) {
#pragma unroll
                for (int j = 0; j < 8; ++j) { cm[r][j] = ldnt8((const uint2*)(mix + (size_t)row * DM) + lane + 64 * j); cx[r][j] = ldnt8((const uint2*)(xb + (size_t)row * DM) + lane + 64 * j); }
            } }
#pragma unroll
        for (int r = 0; r < 4; ++r) { const int row = row0 + r * NGW;
            if (row < MTOK) {
                float4 v[8]; float s = 0.f;
#pragma unroll
                for (int j = 0; j < 8; ++j) { v[j] = make_float4(bf2f(cm[r][j].x & 0xffffu), bf2f(cm[r][j].x >> 16), bf2f(cm[r][j].y & 0xffffu), bf2f(cm[r][j].y >> 16));
                    s += v[j].x * v[j].x + v[j].y * v[j].y + v[j].z * v[j].z + v[j].w * v[j].w; }
                const float rstd = rsqrtf(wave_sum(s) * (1.0f / DM) + NORM_EPS), rms0 = RS0[row];
                float s2 = 0.f; uint2* orow = (uint2*)((bf16_t*)(p.ws + WS_X1) + (size_t)row * DM) + lane;
#pragma unroll
                for (int j = 0; j < 8; ++j) { const f32x4 g = gl1[lane + 64 * j]; const uint2 xw0 = cx[r][j];
                    v[j].x = bf2f(xw0.x & 0xffffu) * rms0 + v[j].x * rstd * g[0]; v[j].y = bf2f(xw0.x >> 16) * rms0 + v[j].y * rstd * g[1]; v[j].z = bf2f(xw0.y & 0xffffu) * rms0 + v[j].z * rstd * g[2]; v[j].w = bf2f(xw0.y >> 16) * rms0 + v[j].w * rstd * g[3];
                    s2 += v[j].x * v[j].x + v[j].y * v[j].y + v[j].z * v[j].z + v[j].w * v[j].w; }
                const float rstd2 = rsqrtf(wave_sum(s2) * (1.0f / DM) + NORM_EPS);
                if (lane == 0) RS2[row] = 1.0f / rstd2;
#pragma unroll
                for (int j = 0; j < 8; ++j) { uint2 xw; xw.x = cvt_pk_bf16(v[j].x * rstd2, v[j].y * rstd2); xw.y = cvt_pk_bf16(v[j].z * rstd2, v[j].w * rstd2); orow[64 * j] = xw; }
            } }
    }
}
__device__ __forceinline__ void p9_final(const Params& p, LAS unsigned char* lds, int NGW) {
    const int tid = opaque_tid(), lane = tid & 63, gw = blockIdx.x * 8 + __builtin_amdgcn_readfirstlane(tid >> 6);
    const bf16_t* y = (const bf16_t*)(p.ws + WS_Y);
    LAS f32x4* gl = (LAS f32x4*)lds;
    __syncthreads();
    gl[tid] = ((const f32x4*)p.in[17])[tid];
    __syncthreads();
    for (int row0 = gw; row0 < MTOK; row0 += 3 * NGW) {
        uint2 cy[3][8], co[3][8];
#pragma unroll
        for (int r = 0; r < 3; ++r) { const int row = row0 + r * NGW;
            if (row < MTOK) {
#pragma unroll
                for (int j = 0; j < 8; ++j) { cy[r][j] = ldnt8((const uint2*)(y + (size_t)row * DM) + lane + 64 * j); co[r][j] = ldnt8((const uint2*)((const bf16_t*)(p.ws + WS_X1) + (size_t)row * DM) + lane + 64 * j); }
            } }
#pragma unroll
        for (int r = 0; r < 3; ++r) { const int row = row0 + r * NGW;
            if (row < MTOK) {
                float4 v[8]; float s = 0.f;
#pragma unroll
                for (int j = 0; j < 8; ++j) { v[j] = make_float4(bf2f(cy[r][j].x & 0xffffu), bf2f(cy[r][j].x >> 16), bf2f(cy[r][j].y & 0xffffu), bf2f(cy[r][j].y >> 16));
                    s += v[j].x * v[j].x + v[j].y * v[j].y + v[j].z * v[j].z + v[j].w * v[j].w; }
                const float rstd = rsqrtf(wave_sum(s) * (1.0f / DM) + NORM_EPS), rms2 = ((const float*)(p.ws + WS_RSTD2))[row];
                float4* orow = (float4*)(p.out + (size_t)row * DM) + lane;
#pragma unroll
                for (int j = 0; j < 8; ++j) { const f32x4 g = gl[lane + 64 * j]; const uint2 xw = co[r][j]; float4 o;
                    o.x = bf2f(xw.x & 0xffffu) * rms2 + v[j].x * rstd * g[0]; o.y = bf2f(xw.x >> 16) * rms2 + v[j].y * rstd * g[1]; o.z = bf2f(xw.y & 0xffffu) * rms2 + v[j].z * rstd * g[2]; o.w = bf2f(xw.y >> 16) * rms2 + v[j].w * rstd * g[3];
                    __builtin_nontemporal_store(o.x, &((float*)(orow + 64 * j))[0]); __builtin_nontemporal_store(o.y, &((float*)(orow + 64 * j))[1]); __builtin_nontemporal_store(o.z, &((float*)(orow + 64 * j))[2]); __builtin_nontemporal_store(o.w, &((float*)(orow + 64 * j))[3]); }
            } }
    }
}

__device__ __forceinline__ int t5_bucket(int rel) {
    const int n = rel > 0 ? rel : 0;
    if (n < 16) return n;
    const float nf = (float)n;
    int large = 16 + (int)(logf(nf / 16.0f) / 2.0794415416798357f * 16.0f);
    return large < 31 ? large : 31;
}

typedef short v4s __attribute__((ext_vector_type(4)));
__device__ __forceinline__ f32x4 mfma16(bf16x8 a, bf16x8 b, f32x4 c) { return __builtin_amdgcn_mfma_f32_16x16x32_bf16(a, b, c, 0, 0, 0); }
__device__ __forceinline__ bf16x8 tr_frag(const LAS bf16_t* X, int ld, int c0, int n0, int lane) {
    const int fq = lane >> 4, q = (lane & 15) >> 2, pq = lane & 3;
    const LAS bf16_t* a0 = X + (c0 + 4 * fq + q) * ld + n0 + 4 * pq;
    const v4s lo = __builtin_amdgcn_ds_read_tr16_b64_v4i16((LAS v4s*)a0);
    const v4s hi = __builtin_amdgcn_ds_read_tr16_b64_v4i16((LAS v4s*)(a0 + 16 * ld));
    return (bf16x8){lo[0], lo[1], lo[2], lo[3], hi[0], hi[1], hi[2], hi[3]};
}
__device__ __forceinline__ bf16x8 pack8(f32x4 a, f32x4 b) {
    u32x4 w; w.x = cvt_pk_bf16(a[0], a[1]); w.y = cvt_pk_bf16(a[2], a[3]); w.z = cvt_pk_bf16(b[0], b[1]); w.w = cvt_pk_bf16(b[2], b[3]);
    return __builtin_bit_cast(bf16x8, w);
}
__device__ __forceinline__ void swap16(unsigned& a, unsigned& b) { const auto r = __builtin_amdgcn_permlane16_swap(a, b, false, false); a = r[0]; b = r[1]; }
__device__ __forceinline__ void swap16f(float& a, float& b) { unsigned x = __float_as_uint(a), y = __float_as_uint(b); swap16(x, y); a = __uint_as_float(x); b = __uint_as_float(y); }
constexpr int RLD = 272;

__device__ __forceinline__ void stage_128x256(const bf16_t* g, LAS bf16_t* X, int tid) {
#pragma unroll
    for (int k = 0; k < 8; ++k) { const int pc = tid + 512 * k, r = pc >> 5, c8 = pc & 31;
        const u32x4 v = ldnt16(g + (size_t)r * 1024 + 8 * c8);
        *(LAS u32x4*)(X + r * RLD + 8 * c8) = v; }
}
__device__ __forceinline__ void mf_ret_u_items(const Params& p, int first, int stride, LAS unsigned char* lds) {
    const int tid = opaque_tid(), lane = tid & 63, wave = __builtin_amdgcn_readfirstlane(tid >> 6);
    unsigned char* ws = p.ws;
    LAS bf16_t* Kl = (LAS bf16_t*)lds; LAS bf16_t* Vl = Kl + 128 * RLD;
    const int wr = wave >> 1, wc = wave & 1, fr = lane & 15, fq = lane >> 4;
    u32x4 kst[8], vst[8];
#define RU_LOAD(bhn_) do { const int n_ = (bhn_) & 63, bh_ = (bhn_) >> 6; const size_t row0_ = (size_t)(bh_ >> 2) * SEQ + n_ * 128; \
        const bf16_t* kg_ = (const bf16_t*)(ws + WS_KR) + row0_ * 1024 + (bh_ & 3) * 256; const bf16_t* vg_ = (const bf16_t*)(ws + WS_VR) + row0_ * 1024 + (bh_ & 3) * 256; \
        _Pragma("unroll") for (int k_ = 0; k_ < 8; ++k_) { const int pc_ = tid + 512 * k_, r_ = pc_ >> 5, c8_ = pc_ & 31; \
            kst[k_] = *(const u32x4*)(kg_ + (size_t)r_ * 1024 + 8 * c8_); vst[k_] = *(const u32x4*)(vg_ + (size_t)r_ * 1024 + 8 * c8_); } } while (0)
    if (first < 512) RU_LOAD(first);
#pragma unroll 1
    for (int bhn = first; bhn < 512; bhn += stride) {
#pragma unroll
        for (int k = 0; k < 8; ++k) { const int pc = tid + 512 * k, r = pc >> 5, c8 = pc & 31; *(LAS u32x4*)(Kl + r * RLD + 8 * c8) = kst[k]; *(LAS u32x4*)(Vl + r * RLD + 8 * c8) = vst[k]; }
        __syncthreads();
        if (bhn + stride < 512) RU_LOAD(bhn + stride);
        bf16_t* UT = (bf16_t*)p.out + (size_t)bhn * 65536;
#pragma unroll 1
        for (int hf = 0; hf < 2; ++hf) {
            const int dk0 = 128 * wc + 64 * hf;
            f32x4 acc[4][4];
#pragma unroll
            for (int m = 0; m < 4; ++m)
#pragma unroll
                for (int nn = 0; nn < 4; ++nn) acc[m][nn] = (f32x4){0.f, 0.f, 0.f, 0.f};
#pragma unroll
            for (int kc = 0; kc < 4; ++kc) {
                bf16x8 a[4], bb[4];
#pragma unroll
                for (int m = 0; m < 4; ++m) a[m] = tr_frag(Vl, RLD, 32 * kc, 64 * wr + 16 * m, lane);
#pragma unroll
                for (int nn = 0; nn < 4; ++nn) bb[nn] = tr_frag(Kl, RLD, 32 * kc, dk0 + 16 * nn, lane);
#pragma unroll
                for (int m = 0; m < 4; ++m)
#pragma unroll
                    for (int nn = 0; nn < 4; ++nn) acc[m][nn] = mfma16(bb[nn], a[m], acc[m][nn]);
            }
#pragma unroll
            for (int m = 0; m < 4; ++m)
#pragma unroll
                for (int P = 0; P < 2; ++P) {
                    unsigned ax = cvt_pk_bf16(acc[m][2 * P][0], acc[m][2 * P][1]), ay = cvt_pk_bf16(acc[m][2 * P][2], acc[m][2 * P][3]);
                    unsigned bx = cvt_pk_bf16(acc[m][2 * P + 1][0], acc[m][2 * P + 1][1]), by = cvt_pk_bf16(acc[m][2 * P + 1][2], acc[m][2 * P + 1][3]);
                    swap16(ax, bx); swap16(ay, by);
                    *(u32x4*)(UT + (size_t)(64 * wr + 16 * m + fr) * 256 + dk0 + 32 * P + 16 * (fq & 1) + 8 * (fq >> 1)) = (u32x4){ax, ay, bx, by};
                }
        }
        __syncthreads();
    }
#undef RU_LOAD
}
__device__ __forceinline__ void mf_ret_scan(const Params& p, int gtid, int gthreads) {
    const bf16_t* UT = (const bf16_t*)p.out; bf16_t* RT = (bf16_t*)(p.ws + WS_RT);
    for (int e4 = gtid; e4 < 8 * 16384; e4 += gthreads) {
        const int bh = e4 >> 14, el = (e4 & 16383) * 4, h = bh & 3;
        const float gc = __expf(128.0f * p.lg[h]);
        float4 r = make_float4(0.f, 0.f, 0.f, 0.f);
        const bf16_t* up = UT + (size_t)bh * 64 * 65536 + el; bf16_t* rp = RT + (size_t)bh * 64 * 65536 + el;
#pragma unroll 8
        for (int n = 0; n < 64; ++n) {
            const uint2 uw = ldnt8(up + (size_t)n * 65536);
            const float4 u = make_float4(bf2f(uw.x & 0xffffu), bf2f(uw.x >> 16), bf2f(uw.y & 0xffffu), bf2f(uw.y >> 16));
            u32x2_t w; w[0] = cvt_pk_bf16(r.x, r.y); w[1] = cvt_pk_bf16(r.z, r.w); __builtin_nontemporal_store(w, (u32x2_t*)(rp + (size_t)n * 65536));
            r.x = gc * (r.x + u.x); r.y = gc * (r.y + u.y); r.z = gc * (r.z + u.z); r.w = gc * (r.w + u.w);
        }
    }
}
constexpr int RO_RT = 128 * RLD * 2;
__device__ __forceinline__ void mf_ret_out(const Params& p, int bhn, LAS unsigned char* lds, int tid_, int wave_, int lane_) {
    const int tid = opaque_tid(), lane = tid & 63, wave = __builtin_amdgcn_readfirstlane(tid >> 6); (void)tid_; (void)wave_; (void)lane_;
    unsigned char* ws = p.ws;
    const int n = bhn & 63, bh = bhn >> 6, b = bh >> 2, h = bh & 3;
    const size_t row0 = (size_t)b * SEQ + n * 128;
    LAS bf16_t* Vl = (LAS bf16_t*)lds;
    const bf16_t* Rg = (const bf16_t*)(ws + WS_RT) + (size_t)bhn * 65536;
    const int srow = tid >> 4, sch = tid & 15;
    const int fr = lane & 15, fq = lane >> 4;
    const bf16_t* Qg = (const bf16_t*)(ws + WS_QR) + (row0 + 16 * wave + fr) * 1024 + h * 256 + 8 * fq;
    bf16x8 qf[8];
#pragma unroll
    for (int kc = 0; kc < 8; ++kc) qf[kc] = __builtin_bit_cast(bf16x8, ldnt16(Qg + 32 * kc));
    u32x4 rstg[8];
    { const bf16_t* Kt = (const bf16_t*)(ws + WS_KR) + row0 * 1024 + h * 256;
#pragma unroll
      for (int k = 0; k < 8; ++k) { const int pc = tid + 512 * k, r = pc >> 5, c8 = pc & 31; rstg[k] = ldnt16(Kt + (size_t)r * 1024 + 8 * c8); } }
    stage_128x256((const bf16_t*)(ws + WS_VR) + row0 * 1024 + h * 256, Vl, tid);
#pragma unroll
    for (int k = 0; k < 8; ++k) { const int pc = tid + 512 * k, r = pc >> 5, c8 = pc & 31; *(LAS u32x4*)(lds + RO_RT + r * 512 + (((c8 & 16) | ((c8 ^ r) & 15)) << 4)) = rstg[k]; }
#pragma unroll
    for (int k = 0; k < 8; ++k) rstg[k] = ldnt16(Rg + (size_t)(srow + 32 * k) * 256 + 8 * sch);
    __syncthreads();
    f32x4 st[8];
#pragma unroll
    for (int jt = 0; jt < 8; ++jt) {
        st[jt] = (f32x4){0.f, 0.f, 0.f, 0.f};
        if (jt <= wave) {
            bf16x8 kfr[8];
#pragma unroll
            for (int kc = 0; kc < 8; ++kc) { const int ch = 4 * kc + fq; kfr[kc] = *(const LAS bf16x8*)(lds + RO_RT + (16 * jt + fr) * 512 + (((ch & 16) | ((ch ^ fr) & 15)) << 4)); }
#pragma unroll
            for (int kc = 0; kc < 8; ++kc) st[jt] = mfma16(kfr[kc], qf[kc], st[jt]);
            if (jt == wave) {
#pragma unroll
                for (int r = 0; r < 4; ++r) if (4 * fq + r > fr) st[jt][r] = 0.f;
            }
        }
    }
    __syncthreads();
#pragma unroll
    for (int k = 0; k < 8; ++k) { const int r = srow + 32 * k; *(LAS u32x4*)(lds + RO_RT + r * 256 + ((sch ^ (r & 15)) << 4)) = rstg[k]; }
#pragma unroll
    for (int k = 0; k < 8; ++k) rstg[k] = ldnt16(Rg + (size_t)(srow + 32 * k) * 256 + 128 + 8 * sch);
    const bf16_t* Gg = (const bf16_t*)(ws + WS_GR) + (row0 + 16 * wave + fr) * 1024 + h * 256 + 8 * (fq >> 1) + 16 * (fq & 1);
    u32x4 gwv[8];
#pragma unroll
    for (int P = 0; P < 8; ++P) gwv[P] = ldnt16(Gg + 32 * P);
    f32x4 acc[16];
#pragma unroll
    for (int dt = 0; dt < 16; ++dt) acc[dt] = (f32x4){0.f, 0.f, 0.f, 0.f};
#pragma unroll
    for (int C = 0; C < 4; ++C) {
        if (2 * C <= wave) {
            const bf16x8 pb = pack8(st[2 * C], st[2 * C + 1]);
#pragma unroll
            for (int dt = 0; dt < 16; ++dt) acc[dt] = mfma16(tr_frag(Vl, RLD, 32 * C, 16 * dt, lane), pb, acc[dt]);
        }
    }
    __syncthreads();
    const unsigned rbase = (unsigned)(RO_RT + fr * 256);
#pragma unroll 1
    for (int hf = 0; hf < 2; ++hf) {
        if (hf == 1) {
            __syncthreads();
#pragma unroll
            for (int k = 0; k < 8; ++k) { const int r = srow + 32 * k; *(LAS u32x4*)(lds + RO_RT + r * 256 + ((sch ^ (r & 15)) << 4)) = rstg[k]; }
            __syncthreads();
        }
#pragma unroll
        for (int kc = 0; kc < 4; ++kc) {
            const unsigned coff = (unsigned)(((4 * kc + fq) ^ fr) << 4);
            const bf16x8 qv = hf ? qf[4 + kc] : qf[kc];
#pragma unroll
            for (int dt = 0; dt < 16; ++dt) acc[dt] = mfma16(*(const LAS bf16x8*)(lds + rbase + dt * 4096 + coff), qv, acc[dt]);
        }
    }
    float s = 0.f;
#pragma unroll
    for (int dt = 0; dt < 16; ++dt) s += (acc[dt][0] + acc[dt][1]) + (acc[dt][2] + acc[dt][3]);
    s += __shfl_xor(s, 16); s += __shfl_xor(s, 32);
    const float mu = s * (1.0f / 256.0f);
    float q = 0.f;
#pragma unroll
    for (int dt = 0; dt < 16; ++dt)
#pragma unroll
        for (int r = 0; r < 4; ++r) { const float d = acc[dt][r] - mu; q += d * d; }
    q += __shfl_xor(q, 16); q += __shfl_xor(q, 32);
    const float rstd = rsqrtf(q * (1.0f / 256.0f) + GN_EPS);
    bf16_t* Og = (bf16_t*)(ws + WS_H) + (row0 + 16 * wave + fr) * 2048 + 1024 + h * 256 + 8 * (fq >> 1) + 16 * (fq & 1);
#pragma unroll
    for (int P = 0; P < 8; ++P) {
        float v[8];
#pragma unroll
        for (int r = 0; r < 4; ++r) { float a_ = acc[2 * P][r], b_ = acc[2 * P + 1][r]; swap16f(a_, b_); v[r] = (a_ - mu) * rstd; v[4 + r] = (b_ - mu) * rstd; }
        const u32x4 gw = gwv[P];
        const unsigned gwd[4] = {gw.x, gw.y, gw.z, gw.w};
        unsigned wd[4];
#pragma unroll
        for (int k = 0; k < 4; ++k) {
            const float g0 = bf2f(gwd[k] & 0xffffu), g1 = bf2f(gwd[k] >> 16);
            wd[k] = cvt_pk_bf16(g0 * __builtin_amdgcn_rcpf(1.0f + __expf(-g0)) * v[2 * k], g1 * __builtin_amdgcn_rcpf(1.0f + __expf(-g1)) * v[2 * k + 1]);
        }
        *(u32x4*)(Og + 32 * P) = (u32x4){wd[0], wd[1], wd[2], wd[3]};
    }
    __syncthreads();
}
__device__ __forceinline__ void mf_compress(const Params& p, int item, LAS unsigned char* lds, int tid_, int wave_, int lane_) {
    const int tid = opaque_tid(), lane = tid & 63, wave = __builtin_amdgcn_readfirstlane(tid >> 6); (void)tid_; (void)wave_; (void)lane_;
    unsigned char* ws = p.ws;
    const int T = item & 31, g = (item >> 5) & 1, b = (item >> 6) & 1, kind = item >> 7;
    const int fr = lane & 15, fq = lane >> 4;
    const bf16_t* KV = (const bf16_t*)(ws + WS_KV6) + (size_t)kind * MTOK * 256;
    const bf16_t* W1T = (const bf16_t*)(ws + WS_CW1T) + (size_t)kind * 128 * 4096;
    const bf16_t* W2T = (const bf16_t*)(ws + WS_CW2T) + (size_t)kind * 128 * 128;
    const float* CB = (const float*)(ws + WS_CB) + kind * 128;
    LAS float* red = (LAS float*)lds;
    LAS bf16_t* hid = (LAS bf16_t*)(lds + 65536);
    f32x4 acc[8];
#pragma unroll
    for (int ct = 0; ct < 8; ++ct) acc[ct] = (f32x4){0.f, 0.f, 0.f, 0.f};
    const int nblk = 16 * T + fr;
#pragma unroll
    for (int ll = 0; ll < 4; ++ll) {
        const int l = 4 * wave + ll;
        int tok = 16 * nblk + l; tok = tok < SEQ ? tok : SEQ - 1;
        const bf16_t* Ag = KV + ((size_t)b * SEQ + tok) * 256 + g * 128 + 8 * fq;
#pragma unroll
        for (int kc = 0; kc < 4; ++kc) {
            const bf16x8 a = *(const bf16x8*)(Ag + 32 * kc);
#pragma unroll
            for (int ct = 0; ct < 8; ++ct) acc[ct] = mfma16(a, *(const bf16x8*)(W1T + (size_t)(16 * ct + fr) * 4096 + l * 128 + 32 * kc + 8 * fq), acc[ct]);
        }
    }
#pragma unroll
    for (int ct = 0; ct < 8; ++ct)
#pragma unroll
        for (int r = 0; r < 4; ++r) red[(wave * 16 + 4 * fq + r) * 128 + 16 * ct + fr] = acc[ct][r];
    __syncthreads();
    for (int idx = tid; idx < 2048; idx += 512) {
        const int nn = idx >> 7, c = idx & 127; float hsum = 0.f;
#pragma unroll
        for (int sl = 0; sl < 8; ++sl) hsum += CB[sl * 256 + c];
#pragma unroll
        for (int w = 0; w < 8; ++w) hsum += red[(w * 16 + nn) * 128 + c];
        const float x3 = hsum * hsum * hsum;
        hsum = 0.5f * hsum * (1.0f + tanhf(0.7978845608028654f * (hsum + 0.044715f * x3)));
        hid[nn * 136 + c] = (bf16_t)(cvt_pk_bf16(hsum, 0.f) & 0xffffu);
    }
    __syncthreads();
    f32x4 o = (f32x4){0.f, 0.f, 0.f, 0.f};
#pragma unroll
    for (int kc = 0; kc < 4; ++kc)
        o = mfma16(*(const LAS bf16x8*)(hid + fr * 136 + 32 * kc + 8 * fq), *(const bf16x8*)(W2T + (size_t)(16 * wave + fr) * 128 + 32 * kc + 8 * fq), o);
    {
        bf16_t* OC = (bf16_t*)(ws + (kind == 0 ? WS_KC : WS_VCT)) + ((size_t)(b * 2 + g) * NCMPP + 16 * T) * 128 + 16 * wave + fr;
#pragma unroll
        for (int r = 0; r < 4; ++r) OC[(4 * fq + r) * 128] = (bf16_t)(cvt_pk_bf16(o[r], 0.f) & 0xffffu);
    }
    __syncthreads();
}


constexpr int ALD = 144;
constexpr int A_KV = 0, A_KVBUF = 32768, A_VOFF = 16384, A_SEL = 98304, A_BIAS = 99328, A_IMP = 103424, IMPLD = 129;
constexpr float QK_SCALE = 0.08838834764831845f;

__device__ __forceinline__ u32x4 ldg16(const void* ubase, unsigned voff) { return *(const u32x4*)((const char*)ubase + voff); }
__device__ __forceinline__ bf16x8 ldg_frag(const void* ubase, unsigned voff) { return __builtin_bit_cast(bf16x8, *(const u32x4*)((const char*)ubase + voff)); }
__device__ __forceinline__ bf16x8 lds_frag(LAS unsigned char* lds, unsigned off) { return *(const LAS bf16x8*)(lds + off); }
__device__ __forceinline__ bf16x8 tr_frag_b(LAS unsigned char* lds, unsigned off, unsigned hi16) {
    const v4s lo = __builtin_amdgcn_ds_read_tr16_b64_v4i16((LAS v4s*)(lds + off));
    const v4s hi = __builtin_amdgcn_ds_read_tr16_b64_v4i16((LAS v4s*)(lds + off + hi16));
    return (bf16x8){lo[0], lo[1], lo[2], lo[3], hi[0], hi[1], hi[2], hi[3]};
}
constexpr float LOG2E = 1.4426950408889634f, C1 = QK_SCALE * LOG2E, RESCALE_THR = 8.0f;
__device__ __forceinline__ float ex2(float x) { return __builtin_amdgcn_exp2f(x); }
__device__ __forceinline__ void lds_addfix(LAS unsigned* pz, float v) { (void)__hip_atomic_fetch_add(pz, (unsigned)__float2uint_rn(v * 67108864.0f), __ATOMIC_RELAXED, __HIP_MEMORY_SCOPE_WORKGROUP); }
__device__ __forceinline__ int sum8_dpp(int v) {
    v += __builtin_amdgcn_mov_dpp(v, 0xB1, 0xf, 0xf, true);
    v += __builtin_amdgcn_mov_dpp(v, 0x4E, 0xf, 0xf, true);
    v += __builtin_amdgcn_mov_dpp(v, 0x141, 0xf, 0xf, true);
    return v;
}
__device__ __forceinline__ float max16(const f32x4& a, const f32x4& b, const f32x4& c, const f32x4& d) {
    return fmaxf(fmaxf(fmaxf(fmaxf(a[0], a[1]), fmaxf(a[2], a[3])), fmaxf(fmaxf(b[0], b[1]), fmaxf(b[2], b[3]))),
                 fmaxf(fmaxf(fmaxf(c[0], c[1]), fmaxf(c[2], c[3])), fmaxf(fmaxf(d[0], d[1]), fmaxf(d[2], d[3]))));
}
typedef int v2i __attribute__((ext_vector_type(2)));
#define TR_READ_ASM(dst, addr, off) asm volatile("ds_read_b64_tr_b16 %0, %1 offset:%2" : "=v"(dst) : "v"(addr), "i"(off))
__device__ __forceinline__ bf16x8 ldg_qfrag(const void* ubase, unsigned voff) {
    const u32x4 v = ldnt16((const char*)ubase + voff); u32x4 w;
    w.x = cvt_pk_bf16(bf2f(v.x & 0xffffu) * C1, bf2f(v.x >> 16) * C1); w.y = cvt_pk_bf16(bf2f(v.y & 0xffffu) * C1, bf2f(v.y >> 16) * C1);
    w.z = cvt_pk_bf16(bf2f(v.z & 0xffffu) * C1, bf2f(v.z >> 16) * C1); w.w = cvt_pk_bf16(bf2f(v.w & 0xffffu) * C1, bf2f(v.w >> 16) * C1);
    return __builtin_bit_cast(bf16x8, w);
}
__device__ __forceinline__ void mf_nsa(const Params& p, int bg, int c, LAS unsigned char* lds, int tid_, int wave_, int lane_) {
    const int tid = opaque_tid(), lane = tid & 63, wave = __builtin_amdgcn_readfirstlane(tid >> 6); (void)tid_; (void)wave_; (void)lane_;
    unsigned char* ws = p.ws;
    const int b = bg >> 1, g = bg & 1, fr = lane & 15, fq = lane >> 4, hg = wave >> 1, th = wave & 1, h = 4 * g + hg;
    LAS unsigned* imp = (LAS unsigned*)(lds + A_IMP); LAS unsigned* sel = (LAS unsigned*)(lds + A_SEL); LAS float* biasT = (LAS float*)(lds + A_BIAS);
    const float* t5 = p.in[11];
    for (int i = tid; i < 64 * IMPLD; i += 512) imp[i] = 0u;
    if (tid < 256) sel[tid] = 0u;
    const float b31 = t5[31 * 8 + h] * LOG2E;
    const int tl0 = 32 * th + fr;
    const size_t row0 = (size_t)b * SEQ + 64 * c;
    const bf16_t* Qu = (const bf16_t*)(ws + WS_QA) + row0 * 1024 + h * 128;     const unsigned qoff = (unsigned)(tl0 * 1024 + 8 * fq) * 2u;
    const float* Gu = (const float*)(ws + WS_GATES) + row0 * 24 + h * 3;          const unsigned goff = (unsigned)(tl0 * 24) * 4u;
    bf16_t* Ou = (bf16_t*)(ws + WS_H) + row0 * 2048 + h * 128;                    const unsigned ooffw = (unsigned)(tl0 * 2048 + 8 * (fq >> 1) + 16 * (fq & 1)) * 2u;
    __syncthreads();
    const bf16_t* KVs = (const bf16_t*)(ws + WS_KV6) + (size_t)b * SEQ * 256 + g * 128;
    const int dr0 = 8 * wave + (lane >> 4);
    unsigned dslot[4];
    { const int r1 = dr0 + 4, sl = lane & 15;
      dslot[0] = (unsigned)((sl ^ (dr0 & 15)) << 4); dslot[1] = (unsigned)((sl ^ (r1 & 15)) << 4);
      dslot[2] = (unsigned)((sl ^ ((dr0 & 7) << 1)) << 4); dslot[3] = (unsigned)((sl ^ ((r1 & 7) << 1)) << 4); }
#define NSA_DMA_T(kb_, vb_, rp_, bi_) do { const unsigned ro0_ = (unsigned)dr0 * (rp_), ro1_ = ro0_ + 4u * (rp_); \
        LAS unsigned char* d_ = lds + A_KV + (bi_) * A_KVBUF + wave * 2048; \
        __builtin_amdgcn_global_load_lds((const unsigned*)((kb_) + ro0_ + dslot[0]), (LAS unsigned*)(d_), 16, 0, 0); \
        __builtin_amdgcn_global_load_lds((const unsigned*)((kb_) + ro1_ + dslot[1]), (LAS unsigned*)(d_ + 1024), 16, 0, 0); \
        __builtin_amdgcn_global_load_lds((const unsigned*)((vb_) + ro0_ + dslot[2]), (LAS unsigned*)(d_ + A_VOFF), 16, 0, 0); \
        __builtin_amdgcn_global_load_lds((const unsigned*)((vb_) + ro1_ + dslot[3]), (LAS unsigned*)(d_ + A_VOFF + 1024), 16, 0, 0); } while (0)
    const int nslc_ = c + 1;
#define NSA_TILE_J(sn) ((sn) < nslc_ ? (sn) : (c < 8 ? (sn) - nslc_ : ((sn) - nslc_ == 8 ? c - 8 : c - 7 + ((sn) - nslc_))))
#define NSA_DMA(sn) do { const bool win_ = (sn) >= nslc_; const int j_ = NSA_TILE_J(sn); \
        const char* kbq_ = (const char*)(KVs + ((size_t)(win_ ? 4 : 2) * MTOK + 64 * j_) * 256); NSA_DMA_T(kbq_, kbq_ + (size_t)MTOK * 512, 512u, (sn) % 3); } while (0)
    const int vq = 4 * fq + ((lane & 15) >> 2), vp = lane & 3;
    const unsigned vrow = (unsigned)(A_VOFF + vq * 256 + (vp >> 1) * 16 + (vp & 1) * 8), vx = (unsigned)((vq & 7) << 5);

    bf16x8 qf[2][4];
#pragma unroll
    for (int qb = 0; qb < 2; ++qb)
#pragma unroll
        for (int kc = 0; kc < 4; ++kc) qf[qb][kc] = ldg_qfrag(Qu + (size_t)qb * 16 * 1024 + 32 * kc, qoff);
    {
        const int nmax = 4 * c + 2 < NCMP - 1 ? 4 * c + 2 : NCMP - 1, NCT = nmax / 64 + 1, CS = 2 * NCT;
        const char* KCb = (const char*)((const bf16_t*)(ws + WS_KC) + (size_t)(b * 2 + g) * NCMPP * 128);
        const char* VCb = (const char*)((const bf16_t*)(ws + WS_VCT) + (size_t)(b * 2 + g) * NCMPP * 128);
#define NSA_DMA_C(un) do { const int T_ = (un) < NCT ? (un) : (un) - NCT; NSA_DMA_T(KCb + (size_t)T_ * 64 * 256, VCb + (size_t)T_ * 64 * 256, 256u, (un) % 3); } while (0)
        NSA_DMA_C(0); NSA_DMA_C(1);
        f32x4 oc[2][8], lacc[2];
        float m2[2] = {0.f, 0.f}, inv_l[2] = {0.f, 0.f};
        const bf16x8 ones8 = (bf16x8){0x3f80, 0x3f80, 0x3f80, 0x3f80, 0x3f80, 0x3f80, 0x3f80, 0x3f80};
#pragma unroll
        for (int qb = 0; qb < 2; ++qb) { lacc[qb] = (f32x4){0.f, 0.f, 0.f, 0.f};
#pragma unroll
            for (int dt = 0; dt < 8; ++dt) oc[qb][dt] = (f32x4){0.f, 0.f, 0.f, 0.f}; }
        unsigned koff[4];
#pragma unroll
        for (int kc = 0; kc < 4; ++kc) koff[kc] = (unsigned)(fr * 256 + (((4 * kc + fq) ^ fr) << 4));
        asm volatile("s_waitcnt vmcnt(0)" ::: "memory");
#pragma unroll 1
        for (int u = 0; u < CS; ++u) {
            const bool p1 = u >= NCT; const int T = p1 ? u - NCT : u;
            if (u > 0) { if (u + 1 < CS) asm volatile("s_waitcnt vmcnt(4)" ::: "memory"); else asm volatile("s_waitcnt vmcnt(0)" ::: "memory"); }
            __builtin_amdgcn_s_barrier(); asm volatile("" ::: "memory");
            if (u + 2 < CS) NSA_DMA_C(u + 2);
            unsigned vxl = vx, vrowl = vrow; asm volatile("" : "+v"(vxl), "+v"(vrowl));
            const unsigned kbuf = (unsigned)(A_KV + (u % 3) * A_KVBUF);
#pragma unroll
            for (int C = 0; C < 2; ++C) {
                f32x4 st[2][2];
                if (64 * c - 1024 * T - 512 * C < 655) {
#pragma unroll
                    for (int qb = 0; qb < 2; ++qb) {
                        const int relb = 64 * c + tl0 + 16 * qb - 31 - 16 * (64 * T + 32 * C + 4 * fq);
#pragma unroll
                        for (int t = 0; t < 2; ++t)
#pragma unroll
                            for (int r = 0; r < 4; ++r) { int rel = relb - 256 * t - 16 * r; rel = rel > 191 ? 191 : (rel < -64 ? -64 : rel);
                                st[t][qb][r] = biasT[hg * 256 + 191 - rel] - m2[qb]; }
                    }
                } else {
                    const float bl0 = b31 - m2[0], bl1 = b31 - m2[1];
#pragma unroll
                    for (int t = 0; t < 2; ++t) { st[t][0] = (f32x4){bl0, bl0, bl0, bl0}; st[t][1] = (f32x4){bl1, bl1, bl1, bl1}; }
                }
#pragma unroll
                for (int t = 0; t < 2; ++t) {
                    bf16x8 kf[4];
#pragma unroll
                    for (int kc = 0; kc < 4; ++kc) kf[kc] = lds_frag(lds, kbuf + koff[kc] + (2 * C + t) * 4096);
#pragma unroll
                    for (int kc = 0; kc < 4; ++kc) { st[t][0] = mfma16(kf[kc], qf[0][kc], st[t][0]); st[t][1] = mfma16(kf[kc], qf[1][kc], st[t][1]); }
                }
                bf16x8 pb[2];
                if (!p1) {
                    int imx = __float_as_int(st[0][0][0]);
#pragma unroll
                    for (int qb = 0; qb < 2; ++qb)
#pragma unroll
                        for (int t = 0; t < 2; ++t)
#pragma unroll
                            for (int r = 0; r < 4; ++r) imx = max(imx, __float_as_int(st[t][qb][r]));
                    const bool first = u == 0 && C == 0;
                    if (first || __any(imx > __float_as_int(RESCALE_THR))) {
#pragma unroll
                        for (int qb = 0; qb < 2; ++qb) {
                            float mx = fmaxf(fmaxf(fmaxf(st[0][qb][0], st[0][qb][1]), fmaxf(st[0][qb][2], st[0][qb][3])), fmaxf(fmaxf(st[1][qb][0], st[1][qb][1]), fmaxf(st[1][qb][2], st[1][qb][3])));
                            mx = fmaxf(mx, __shfl_xor(mx, 16)); mx = fmaxf(mx, __shfl_xor(mx, 32));
                            const float d = first ? mx : fmaxf(mx, 0.f), al = first ? 1.0f : ex2(-d);
                            m2[qb] += d; lacc[qb] = lacc[qb] * al;
#pragma unroll
                            for (int t = 0; t < 2; ++t)
#pragma unroll
                                for (int r = 0; r < 4; ++r) st[t][qb][r] -= d;
                        }
                    }
#pragma unroll
                    for (int qb = 0; qb < 2; ++qb) {
#pragma unroll
                        for (int t = 0; t < 2; ++t)
#pragma unroll
                            for (int r = 0; r < 4; ++r) st[t][qb][r] = ex2(st[t][qb][r]);
                        pb[qb] = pack8(st[0][qb], st[1][qb]);
                    }
                    lacc[0] = mfma16(ones8, pb[0], lacc[0]); lacc[1] = mfma16(ones8, pb[1], lacc[1]);
                } else {
                    v2i vlo[8], vhi[8];
#pragma unroll
                    for (int dt = 0; dt < 8; ++dt) { const unsigned va = (unsigned)(size_t)lds + kbuf + vrowl + (((unsigned)(dt << 5)) ^ vxl);
                        if (C == 0) { TR_READ_ASM(vlo[dt], va, 0); TR_READ_ASM(vhi[dt], va, 4096); } else { TR_READ_ASM(vlo[dt], va, 8192); TR_READ_ASM(vhi[dt], va, 12288); } }
#pragma unroll
                    for (int qb = 0; qb < 2; ++qb) {
#pragma unroll
                        for (int t = 0; t < 2; ++t)
#pragma unroll
                            for (int r = 0; r < 4; ++r) st[t][qb][r] = ex2(st[t][qb][r]) * inv_l[qb];
                        LAS unsigned* ip = imp + (tl0 + 16 * qb) * IMPLD + 16 * T + 8 * C + fq;
#pragma unroll
                        for (int t = 0; t < 2; ++t) {
                            lds_addfix(ip + 4 * t, (st[t][qb][0] + st[t][qb][1]) + (st[t][qb][2] + st[t][qb][3]));
                            if (16 * T + 8 * C + 4 * t + fq + 1 < 128) lds_addfix(ip + 4 * t + 1, st[t][qb][3]);
                        }
                        pb[qb] = pack8(st[0][qb], st[1][qb]);
                    }
                    asm volatile("s_waitcnt lgkmcnt(0)" : "+v"(vlo[0]), "+v"(vlo[1]), "+v"(vlo[2]), "+v"(vlo[3]), "+v"(vlo[4]), "+v"(vlo[5]), "+v"(vlo[6]), "+v"(vlo[7]),
                                 "+v"(vhi[0]), "+v"(vhi[1]), "+v"(vhi[2]), "+v"(vhi[3]), "+v"(vhi[4]), "+v"(vhi[5]), "+v"(vhi[6]), "+v"(vhi[7]) :: "memory");
                    __builtin_amdgcn_sched_barrier(0);
#pragma unroll
                    for (int dt = 0; dt < 8; ++dt) { const bf16x8 vfr = __builtin_bit_cast(bf16x8, (u32x4){(unsigned)vlo[dt][0], (unsigned)vlo[dt][1], (unsigned)vhi[dt][0], (unsigned)vhi[dt][1]});
                        oc[0][dt] = mfma16(vfr, pb[0], oc[0][dt]); oc[1][dt] = mfma16(vfr, pb[1], oc[1][dt]); }
                }
            }
            if (u == NCT - 1) {
#pragma unroll
                for (int qb = 0; qb < 2; ++qb) inv_l[qb] = (64 * c + tl0 + 16 * qb >= 31) ? 1.0f / lacc[qb][0] : 0.f;
            }
        }
#undef NSA_DMA_C
#pragma unroll
        for (int qb = 0; qb < 2; ++qb) {
            const float gzr = *(const float*)((const char*)(Gu + qb * 16 * 24 + 0) + goff), gz = 1.0f / (1.0f + __expf(-gzr));
#pragma unroll
            for (int P = 0; P < 4; ++P) {
                unsigned ax = cvt_pk_bf16(oc[qb][2 * P][0] * gz, oc[qb][2 * P][1] * gz), ay = cvt_pk_bf16(oc[qb][2 * P][2] * gz, oc[qb][2 * P][3] * gz);
                unsigned bx = cvt_pk_bf16(oc[qb][2 * P + 1][0] * gz, oc[qb][2 * P + 1][1] * gz), by = cvt_pk_bf16(oc[qb][2 * P + 1][2] * gz, oc[qb][2 * P + 1][3] * gz);
                swap16(ax, bx); swap16(ay, by);
                *(u32x4*)((char*)(Ou + (size_t)qb * 16 * 2048 + 32 * P) + ooffw) = (u32x4){ax, ay, bx, by}; }
        }
    }
    __syncthreads();
    NSA_DMA(0); NSA_DMA(1);
    {
        const int tk = tid >> 3, k = tid & 7;
        unsigned bits = 0u;
        if (c < 16) {
#pragma unroll
            for (int jj = 0; jj < 16; ++jj) bits |= (16 * k + jj <= c ? 1u : 0u) << jj;
        } else {
            unsigned v[16];
#pragma unroll
            for (int jj = 0; jj < 16; ++jj) { const int j = 16 * k + jj; v[jj] = (j >= 1 && j <= c - 2) ? imp[tk * IMPLD + j] : 0u; }
            unsigned T = 0u;
#pragma unroll 1
            for (int bit = 30; bit >= 0; --bit) {
                const unsigned trial = T | (1u << bit);
                int cnt = 0;
#pragma unroll
                for (int jj = 0; jj < 16; ++jj) cnt += v[jj] >= trial ? 1 : 0;
                cnt = sum8_dpp(cnt);
                if (cnt >= 13) T = trial;
            }
            int ngt = 0, neq = 0;
#pragma unroll
            for (int jj = 0; jj < 16; ++jj) { const int j = 16 * k + jj; const bool cand = j >= 1 && j <= c - 2; ngt += (cand && v[jj] > T) ? 1 : 0; neq += (cand && v[jj] == T) ? 1 : 0; }
            const int tgt = sum8_dpp(ngt);
            int pre = 0;
#pragma unroll
            for (int kk = 0; kk < 8; ++kk) { const int o = __shfl(neq, (lane & ~7) | kk); pre += kk < k ? o : 0; }
            int room = 13 - tgt - pre;
#pragma unroll
            for (int jj = 0; jj < 16; ++jj) { const int j = 16 * k + jj; const bool cand = j >= 1 && j <= c - 2;
                bool s1 = (j == 0) || (j == c) || (j == c - 1) || (cand && v[jj] > T);
                if (cand && v[jj] == T) { if (room > 0) s1 = true; --room; }
                bits |= (s1 ? 1u : 0u) << jj; }
        }
        atomicOr((unsigned*)(sel + tk * 4 + (k >> 1)), bits << (16 * (k & 1)));
    }
    __syncthreads();
    {
        const int nslc = c + 1, nwin = (c < 8 ? c : 8) + 1, nsteps = nslc + nwin;
        f32x4 oacc[2][8], lacc[2];
        float m2[2];
        const bf16x8 ones8 = (bf16x8){0x3f80, 0x3f80, 0x3f80, 0x3f80, 0x3f80, 0x3f80, 0x3f80, 0x3f80};
#pragma unroll
        for (int qb = 0; qb < 2; ++qb) { m2[qb] = 0.f; lacc[qb] = (f32x4){0.f, 0.f, 0.f, 0.f};
#pragma unroll
            for (int dt = 0; dt < 8; ++dt) oacc[qb][dt] = (f32x4){0.f, 0.f, 0.f, 0.f}; }
        unsigned koff[4];
#pragma unroll
        for (int kc = 0; kc < 4; ++kc) koff[kc] = (unsigned)(fr * 256 + (((4 * kc + fq) ^ fr) << 4));
        asm volatile("s_waitcnt vmcnt(0)" ::: "memory");
#pragma unroll 1
        for (int s = 0; s < nsteps; ++s) {
            const bool win = s >= nslc; const int j = NSA_TILE_J(s), dlt = c - j;
            if (s > 0) { if (s + 1 < nsteps) asm volatile("s_waitcnt vmcnt(4)" ::: "memory"); else asm volatile("s_waitcnt vmcnt(0)" ::: "memory"); }
            __builtin_amdgcn_s_barrier(); asm volatile("" ::: "memory");
            if (s + 2 < nsteps) NSA_DMA(s + 2);
            unsigned selw[2] = {0xffffffffu, 0xffffffffu};
            if (!win) { selw[0] = sel[tl0 * 4 + (j >> 5)]; selw[1] = sel[(tl0 + 16) * 4 + (j >> 5)]; }
            const unsigned kbuf = (unsigned)(A_KV + (s % 3) * A_KVBUF);
            const bool on0 = ((selw[0] >> (j & 31)) & 1u) != 0u, on1 = ((selw[1] >> (j & 31)) & 1u) != 0u;
#pragma unroll
            for (int C = 0; C < 2; ++C) {
                bf16x8 kf[2][4];
#pragma unroll
                for (int t = 0; t < 2; ++t)
#pragma unroll
                    for (int kc = 0; kc < 4; ++kc) kf[t][kc] = lds_frag(lds, kbuf + koff[kc] + (2 * C + t) * 4096);
                f32x4 st[2][2];
                if (dlt <= 2) {
#pragma unroll
                    for (int qb = 0; qb < 2; ++qb) {
                        const int tlq = tl0 + 16 * qb; const bool on = qb ? on1 : on0;
                        const LAS float* bt = biasT + hg * 256 + (191 - 64 * dlt - tlq + 4 * fq) + 32 * C;
#pragma unroll
                        for (int t = 0; t < 2; ++t)
#pragma unroll
                            for (int r = 0; r < 4; ++r) { const float tv = bt[16 * t + r] - m2[qb]; st[t][qb][r] = on ? tv : -1e30f; }
                    }
                } else {
                    const float bl0 = on0 ? b31 - m2[0] : -1e30f, bl1 = on1 ? b31 - m2[1] : -1e30f;
#pragma unroll
                    for (int t = 0; t < 2; ++t) { st[t][0] = (f32x4){bl0, bl0, bl0, bl0}; st[t][1] = (f32x4){bl1, bl1, bl1, bl1}; }
                    if (win && dlt == 8) {
#pragma unroll
                        for (int qb = 0; qb < 2; ++qb)
#pragma unroll
                            for (int t = 0; t < 2; ++t)
#pragma unroll
                                for (int r = 0; r < 4; ++r) st[t][qb][r] = (32 * C + 16 * t + 4 * fq + r > tl0 + 16 * qb) ? st[t][qb][r] : -1e30f;
                    }
                }
#pragma unroll
                for (int t = 0; t < 2; ++t)
#pragma unroll
                    for (int kc = 0; kc < 4; ++kc) { st[t][0] = mfma16(kf[t][kc], qf[0][kc], st[t][0]); st[t][1] = mfma16(kf[t][kc], qf[1][kc], st[t][1]); }
                v2i vlo[8], vhi[8];
#pragma unroll
                for (int dt = 0; dt < 8; ++dt) { const unsigned va = (unsigned)(size_t)lds + kbuf + vrow + (((unsigned)(dt << 5)) ^ vx);
                    if (C == 0) { TR_READ_ASM(vlo[dt], va, 0); TR_READ_ASM(vhi[dt], va, 4096); } else { TR_READ_ASM(vlo[dt], va, 8192); TR_READ_ASM(vhi[dt], va, 12288); } }
                int imx = __float_as_int(st[0][0][0]);
#pragma unroll
                for (int qb = 0; qb < 2; ++qb)
#pragma unroll
                    for (int t = 0; t < 2; ++t)
#pragma unroll
                        for (int r = 0; r < 4; ++r) imx = max(imx, __float_as_int(st[t][qb][r]));
                const bool first = (s == 0 || s == nslc) && C == 0;
                if (first || __any(imx > __float_as_int(RESCALE_THR))) {
#pragma unroll
                    for (int qb = 0; qb < 2; ++qb) {
                        float mx = fmaxf(fmaxf(fmaxf(st[0][qb][0], st[0][qb][1]), fmaxf(st[0][qb][2], st[0][qb][3])), fmaxf(fmaxf(st[1][qb][0], st[1][qb][1]), fmaxf(st[1][qb][2], st[1][qb][3])));
                        mx = fmaxf(mx, __shfl_xor(mx, 16)); mx = fmaxf(mx, __shfl_xor(mx, 32));
                        const float d = first ? mx : fmaxf(mx, 0.f), al = first ? 1.0f : ex2(-d);
                        m2[qb] += d; lacc[qb] = lacc[qb] * al;
#pragma unroll
                        for (int dt = 0; dt < 8; ++dt) oacc[qb][dt] = oacc[qb][dt] * al;
#pragma unroll
                        for (int t = 0; t < 2; ++t)
#pragma unroll
                            for (int r = 0; r < 4; ++r) st[t][qb][r] -= d;
                    }
                }
                bf16x8 pb[2];
#pragma unroll
                for (int qb = 0; qb < 2; ++qb) {
#pragma unroll
                    for (int t = 0; t < 2; ++t)
#pragma unroll
                        for (int r = 0; r < 4; ++r) st[t][qb][r] = ex2(st[t][qb][r]);
                    pb[qb] = pack8(st[0][qb], st[1][qb]);
                }
                asm volatile("s_waitcnt lgkmcnt(0)" : "+v"(vlo[0]), "+v"(vlo[1]), "+v"(vlo[2]), "+v"(vlo[3]), "+v"(vlo[4]), "+v"(vlo[5]), "+v"(vlo[6]), "+v"(vlo[7]),
                             "+v"(vhi[0]), "+v"(vhi[1]), "+v"(vhi[2]), "+v"(vhi[3]), "+v"(vhi[4]), "+v"(vhi[5]), "+v"(vhi[6]), "+v"(vhi[7]) :: "memory");
                __builtin_amdgcn_sched_barrier(0);
#pragma unroll
                for (int dt = 0; dt < 8; ++dt) { const bf16x8 vfr = __builtin_bit_cast(bf16x8, (u32x4){(unsigned)vlo[dt][0], (unsigned)vlo[dt][1], (unsigned)vhi[dt][0], (unsigned)vhi[dt][1]});
                    oacc[0][dt] = mfma16(vfr, pb[0], oacc[0][dt]); oacc[1][dt] = mfma16(vfr, pb[1], oacc[1][dt]); }
                lacc[0] = mfma16(ones8, pb[0], lacc[0]); lacc[1] = mfma16(ones8, pb[1], lacc[1]);
            }
            if (s == nslc - 1 || s == nsteps - 1) {
                u32x4 old[2][4];
#pragma unroll
                for (int qb = 0; qb < 2; ++qb)
#pragma unroll
                    for (int P = 0; P < 4; ++P) old[qb][P] = *(const u32x4*)((const char*)(Ou + (size_t)qb * 16 * 2048 + 32 * P) + ooffw);
                const float g0r = *(const float*)((const char*)(Gu + (win ? 2 : 1)) + goff), g1r = *(const float*)((const char*)(Gu + 16 * 24 + (win ? 2 : 1)) + goff);
                const float g0 = 1.0f / (1.0f + __expf(-g0r)), g1 = 1.0f / (1.0f + __expf(-g1r));
#pragma unroll
                for (int qb = 0; qb < 2; ++qb)
#pragma unroll
                    for (int P = 0; P < 4; ++P)
#pragma unroll
                        for (int r = 0; r < 4; ++r) { float a_ = oacc[qb][2 * P][r], b_ = oacc[qb][2 * P + 1][r]; swap16f(a_, b_); oacc[qb][2 * P][r] = a_; oacc[qb][2 * P + 1][r] = b_; }
                asm volatile("s_waitcnt vmcnt(0)" ::: "memory");
#pragma unroll
                for (int qb = 0; qb < 2; ++qb) {
                    const float gz = (qb ? g1 : g0) / lacc[qb][0];
                    char* Op = (char*)(Ou + (size_t)qb * 16 * 2048) + ooffw;
#pragma unroll
                    for (int P = 0; P < 4; ++P) {
                        const u32x4 o4 = old[qb][P]; const f32x4 a = oacc[qb][2 * P], b = oacc[qb][2 * P + 1];
                        u32x4 w; w.x = cvt_pk_bf16(bf2f(o4.x & 0xffffu) + a[0] * gz, bf2f(o4.x >> 16) + a[1] * gz); w.y = cvt_pk_bf16(bf2f(o4.y & 0xffffu) + a[2] * gz, bf2f(o4.y >> 16) + a[3] * gz);
                        w.z = cvt_pk_bf16(bf2f(o4.z & 0xffffu) + b[0] * gz, bf2f(o4.z >> 16) + b[1] * gz); w.w = cvt_pk_bf16(bf2f(o4.w & 0xffffu) + b[2] * gz, bf2f(o4.w >> 16) + b[3] * gz);
                        *(u32x4*)(Op + 64 * P) = w;
                        oacc[qb][2 * P] = (f32x4){0.f, 0.f, 0.f, 0.f}; oacc[qb][2 * P + 1] = (f32x4){0.f, 0.f, 0.f, 0.f};
                    }
                    m2[qb] = 0.f; lacc[qb] = (f32x4){0.f, 0.f, 0.f, 0.f};
                }
                asm volatile("s_waitcnt vmcnt(0)" ::: "memory");
            }
        }
        __syncthreads();
    }
#undef NSA_DMA
#undef NSA_TILE_J
}

#define XB_TMO      128
#define XB_XCNT(j)  (256  + 64 * (j))
#define XB_XSUB(j)  (1280 + 64 * (j))
#define XB_XGEN(j)  (2304 + 64 * (j))
#define XB_TOP      3328
#define XB_TOPGEN   3392
#define XCD_BAR_WORDS 3456
#define XB_SPIN_CAP (1u << 18)

__device__ __forceinline__ unsigned xb_ld(unsigned* p)              { return __hip_atomic_load(p, __ATOMIC_RELAXED, __HIP_MEMORY_SCOPE_AGENT); }
__device__ __forceinline__ unsigned xb_add(unsigned* p, unsigned v) { return __hip_atomic_fetch_add(p, v, __ATOMIC_RELAXED, __HIP_MEMORY_SCOPE_AGENT); }
__device__ __forceinline__ unsigned xb_xcc_id() { return (unsigned)__builtin_amdgcn_s_getreg((3 << 11) | 20) & 0xFu; }
#define XB_SPIN(cond, bar) do { unsigned _sp = 0; while (cond) { __builtin_amdgcn_s_sleep(1); \
    if ((++_sp & 255u) == 0u) { if (xb_ld(&(bar)[XB_TMO])) break; if (_sp > XB_SPIN_CAP) { atomicAdd(&(bar)[XB_TMO], 1u); break; } } } } while (0)

struct XcdBarrier {
    unsigned* bar; unsigned x;
    volatile LAS unsigned* st;
};

__device__ __forceinline__ XcdBarrier xcd_barrier_post(unsigned* bar, volatile LAS unsigned* st) {
    XcdBarrier b; b.bar = bar; b.x = xb_xcc_id(); b.st = st;
    if (threadIdx.x == 0) (void)xb_add(&bar[XB_XCNT(b.x)], 1u);
    return b;
}
__device__ __forceinline__ void xcd_barrier_complete(unsigned* bar, unsigned x, unsigned& nloc, unsigned& nx) {
    const unsigned G = gridDim.x * gridDim.y * gridDim.z;
    unsigned sum, cnt, mine, sp = 0u;
    for (;;) {
        sum = 0u; cnt = 0u; mine = 0u;
#pragma unroll
        for (unsigned j = 0; j < 16; ++j) { const unsigned c = xb_ld(&bar[XB_XCNT(j)]); sum += c; cnt += (c > 0u) ? 1u : 0u; mine = (j == x) ? c : mine; }
        if (sum == G) break;
        __builtin_amdgcn_s_sleep(1);
        if ((++sp & 255u) == 0u) { if (xb_ld(&bar[XB_TMO])) break; if (sp > XB_SPIN_CAP) { atomicAdd(&bar[XB_TMO], 1u); break; } }
    }
    nloc = mine > 0u ? mine : 1u; nx = cnt > 0u ? cnt : 1u;
}

__device__ __forceinline__ void xcd_barrier(const XcdBarrier& b) {
    asm volatile("s_waitcnt vmcnt(0)" ::: "memory");
    __syncthreads();
    if (threadIdx.x == 0) {
        unsigned* bar = b.bar;
        __builtin_amdgcn_s_waitcnt(0);
        unsigned nloc = b.st[0], nx = b.st[1];
        if (nloc == 0u) { xcd_barrier_complete(bar, b.x, nloc, nx); b.st[0] = nloc; b.st[1] = nx; }
        const unsigned old = xb_add(&bar[XB_XSUB(b.x)], 1u);
        const unsigned gen = old / nloc;
        if (old + 1u == (gen + 1u) * nloc) {
            __builtin_amdgcn_fence(__ATOMIC_RELEASE, "agent");
            asm volatile("s_waitcnt vmcnt(0)" ::: "memory");
            const unsigned og = xb_add(&bar[XB_TOP], 1u);
            const unsigned tg = og / nx;
            if (og + 1u == (tg + 1u) * nx) xb_add(&bar[XB_TOPGEN], 1u);
            else XB_SPIN(xb_ld(&bar[XB_TOPGEN]) == tg, bar);
            __builtin_amdgcn_fence(__ATOMIC_ACQUIRE, "agent");
            xb_add(&bar[XB_XGEN(b.x)], 1u);
            asm volatile("s_waitcnt vmcnt(0)" ::: "memory");
        } else {
            XB_SPIN(xb_ld(&bar[XB_XGEN(b.x)]) == gen, bar);
            __builtin_amdgcn_fence(__ATOMIC_ACQUIRE, "agent");
            asm volatile("s_waitcnt vmcnt(0)" ::: "memory");
        }
    }
    __syncthreads();
}

__global__ void __launch_bounds__(512, 2) mega(Params p) {
    extern __shared__ __attribute__((aligned(16))) unsigned char lds_raw[];
    LAS unsigned char* lds = (LAS unsigned char*)lds_raw;
    cg::grid_group grid = cg::this_grid();
    const int tid = threadIdx.x, lane = tid & 63, wave = __builtin_amdgcn_readfirstlane(tid >> 6);
    const int G = gridDim.x, gw = blockIdx.x * 8 + wave, NGW = G * 8;
    unsigned char* ws = p.ws;
    const int lo = p.ph_lo, hi = p.ph_hi;
    volatile LAS unsigned* bst = (volatile LAS unsigned*)(lds + LDS_BYTES - 64);
    if (tid < 2) bst[tid] = 0u;
    __syncthreads();
    const XcdBarrier xbar = xcd_barrier_post((unsigned*)(ws + WS_BAR), bst);
#define IN(k) (lo <= (k) && (k) < hi)
#define SEAM(k) do { if (IN(k) && IN((k) + 1)) { if (hi > 1000) grid.sync(); else xcd_barrier(xbar); } } while (0)
    if (IN(0)) { p0_prologue(p, lds, wave, lane, gw, NGW); }
    SEAM(0);
    if (IN(1)) {
        pg8::Gemm g{(const bf16_t*)((const unsigned char*)p.out + XB_OFF), (const bf16_t*)(ws + WS_WINT), MTOK, NIN, DM}; pg8::StaticOrder S; S.init(MTOK, NIN, G, (int)blockIdx.x, WGM_IN);
        EpiInProj E{(bf16_t*)(ws + WS_QA), (bf16_t*)(ws + WS_KV6), (bf16_t*)(ws + WS_QR), (bf16_t*)(ws + WS_KR), (bf16_t*)(ws + WS_VR), (bf16_t*)(ws + WS_GR), (float*)(ws + WS_GATES), (const float2*)(ws + WS_ROPE), p.lg[0], p.lg[1], p.lg[2], p.lg[3]};
        pg8::gemm_phase<EpiInProj, pg8::StaticOrder, GEMM_ALIGN, GEMM_SP2>(lds, g, S, E);
        { const int U = (MTOK / 256) * (NIN / 256), rounds = (U + G - 1) / G, nfull = U - (rounds - 1) * G, nidle = G - nfull;
          __syncthreads();
          if (nidle == 0) p1_tail_weights(p, lds, gw, NGW);
          else if ((int)blockIdx.x >= nfull) p1_tail_weights(p, lds, ((int)blockIdx.x - nfull) * 8 + wave, nidle * 8); }
    }
    SEAM(1);
    if (IN(2)) {
        for (int it = blockIdx.x; it < 256; it += G) mf_compress(p, it, lds, tid, wave, lane);
        mf_ret_u_items(p, (int)blockIdx.x, G, lds);
    }
    SEAM(2);
    if (IN(3)) { mf_ret_scan(p, blockIdx.x * 512 + opaque_tid(), G * 512); }
    SEAM(3);
    if (IN(4)) {
        for (int it = blockIdx.x; it < 256; it += G) { const int bgi = it & 3, pr = it >> 2;
            __syncthreads();
            for (int i = tid; i < 4 * 256; i += 512) { const int hh = i >> 8, rel = 191 - (i & 255);
                ((LAS float*)(lds + A_BIAS))[i] = rel >= 0 ? p.in[11][t5_bucket(rel) * 8 + 4 * (bgi & 1) + hh] * LOG2E : -1e30f; }
            mf_nsa(p, bgi, 127 - pr, lds, tid, wave, lane); mf_nsa(p, bgi, pr, lds, tid, wave, lane); }
        for (int it = blockIdx.x; it < 512; it += G) mf_ret_out(p, it, lds, tid, wave, lane);
    }
    SEAM(4);
    if (IN(5)) {
        pg8::Gemm g{(const bf16_t*)(ws + WS_H), (const bf16_t*)(ws + WS_WOUTT), MTOK, DM, DM}; pg8::StaticOrder S; S.init(MTOK, DM, G, (int)blockIdx.x, WGM_OUT);
        EpiBf16Plain E{(bf16_t*)(ws + WS_MIX), DM};
        pg8::gemm_phase<EpiBf16Plain, pg8::StaticOrder, GEMM_ALIGN, GEMM_SP2>(lds, g, S, E);
    }
    SEAM(5);
    if (IN(6)) { p6_resnorm(p, lds, NGW); }
    SEAM(6);
    if (IN(7)) {
        pg8::Gemm g{(const bf16_t*)(ws + WS_X1), (const bf16_t*)(ws + WS_WUPT), MTOK, DFF, DM}; pg8::StaticOrder S; S.init(MTOK, DFF, G, (int)blockIdx.x, WGM_UP);
        EpiRelu2 E{(bf16_t*)(ws + WS_UM), DFF};
        pg8::gemm_phase<EpiRelu2, pg8::StaticOrder, GEMM_ALIGN, GEMM_SP2>(lds, g, S, E);
    }
    SEAM(7);
    if (IN(8)) {
        pg8::Gemm g{(const bf16_t*)(ws + WS_UM), (const bf16_t*)(ws + WS_WDNT), MTOK, DM, DFF}; RevOrder S; S.init(MTOK, DM, G, (int)blockIdx.x, WGM_DN);
        EpiBf16Plain E{(bf16_t*)(ws + WS_Y), DM};
        pg8::gemm_phase<EpiBf16Plain, RevOrder, GEMM_ALIGN, GEMM_SP2>(lds, g, S, E);
    }
    SEAM(8);
    if (IN(9)) { p9_final(p, lds, NGW); }
#undef IN
#undef SEAM
}
}

extern "C" void kernel_launch(void* const* d_in, const int* in_sizes, int n_in, void* d_out, int out_size, void* d_ws, size_t ws_size, hipStream_t stream) {
    using namespace mk;
    static int grid = 0;
    if (n_in != 18 || out_size != MTOK * DM || ws_size < WS_NEED) { fprintf(stderr, "kernel_launch: unexpected shapes (n_in %d out %d ws %zu)\n", n_in, out_size, ws_size); return; }
    if (!grid) {
        int dev = 0, cus = 0, per_cu = 0;
        hipGetDevice(&dev); hipDeviceGetAttribute(&cus, hipDeviceAttributeMultiprocessorCount, dev);
        hipFuncSetAttribute((const void*)mega, hipFuncAttributeMaxDynamicSharedMemorySize, LDS_BYTES);
        hipOccupancyMaxActiveBlocksPerMultiprocessor(&per_cu, (const void*)mega, 512, LDS_BYTES);
        if (per_cu < 1) { fprintf(stderr, "kernel_launch: occupancy query says %d blocks per CU\n", per_cu); per_cu = 1; }
        grid = cus * per_cu;
        fprintf(stderr, "kernel_launch: grid %d (%d CUs x %d)\n", grid, cus, per_cu);
    }
    Params p{};
    for (int i = 0; i < 18; ++i) p.in[i] = (const float*)d_in[i];
    p.out = (float*)d_out; p.ws = (unsigned char*)d_ws;
    for (int h = 0; h < 4; ++h) p.lg[h] = (float)std::log(1.0 - std::exp2(-5.0 - (double)h));
    for (int i = 0; i < 128; ++i) p.invf[i] = (double)std::pow(10000.0f, -(float)(2 * i) / 256.0f);
    auto launch = [&](int lo, int hi) {
        Params q = p; q.ph_lo = lo; q.ph_hi = hi; void* args[] = {&q};
        hipError_t e = hipLaunchCooperativeKernel((const void*)mega, dim3(grid), dim3(512), args, LDS_BYTES, stream);
        if (e != hipSuccess) fprintf(stderr, "cooperative launch [%d,%d) failed: %s (grid %d)\n", lo, hi, hipGetErrorString(e), grid);
    };
    if (hipMemsetAsync(d_ws, 0, 65536, stream) != hipSuccess) fprintf(stderr, "kernel_launch: memset of the control words failed\n");
    launch(0, 10);
}
```

```cpp
#include <hip/hip_runtime.h>
#include <hip/hip_cooperative_groups.h>
#include <cstdio>
#include <cmath>
namespace pg8 {
#define PG8_LAS __attribute__((address_space(3)))
typedef unsigned short bf16_t;
typedef short bf16x8 __attribute__((ext_vector_type(8)));
typedef float f32x4 __attribute__((ext_vector_type(4)));
typedef unsigned u32x4 __attribute__((ext_vector_type(4)));
constexpr int BM = 256, BK = 64, HALF = 128, HTB = HALF * BK * 2  , STAGE_BYTES = 8 * HTB, NXCD = 8, WGM = 8;

__host__ __device__ __forceinline__ int lds_byte(int r, int c) { const int st = (r >> 4) * 2 + (c >> 5), rr = r & 15, cc = c & 31, ob = rr * 64 + cc * 2; return st * 1024 + (ob ^ (((ob >> 9) & 1) << 5)); }
__host__ __device__ __forceinline__ void stage_rc(int b, int& R, int& C) { const int st = b / 1024, sb = b % 1024, swz = sb ^ (((sb >> 9) & 1) << 5); R = (st >> 1) * 16 + swz / 64; C = (st & 1) * 32 + (swz % 64) / 2; }
__host__ __device__ __forceinline__ int perm32(int rho) { const int n = rho >> 4, i = rho & 15; return 8 * (i >> 2) + 4 * n + (i & 3); }

struct Unit { int pm, pn; };
struct Gemm { const bf16_t* A; const bf16_t* Bt; int M, N, K; };

struct StaticOrder {
    int nM, nN, nwg, G, c, wgm;
    __host__ __device__ void init(int M, int N, int G_, int c_, int wgm_ = WGM) { nM = M / BM; nN = N / BM; nwg = nM * nN; G = G_; c = c_; wgm = wgm_; }
    __host__ __device__ bool next(int i, Unit& u) const {
        const long L = (long)i * G + c; if (L >= nwg) return false;
        int wgid = (int)L; { const int q = nwg / NXCD, r = nwg % NXCD, xcd = wgid % NXCD, off = wgid / NXCD; wgid = (xcd < r ? xcd * (q + 1) : r * (q + 1) + (xcd - r) * q) + off; }
        const int nig = wgm * nN, gid = wgid / nig, fm = gid * wgm, gsz = (nM - fm) < wgm ? (nM - fm) : wgm;
        u.pm = fm + ((wgid % nig) % gsz); u.pn = (wgid % nig) / gsz; return true;
    }
    __device__ __forceinline__ void a_ready(const Unit&) const {}
    __device__ __forceinline__ void done(const Unit&) const {}
};
typedef float f32x2 __attribute__((ext_vector_type(2)));
typedef __bf16 bf16x2_nat __attribute__((ext_vector_type(2)));
__device__ __forceinline__ unsigned cvt_pk_bf16(float lo, float hi) { const f32x2 v = {lo, hi}; return __builtin_bit_cast(unsigned, __builtin_convertvector(v, bf16x2_nat)); }
struct EpiF32 {
    static constexpr bool PERM = false, AFTER_DRAIN = false;
    float* C; int ldc; const float* bias;
    __device__ __forceinline__ void operator()(const f32x4 (&acc)[2][2][4][2], const Unit& u, int wr, int wc, int fr, int fq) const {
        const int row0 = u.pm * BM + wr * 64 + fr, col0 = u.pn * BM + wc * 32 + 4 * fq;
        f32x4 bv[2][2];
#pragma unroll
        for (int bj = 0; bj < 2; ++bj)
#pragma unroll
            for (int n = 0; n < 2; ++n) bv[bj][n] = bias ? *(const f32x4*)(bias + col0 + bj * HALF + n * 16) : (f32x4){0.f, 0.f, 0.f, 0.f};
#pragma unroll
        for (int ai = 0; ai < 2; ++ai)
#pragma unroll
            for (int m = 0; m < 4; ++m) { float* rowp = C + (size_t)(row0 + ai * HALF + m * 16) * ldc + col0;
#pragma unroll
                for (int bj = 0; bj < 2; ++bj)
#pragma unroll
                    for (int n = 0; n < 2; ++n) *(f32x4*)(rowp + bj * HALF + n * 16) = acc[ai][bj][m][n] + bv[bj][n]; }
    }
};
template <class Epi, class Sched, bool ALIGN_EPI = false, bool SP2 = false>
__device__ __forceinline__ void gemm_phase(PG8_LAS unsigned char* lds, const Gemm g, const Sched& S, const Epi& E) {
    int tid_o = threadIdx.x; asm volatile("" : "+v"(tid_o));
    const int tid = tid_o, wid = __builtin_amdgcn_readfirstlane(tid >> 6), lane = tid & 63, wr = wid >> 2, wc = wid & 3, fr = lane & 15, fq = lane >> 4;
    const int K = g.K, nt = K / BK;
    unsigned voffA[2], voffB[2];
#pragma unroll
    for (int i = 0; i < 2; ++i) { int R, C; stage_rc(tid * 16 + i * 8192, R, C); const int Rb = Epi::PERM ? ((R & ~31) + perm32(R & 31)) : R;
        voffA[i] = (unsigned)(R * K + C) * 2u; voffB[i] = (unsigned)(Rb * K + C) * 2u; }
    const size_t kstep = (size_t)(BK * 2);
    const size_t hstep = (size_t)HALF * K * 2;
    const size_t tstep = 2 * hstep;
    const unsigned ldsw = (unsigned)wid * 1024u;
    const int aoff = lds_byte(wr * 64 + fr, fq * 8), boff = lds_byte(wc * 32 + fr, fq * 8);
#define PG8_SA(b, h) (((b) * 2 + (h)) * HTB)
#define PG8_SB(b, h) ((4 + (b) * 2 + (h)) * HTB)
#define PG8_STAGE(bufoff, gbase, voff) do { _Pragma("unroll") for (int _i = 0; _i < 2; ++_i) \
        __builtin_amdgcn_global_load_lds((const unsigned*)((const char*)(gbase) + (voff)[_i]), (PG8_LAS unsigned*)(lds + (bufoff) + ldsw + _i * 8192), 16, 0, 0); } while (0)
#define PG8_LDA(dst, b, h) do { _Pragma("unroll") for (int m = 0; m < 4; ++m) _Pragma("unroll") for (int k = 0; k < 2; ++k) dst[m][k] = *(const PG8_LAS bf16x8*)(lds + PG8_SA(b, h) + aoff + m * 2048 + k * 1024); } while (0)
#define PG8_LDB(dst, b, h) do { _Pragma("unroll") for (int n = 0; n < 2; ++n) _Pragma("unroll") for (int k = 0; k < 2; ++k) dst[n][k] = *(const PG8_LAS bf16x8*)(lds + PG8_SB(b, h) + boff + n * 2048 + k * 1024); } while (0)
#define PG8_MMA(ai, bj, At, Bt) do { __builtin_amdgcn_s_setprio(1); _Pragma("unroll") for (int m = 0; m < 4; ++m) _Pragma("unroll") for (int n = 0; n < 2; ++n) _Pragma("unroll") for (int k = 0; k < 2; ++k) \
        acc[ai][bj][m][n] = __builtin_amdgcn_mfma_f32_16x16x32_bf16(Bt[n][k], At[m][k], acc[ai][bj][m][n], 0, 0, 0); __builtin_amdgcn_s_setprio(0); } while (0)
#define PG8_WAIT_V(n) asm volatile("s_waitcnt vmcnt(" #n ")" ::: "memory")
#define PG8_WAIT_L(n) asm volatile("s_waitcnt lgkmcnt(" #n ")" ::: "memory")
#define PG8_BAR __builtin_amdgcn_s_barrier()
#define PG8_SCHED __builtin_amdgcn_sched_barrier(0)
    Unit cur, nxt; int ui = 0;
    if (!S.next(0, cur)) return;
    f32x4 acc[2][2][4][2];
#pragma unroll
    for (int a = 0; a < 2; ++a)
#pragma unroll
        for (int b = 0; b < 2; ++b)
#pragma unroll
            for (int m = 0; m < 4; ++m)
#pragma unroll
                for (int n = 0; n < 2; ++n) acc[a][b][m][n] = (f32x4){0.f, 0.f, 0.f, 0.f};
    bf16x8 At[4][2], B0[2][2], B1[2][2];
    const char* cA = (const char*)g.A + (size_t)cur.pm * tstep; const char* cB = (const char*)g.Bt + (size_t)cur.pn * tstep;
    S.a_ready(cur);
    if constexpr (SP2) {
        PG8_STAGE(PG8_SB(0, 0), cB, voffB); PG8_STAGE(PG8_SB(0, 1), cB + hstep, voffB); PG8_STAGE(PG8_SA(0, 0), cA, voffA); PG8_STAGE(PG8_SA(0, 1), cA + hstep, voffA);
        if (wr == 1) PG8_BAR;
        PG8_WAIT_V(2); PG8_BAR;
        PG8_STAGE(PG8_SB(1, 0), cB + kstep, voffB); PG8_STAGE(PG8_SA(1, 0), cA + kstep, voffA); PG8_STAGE(PG8_SB(1, 1), cB + hstep + kstep, voffB);
        PG8_WAIT_V(6); PG8_BAR;
    } else {
        PG8_STAGE(PG8_SB(0, 0), cB, voffB); PG8_STAGE(PG8_SA(0, 0), cA, voffA); PG8_STAGE(PG8_SB(0, 1), cB + hstep, voffB); PG8_STAGE(PG8_SA(0, 1), cA + hstep, voffA);
        if (wr == 1) PG8_BAR;
        PG8_WAIT_V(4); PG8_BAR;
        PG8_STAGE(PG8_SB(1, 0), cB + kstep, voffB); PG8_STAGE(PG8_SA(1, 0), cA + kstep, voffA); PG8_STAGE(PG8_SB(1, 1), cB + hstep + kstep, voffB);
        PG8_WAIT_V(6); PG8_BAR;
    }
    for (;;) {
        const bool has_next = S.next(ui + 1, nxt);
        const char* nA = has_next ? (const char*)g.A + (size_t)nxt.pm * tstep : cA; const char* nB = has_next ? (const char*)g.Bt + (size_t)nxt.pn * tstep : cB;
        for (int t = 0; t < nt; t += 2) {
            const bool last = (t == nt - 2);
            const char* a1 = cA + (size_t)(t + 1) * kstep;
            const char* a2 = last ? nA : cA + (size_t)(t + 2) * kstep; const char* b2 = last ? nB : cB + (size_t)(t + 2) * kstep;
            const char* a3 = a2 + kstep; const char* b3 = b2 + kstep;
            if (last && has_next) S.a_ready(nxt);
            if constexpr (SP2) {
            PG8_LDB(B0, 0, 0); PG8_LDB(B1, 0, 1); PG8_SCHED; PG8_LDA(At, 0, 0); PG8_STAGE(PG8_SA(1, 1), a1 + hstep, voffA);
            PG8_WAIT_V(8); PG8_WAIT_L(0); PG8_BAR; PG8_MMA(0, 0, At, B0); PG8_MMA(0, 1, At, B1); PG8_BAR; PG8_SCHED;
            PG8_LDA(At, 0, 1); PG8_STAGE(PG8_SB(0, 0), b2, voffB); PG8_STAGE(PG8_SB(0, 1), b2 + hstep, voffB); PG8_STAGE(PG8_SA(0, 0), a2, voffA);
            PG8_WAIT_V(8); PG8_WAIT_L(0); PG8_BAR; PG8_MMA(1, 0, At, B0); PG8_MMA(1, 1, At, B1); PG8_BAR; PG8_SCHED;
            PG8_LDB(B0, 1, 0); PG8_LDB(B1, 1, 1); PG8_SCHED; PG8_LDA(At, 1, 0); PG8_STAGE(PG8_SA(0, 1), a2 + hstep, voffA);
            PG8_WAIT_V(8); PG8_WAIT_L(0); PG8_BAR; PG8_MMA(0, 0, At, B0); PG8_MMA(0, 1, At, B1); PG8_BAR; PG8_SCHED;
            PG8_LDA(At, 1, 1); PG8_STAGE(PG8_SB(1, 0), b3, voffB); PG8_STAGE(PG8_SB(1, 1), b3 + hstep, voffB); PG8_STAGE(PG8_SA(1, 0), a3, voffA);
            PG8_WAIT_V(8); PG8_WAIT_L(0); PG8_BAR; PG8_MMA(1, 0, At, B0); PG8_MMA(1, 1, At, B1); PG8_BAR; PG8_SCHED;
            } else {
            PG8_LDB(B0, 0, 0); PG8_SCHED; PG8_LDA(At, 0, 0); PG8_STAGE(PG8_SA(1, 1), a1 + hstep, voffA);
            PG8_WAIT_L(8); PG8_BAR; PG8_WAIT_L(0); PG8_MMA(0, 0, At, B0); PG8_BAR; PG8_SCHED;
            PG8_LDB(B1, 0, 1); PG8_STAGE(PG8_SB(0, 0), b2, voffB);
            PG8_BAR; PG8_WAIT_L(0); PG8_MMA(0, 1, At, B1); PG8_BAR;
            PG8_LDA(At, 0, 1); PG8_STAGE(PG8_SA(0, 0), a2, voffA);
            PG8_BAR; PG8_WAIT_L(0); PG8_MMA(1, 0, At, B0); PG8_BAR; PG8_SCHED;
            PG8_STAGE(PG8_SB(0, 1), b2 + hstep, voffB);
            PG8_WAIT_V(6); PG8_BAR; PG8_MMA(1, 1, At, B1); PG8_BAR;
            PG8_LDB(B0, 1, 0); PG8_SCHED; PG8_LDA(At, 1, 0); PG8_STAGE(PG8_SA(0, 1), a2 + hstep, voffA);
            PG8_WAIT_L(8); PG8_BAR; PG8_WAIT_L(0); PG8_MMA(0, 0, At, B0); PG8_BAR; PG8_SCHED;
            PG8_LDB(B1, 1, 1); PG8_STAGE(PG8_SB(1, 0), b3, voffB);
            PG8_BAR; PG8_WAIT_L(0); PG8_MMA(0, 1, At, B1); PG8_BAR;
            PG8_LDA(At, 1, 1); PG8_STAGE(PG8_SA(1, 0), a3, voffA);
            PG8_BAR; PG8_WAIT_L(0); PG8_MMA(1, 0, At, B0); PG8_BAR; PG8_SCHED;
            PG8_STAGE(PG8_SB(1, 1), b3 + hstep, voffB);
            PG8_WAIT_V(6); PG8_BAR; PG8_MMA(1, 1, At, B1); PG8_BAR;
            }
        }
        if constexpr (ALIGN_EPI) { if (wr == 0) PG8_BAR; }
        if constexpr (!Epi::AFTER_DRAIN) { E(acc, cur, wr, wc, fr, fq); S.done(cur); }
        if (!has_next) break;
#pragma unroll
        for (int a = 0; a < 2; ++a)
#pragma unroll
            for (int b = 0; b < 2; ++b)
#pragma unroll
                for (int m = 0; m < 4; ++m)
#pragma unroll
                    for (int n = 0; n < 2; ++n) acc[a][b][m][n] = (f32x4){0.f, 0.f, 0.f, 0.f};
        cur = nxt; cA = nA; cB = nB; ++ui;
        if constexpr (ALIGN_EPI) { if (wr == 1) PG8_BAR; }
    }
    PG8_WAIT_V(0);
    if constexpr (!ALIGN_EPI) { if (wr == 0) PG8_BAR; }
    PG8_BAR;
    if constexpr (Epi::AFTER_DRAIN) { E.fused(acc, cur, wr, wc, fr, fq, lds, wid, lane); S.done(cur); }
#undef PG8_SA
#undef PG8_SB
#undef PG8_STAGE
#undef PG8_LDA
#undef PG8_LDB
#undef PG8_MMA
#undef PG8_WAIT_V
#undef PG8_WAIT_L
#undef PG8_BAR
#undef PG8_SCHED
}
}
constexpr int T_DN_TAIL = 2696;

namespace mk {
namespace cg = cooperative_groups;
using pg8::bf16_t; using pg8::bf16x8; using pg8::f32x4; using pg8::u32x4; using pg8::cvt_pk_bf16;
#define LAS __attribute__((address_space(3)))
constexpr int BATCH = 2, SEQ = 8192, DM = 2048, MTOK = BATCH * SEQ, DFF = 8192;
constexpr int DIN = 6680, NIN = 6912;
constexpr int C_GATE = 2560, C_QR = 2584;
constexpr int NCMP = 511, NCMPP = 512;
constexpr float NORM_EPS = 1e-6f, GN_EPS = 1e-6f, NEGV = -1e30f;
constexpr size_t MiB = 1u << 20;
constexpr size_t WS_BAR = 16384;
constexpr size_t WS_RSTD0 = 256 * 1024;
constexpr size_t WS_RSTD2 = 384 * 1024;
constexpr size_t XB_OFF = 64 * MiB;
constexpr size_t WS_CB = 1 * MiB - 8192;
constexpr size_t WS_CW2T = 1 * MiB + 4096;
constexpr size_t WS_CW1T = 2 * MiB;
constexpr size_t WS_KC = 4 * MiB;
constexpr size_t WS_VCT = 5 * MiB;
constexpr size_t WS_GATES = 6 * MiB;
constexpr size_t WS_ROPE = 8 * MiB;
constexpr size_t WS_WDNT = 16 * MiB;
constexpr size_t WS_WINT = 48 * MiB;
constexpr size_t WS_WOUTT = 76 * MiB;
constexpr size_t WS_WUPT = 84 * MiB;
constexpr size_t WS_H = 116 * MiB;
constexpr size_t WS_QA = 180 * MiB;
constexpr size_t WS_KV6 = 212 * MiB;
constexpr size_t WS_QR = 260 * MiB;
constexpr size_t WS_KR = 292 * MiB;
constexpr size_t WS_VR = 324 * MiB;
constexpr size_t WS_GR = 356 * MiB;
constexpr size_t WS_MIX = 180 * MiB;
constexpr size_t WS_UM = 180 * MiB;
constexpr size_t WS_Y = 48 * MiB;
constexpr size_t WS_RT = 436 * MiB;
constexpr size_t WS_X1 = 436 * MiB;
constexpr size_t WS_NEED = 500 * MiB;
#ifndef GEMM_SP2
#define GEMM_SP2 true
#endif
#ifndef GEMM_ALIGN
#define GEMM_ALIGN true
#endif
#ifndef WGM_IN
#define WGM_IN 4
#endif
#ifndef WGM_OUT
#define WGM_OUT 4
#endif
#ifndef WGM_UP
#define WGM_UP 4
#endif
#ifndef WGM_DN
#define WGM_DN 4
#endif
constexpr int LDS_BYTES = 147456;

struct Params { const float* in[18]; float* out; unsigned char* ws; int ph_lo, ph_hi; float lg[4]; double invf[128]; };

__device__ __forceinline__ float bf2f(unsigned v) { return __uint_as_float(v << 16); }
typedef unsigned u32x2_t __attribute__((ext_vector_type(2)));
__device__ __forceinline__ u32x4 ldnt16(const void* p) { return __builtin_nontemporal_load((const u32x4*)p); }
__device__ __forceinline__ uint2 ldnt8(const void* p) { const u32x2_t t = __builtin_nontemporal_load((const u32x2_t*)p); return make_uint2(t[0], t[1]); }
__device__ __forceinline__ float wave_sum(float v) {
#pragma unroll
    for (int o = 1; o < 64; o <<= 1) v += __shfl_xor(v, o);
    return v;
}
__device__ __forceinline__ float wave_max(float v) {
#pragma unroll
    for (int o = 1; o < 64; o <<= 1) v = fmaxf(v, __shfl_xor(v, o));
    return v;
}
#define LDS_WAIT() asm volatile("s_waitcnt lgkmcnt(0)" ::: "memory")
__device__ __forceinline__ int opaque_tid() { int x = threadIdx.x; asm volatile("" : "+v"(x)); return x; }

__device__ __forceinline__ int win_src(int n) { return n < 2560 ? n : (n < 6656 ? n + 24 : (n < 6680 ? n - 4096 : -1)); }
template <bool WIN, bool GAIN = false>
__device__ __forceinline__ void transpose_pair(const float* W, int ld, int K, int Nout, bf16_t* WT, LAS float* scr, int q, int lane, const float* G = nullptr) {
    const int nblk = Nout / 32, item = 2 * q, kb = item / nblk, nb = item % nblk, k0 = 64 * kb, n0 = 32 * nb;
    const int np0 = n0 + (lane & 31), np1 = np0 + 32, src0 = WIN ? win_src(np0) : np0, src1 = WIN ? win_src(np1) : np1;
    float va[32], vb[32];
#pragma unroll
    for (int i = 0; i < 32; ++i) { const int kk = 2 * i + (lane >> 5); const float* rowp = W + (size_t)(k0 + kk) * ld;
        va[i] = src0 >= 0 ? __builtin_nontemporal_load(rowp + src0) : 0.f; vb[i] = src1 >= 0 ? __builtin_nontemporal_load(rowp + src1) : 0.f;
        if (GAIN) { const float gk = G[k0 + kk]; va[i] *= gk; vb[i] *= gk; } }
    const int c = lane & 7;
#pragma unroll
    for (int half = 0; half < 2; ++half) {
#pragma unroll
        for (int i = 0; i < 32; ++i) { const int kk = 2 * i + (lane >> 5); scr[kk * 33 + (lane & 31)] = half ? vb[i] : va[i]; }
        LDS_WAIT();
#pragma unroll
        for (int j = 0; j < 4; ++j) { const int n = (lane >> 3) + 8 * j; const LAS float* sp = scr + (8 * c) * 33 + n;
            u32x4 o; o.x = cvt_pk_bf16(sp[0 * 33], sp[1 * 33]); o.y = cvt_pk_bf16(sp[2 * 33], sp[3 * 33]); o.z = cvt_pk_bf16(sp[4 * 33], sp[5 * 33]); o.w = cvt_pk_bf16(sp[6 * 33], sp[7 * 33]);
            *(u32x4*)(WT + (size_t)(n0 + 32 * half + n) * K + k0 + 8 * c) = o; }
        LDS_WAIT();
    }
}
__device__ __forceinline__ void sincos_d(double r, double& s, double& c) {
    const double r2 = r * r;
    double ts = 1.0, tc = 1.0, term_s = 1.0, term_c = 1.0;
#pragma unroll
    for (int k = 1; k <= 13; ++k) {
        constexpr double one = 1.0;
        const double ic = -one / (double)((2 * k - 1) * (2 * k)), is = -one / (double)((2 * k) * (2 * k + 1));
        term_c *= r2 * ic; tc += term_c;
        term_s *= r2 * is; ts += term_s;
    }
    s = r * ts; c = tc;
}
__device__ __forceinline__ void p0_prologue(const Params& p, LAS unsigned char* lds, int wave_, int lane_, int gw_, int NGW) {
    const int tid = opaque_tid(), lane = tid & 63, wave = __builtin_amdgcn_readfirstlane(tid >> 6), gw = blockIdx.x * 8 + wave; (void)wave_; (void)lane_; (void)gw_;
    unsigned char* ws = p.ws;
    LAS float* scr = (LAS float*)(lds + wave * 16384);
    constexpr int T_IN = (DM / 64) * (NIN / 32) / 2, T_OUT = (DM / 64) * (DM / 32) / 2, T_UP = (DM / 64) * (DFF / 32) / 2, T_DN = (DFF / 64) * (DM / 32) / 2, T_C1 = (4096 / 64) * (128 / 32) / 2, T_C2 = (128 / 64) * (128 / 32) / 2;
    constexpr int T_DN0 = T_DN - T_DN_TAIL;
    constexpr int NT = T_IN + T_OUT + T_UP + T_DN0 + 2 * T_C1 + 2 * T_C2;
    for (int it = gw; it < NT; it += NGW) {
        int r = it;
        if (r < T_IN) { transpose_pair<true, true>(p.in[2], DIN, DM, NIN, (bf16_t*)(ws + WS_WINT), scr, r, lane, p.in[1]); continue; } r -= T_IN;
        if (r < T_OUT) { transpose_pair<false>(p.in[12], DM, DM, DM, (bf16_t*)(ws + WS_WOUTT), scr, r, lane); continue; } r -= T_OUT;
        if (r < T_UP) { transpose_pair<false, true>(p.in[15], DFF, DM, DFF, (bf16_t*)(ws + WS_WUPT), scr, r, lane, p.in[14]); continue; } r -= T_UP;
        if (r < T_DN0) { transpose_pair<false>(p.in[16], DM, DFF, DM, (bf16_t*)(ws + WS_WDNT), scr, r, lane); continue; } r -= T_DN0;
        if (r < T_C1) { transpose_pair<false>(p.in[4], 128, 4096, 128, (bf16_t*)(ws + WS_CW1T), scr, r, lane); continue; } r -= T_C1;
        if (r < T_C1) { transpose_pair<false>(p.in[8], 128, 4096, 128, (bf16_t*)(ws + WS_CW1T) + 128 * 4096, scr, r, lane); continue; } r -= T_C1;
        if (r < T_C2) { transpose_pair<false>(p.in[6], 128, 128, 128, (bf16_t*)(ws + WS_CW2T), scr, r, lane); continue; } r -= T_C2;
        transpose_pair<false>(p.in[10], 128, 128, 128, (bf16_t*)(ws + WS_CW2T) + 128 * 128, scr, r, lane);
    }
    const float* x = p.in[0]; bf16_t* XB = (bf16_t*)((unsigned char*)p.out + XB_OFF); float* RS0 = (float*)(ws + WS_RSTD0);
    {
        for (int row0 = gw; row0 < MTOK; row0 += 4 * NGW) {
            float4 v[4][8];
#pragma unroll
            for (int r = 0; r < 4; ++r) { const int row = row0 + r * NGW;
                if (row < MTOK) {
#pragma unroll
                    for (int j = 0; j < 8; ++j) { const f32x4 t_ = __builtin_nontemporal_load((const f32x4*)(x + (size_t)row * DM) + lane + 64 * j); v[r][j] = make_float4(t_[0], t_[1], t_[2], t_[3]); }
                } }
#pragma unroll
            for (int r = 0; r < 4; ++r) { const int row = row0 + r * NGW;
                if (row < MTOK) {
                    float s = 0.f;
#pragma unroll
                    for (int j = 0; j < 8; ++j) s += v[r][j].x * v[r][j].x + v[r][j].y * v[r][j].y + v[r][j].z * v[r][j].z + v[r][j].w * v[r][j].w;
                    const float rstd = rsqrtf(wave_sum(s) * (1.0f / DM) + NORM_EPS);
                    if (lane == 0) RS0[row] = 1.0f / rstd;
                    uint2* o = (uint2*)(XB + (size_t)row * DM) + lane;
#pragma unroll
                    for (int j = 0; j < 8; ++j) { uint2 w; w.x = cvt_pk_bf16(v[r][j].x * rstd, v[r][j].y * rstd); w.y = cvt_pk_bf16(v[r][j].z * rstd, v[r][j].w * rstd); o[64 * j] = w; }
                } }
        }
    }
    float2* tab = (float2*)(ws + WS_ROPE);
    for (int idx = gw * 64 + lane; idx < SEQ * 128; idx += NGW * 64) {
        const int pos = idx >> 7, i = idx & 127;
        const float angf = (float)pos * (float)p.invf[i];
        const double ang = (double)angf, twopi = 6.283185307179586476925286766559;
        const double k = rint(ang * 0.15915494309189533576888376337251), r = ang - k * twopi;
        double s, c; sincos_d(r, s, c);
        tab[idx] = make_float2((float)c, (float)s);
    }
    float* CB = (float*)(ws + WS_CB);
    for (int o = gw; o < 8 * 256; o += NGW) {
        const int sl = o >> 8, oc = o & 255, kind = oc >> 7, c = oc & 127;
        const float* pe = kind ? p.in[7] : p.in[3]; const float* w1 = kind ? p.in[8] : p.in[4]; const float* b1 = kind ? p.in[9] : p.in[5];
        float s = 0.f;
#pragma unroll
        for (int i = 0; i < 8; ++i) { const int k = 512 * sl + 64 * i + lane; s += pe[k] * w1[(size_t)k * 128 + c]; }
        s = wave_sum(s);
        if (lane == 0) CB[o] = s + (sl == 0 ? b1[c] : 0.f);
    }
}

__device__ __forceinline__ void p1_tail_weights(const Params& p, LAS unsigned char* lds, int tw, int ntw) {
    const int tid = opaque_tid(), lane = tid & 63, wave = __builtin_amdgcn_readfirstlane(tid >> 6);
    LAS float* scr = (LAS float*)(lds + wave * 16384);
    constexpr int T_DN = (DFF / 64) * (DM / 32) / 2;
    for (int it = T_DN - T_DN_TAIL + tw; it < T_DN; it += ntw) transpose_pair<false>(p.in[16], DM, DFF, DM, (bf16_t*)(p.ws + WS_WDNT), scr, it, lane);
}

struct EpiInProj {
    static constexpr bool PERM = true, AFTER_DRAIN = false;
    bf16_t *QA, *KV6, *QR, *KR, *VR, *GR; float* GATES; const float2* rope; float lg0, lg1, lg2, lg3;
    __device__ __forceinline__ void operator()(const f32x4 (&acc)[2][2][4][2], const pg8::Unit& u, int wr, int wc, int fr, int fq) const {
        const int pn = u.pn, row0 = u.pm * 256 + wr * 64 + fr, cl0 = wc * 32 + 8 * fq;
        if (pn < 10 || (pn >= 18 && pn < 26)) {
            bf16_t* base; int ld;
            if (pn < 4) { base = QA + pn * 256; ld = 1024; }
            else if (pn < 10) { base = KV6 + (size_t)(pn - 4) * MTOK * 256; ld = 256; }
            else if (pn < 22) { base = VR + (pn - 18) * 256; ld = 1024; }
            else { base = GR + (pn - 22) * 256; ld = 1024; }
#pragma unroll
            for (int ai = 0; ai < 2; ++ai)
#pragma unroll
                for (int m = 0; m < 4; ++m) { bf16_t* rowp = base + (size_t)(row0 + ai * 128 + m * 16) * ld + cl0;
#pragma unroll
                    for (int bj = 0; bj < 2; ++bj) { f32x4 v0 = acc[ai][bj][m][0], v1 = acc[ai][bj][m][1];
                        u32x4 w; w.x = cvt_pk_bf16(v0[0], v0[1]); w.y = cvt_pk_bf16(v0[2], v0[3]); w.z = cvt_pk_bf16(v1[0], v1[1]); w.w = cvt_pk_bf16(v1[2], v1[3]);
                        *(u32x4*)(rowp + bj * 128) = w; } }
        } else if (pn < 18) {
            const bool isk = pn >= 14; const int hh = (pn - 10) & 3; bf16_t* base = (isk ? KR : QR) + hh * 256;
            const float lgh = hh == 0 ? lg0 : (hh == 1 ? lg1 : (hh == 2 ? lg2 : lg3));
#pragma unroll
            for (int ai = 0; ai < 2; ++ai)
#pragma unroll
                for (int m = 0; m < 4; ++m) { const int row = row0 + ai * 128 + m * 16, pos = row & (SEQ - 1);
                    const float ef = (float)((pos & 127) + 1) * lgh; const float sc = isk ? 0.0625f * __expf(-ef) : __expf(ef);
                    const float4* t4 = (const float4*)(rope + (size_t)pos * 128 + cl0);
                    const float4 ta = t4[0], tb = t4[1], tc = t4[2], td = t4[3];
                    const f32x4 a0 = acc[ai][0][m][0], a1 = acc[ai][0][m][1], b0 = acc[ai][1][m][0], b1 = acc[ai][1][m][1];
                    float o1[8], o2[8];
                    o1[0] = a0[0] * ta.x - b0[0] * ta.y; o2[0] = b0[0] * ta.x + a0[0] * ta.y;
                    o1[1] = a0[1] * ta.z - b0[1] * ta.w; o2[1] = b0[1] * ta.z + a0[1] * ta.w;
                    o1[2] = a0[2] * tb.x - b0[2] * tb.y; o2[2] = b0[2] * tb.x + a0[2] * tb.y;
                    o1[3] = a0[3] * tb.z - b0[3] * tb.w; o2[3] = b0[3] * tb.z + a0[3] * tb.w;
                    o1[4] = a1[0] * tc.x - b1[0] * tc.y; o2[4] = b1[0] * tc.x + a1[0] * tc.y;
                    o1[5] = a1[1] * tc.z - b1[1] * tc.w; o2[5] = b1[1] * tc.z + a1[1] * tc.w;
                    o1[6] = a1[2] * td.x - b1[2] * td.y; o2[6] = b1[2] * td.x + a1[2] * td.y;
                    o1[7] = a1[3] * td.z - b1[3] * td.w; o2[7] = b1[3] * td.z + a1[3] * td.w;
                    u32x4 w1, w2;
                    w1.x = cvt_pk_bf16(o1[0] * sc, o1[1] * sc); w1.y = cvt_pk_bf16(o1[2] * sc, o1[3] * sc); w1.z = cvt_pk_bf16(o1[4] * sc, o1[5] * sc); w1.w = cvt_pk_bf16(o1[6] * sc, o1[7] * sc);
                    w2.x = cvt_pk_bf16(o2[0] * sc, o2[1] * sc); w2.y = cvt_pk_bf16(o2[2] * sc, o2[3] * sc); w2.z = cvt_pk_bf16(o2[4] * sc, o2[5] * sc); w2.w = cvt_pk_bf16(o2[6] * sc, o2[7] * sc);
                    bf16_t* rowp = base + (size_t)row * 1024 + cl0;
                    *(u32x4*)(rowp) = w1; *(u32x4*)(rowp + 128) = w2; }
        } else {
            if (wc == 0 && fq < 3) {
#pragma unroll
                for (int ai = 0; ai < 2; ++ai)
#pragma unroll
                    for (int m = 0; m < 4; ++m) { const int row = row0 + ai * 128 + m * 16; float* gp = GATES + (size_t)row * 24 + 8 * fq;
                        f32x4 v0 = acc[ai][0][m][0], v1 = acc[ai][0][m][1];
                        *(f32x4*)gp = v0; *(f32x4*)(gp + 4) = v1; }
            }
        }
    }
};
struct RevOrder : pg8::StaticOrder {
    __device__ bool next(int i, pg8::Unit& u) const { const bool ok = pg8::StaticOrder::next(i, u); if (ok) u.pm = nM - 1 - u.pm; return ok; }
};
struct EpiBf16Plain {
    static constexpr bool PERM = true, AFTER_DRAIN = false;
    bf16_t* O; int ldc;
    __device__ __forceinline__ void operator()(const f32x4 (&acc)[2][2][4][2], const pg8::Unit& u, int wr, int wc, int fr, int fq) const {
        const int row0 = u.pm * 256 + wr * 64 + fr, col0 = u.pn * 256 + wc * 32 + 8 * fq;
#pragma unroll
        for (int ai = 0; ai < 2; ++ai)
#pragma unroll
            for (int m = 0; m < 4; ++m) { bf16_t* rowp = O + (size_t)(row0 + ai * 128 + m * 16) * ldc + col0;
#pragma unroll
                for (int bj = 0; bj < 2; ++bj) { const f32x4 v0 = acc[ai][bj][m][0], v1 = acc[ai][bj][m][1];
                    u32x4 w; w.x = cvt_pk_bf16(v0[0], v0[1]); w.y = cvt_pk_bf16(v0[2], v0[3]); w.z = cvt_pk_bf16(v1[0], v1[1]); w.w = cvt_pk_bf16(v1[2], v1[3]);
                    *(u32x4*)(rowp + bj * 128) = w; } }
    }
};
struct EpiRelu2 {
    static constexpr bool PERM = true, AFTER_DRAIN = false;
    bf16_t* O; int ldc;
    __device__ __forceinline__ void operator()(const f32x4 (&acc)[2][2][4][2], const pg8::Unit& u, int wr, int wc, int fr, int fq) const {
        const int row0 = u.pm * 256 + wr * 64 + fr, col0 = u.pn * 256 + wc * 32 + 8 * fq;
#pragma unroll
        for (int ai = 0; ai < 2; ++ai)
#pragma unroll
            for (int m = 0; m < 4; ++m) { bf16_t* rowp = O + (size_t)(row0 + ai * 128 + m * 16) * ldc + col0;
#pragma unroll
                for (int bj = 0; bj < 2; ++bj) { f32x4 v0 = acc[ai][bj][m][0], v1 = acc[ai][bj][m][1];
#pragma unroll
                    for (int e = 0; e < 4; ++e) { const float a = fmaxf(v0[e], 0.f), b = fmaxf(v1[e], 0.f); v0[e] = a * a; v1[e] = b * b; }
                    u32x4 w; w.x = cvt_pk_bf16(v0[0], v0[1]); w.y = cvt_pk_bf16(v0[2], v0[3]); w.z = cvt_pk_bf16(v1[0], v1[1]); w.w = cvt_pk_bf16(v1[2], v1[3]);
                    *(u32x4*)(rowp + bj * 128) = w; } }
    }
};

__device__ __forceinline__ void p6_resnorm(const Params& p, LAS unsigned char* lds, int NGW) {
    const int tid = opaque_tid(), lane = tid & 63, gw = blockIdx.x * 8 + __builtin_amdgcn_readfirstlane(tid >> 6);
    const bf16_t* xb = (const bf16_t*)((const unsigned char*)p.out + XB_OFF); const bf16_t* mix = (const bf16_t*)(p.ws + WS_MIX);
    float* RS2 = (float*)(p.ws + WS_RSTD2); const float* RS0 = (const float*)(p.ws + WS_RSTD0);
    LAS f32x4* gl1 = (LAS f32x4*)lds;
    __syncthreads();
    gl1[tid] = ((const f32x4*)p.in[13])[tid];
    __syncthreads();
    for (int row0 = gw; row0 < MTOK; row0 += 4 * NGW) {
        uint2 cm[4][8], cx[4][8];
#pragma unroll
        for (int r = 0; r < 4; ++r) { const int row = row0 + r * NGW;
            if (row < MTOK) {
#pragma unroll
                for (int j = 0; j < 8; ++j) { cm[r][j] = ldnt8((const uint2*)(mix + (size_t)row * DM) + lane + 64 * j); cx[r][j] = ldnt8((const uint2*)(xb + (size_t)row * DM) + lane + 64 * j); }
            } }
#pragma unroll
        for (int r = 0; r < 4; ++r) { const int row = row0 + r * NGW;
            if (row < MTOK) {
                float4 v[8]; float s = 0.f;
#pragma unroll
                for (int j = 0; j < 8; ++j) { v[j] = make_float4(bf2f(cm[r][j].x & 0xffffu), bf2f(cm[r][j].x >> 16), bf2f(cm[r][j].y & 0xffffu), bf2f(cm[r][j].y >> 16));
                    s += v[j].x * v[j].x + v[j].y * v[j].y + v[j].z * v[j].z + v[j].w * v[j].w; }
                const float rstd = rsqrtf(wave_sum(s) * (1.0f / DM) + NORM_EPS), rms0 = RS0[row];
                float s2 = 0.f; uint2* orow = (uint2*)((bf16_t*)(p.ws + WS_X1) + (size_t)row * DM) + lane;
#pragma unroll
                for (int j = 0; j < 8; ++j) { const f32x4 g = gl1[lane + 64 * j]; const uint2 xw0 = cx[r][j];
                    v[j].x = bf2f(xw0.x & 0xffffu) * rms0 + v[j].x * rstd * g[0]; v[j].y = bf2f(xw0.x >> 16) * rms0 + v[j].y * rstd * g[1]; v[j].z = bf2f(xw0.y & 0xffffu) * rms0 + v[j].z * rstd * g[2]; v[j].w = bf2f(xw0.y >> 16) * rms0 + v[j].w * rstd * g[3];
                    s2 += v[j].x * v[j].x + v[j].y * v[j].y + v[j].z * v[j].z + v[j].w * v[j].w; }
                const float rstd2 = rsqrtf(wave_sum(s2) * (1.0f / DM) + NORM_EPS);
                if (lane == 0) RS2[row] = 1.0f / rstd2;
#pragma unroll
                for (int j = 0; j < 8; ++j) { uint2 xw; xw.x = cvt_pk_bf16(v[j].x * rstd2, v[j].y * rstd2); xw.y = cvt_pk_bf16(v[j].z * rstd2, v[j].w * rstd2); orow[64 * j] = xw; }
            } }
    }
}
__device__ __forceinline__ void p9_final(const Params& p, LAS unsigned char* lds, int NGW) {
    const int tid = opaque_tid(), lane = tid & 63, gw = blockIdx.x * 8 + __builtin_amdgcn_readfirstlane(tid >> 6);
    const bf16_t* y = (const bf16_t*)(p.ws + WS_Y);
    LAS f32x4* gl = (LAS f32x4*)lds;
    __syncthreads();
    gl[tid] = ((const f32x4*)p.in[17])[tid];
    __syncthreads();
    for (int row0 = gw; row0 < MTOK; row0 += 3 * NGW) {
        uint2 cy[3][8], co[3][8];
#pragma unroll
        for (int r = 0; r < 3; ++r) { const int row = row0 + r * NGW;
            if (row < MTOK) {
#pragma unroll
                for (int j = 0; j < 8; ++j) { cy[r][j] = ldnt8((const uint2*)(y + (size_t)row * DM) + lane + 64 * j); co[r][j] = ldnt8((const uint2*)((const bf16_t*)(p.ws + WS_X1) + (size_t)row * DM) + lane + 64 * j); }
            } }
#pragma unroll
        for (int r = 0; r < 3; ++r) { const int row = row0 + r * NGW;
            if (row < MTOK) {
                float4 v[8]; float s = 0.f;
#pragma unroll
                for (int j = 0; j < 8; ++j) { v[j] = make_float4(bf2f(cy[r][j].x & 0xffffu), bf2f(cy[r][j].x >> 16), bf2f(cy[r][j].y & 0xffffu), bf2f(cy[r][j].y >> 16));
                    s += v[j].x * v[j].x + v[j].y * v[j].y + v[j].z * v[j].z + v[j].w * v[j].w; }
                const float rstd = rsqrtf(wave_sum(s) * (1.0f / DM) + NORM_EPS), rms2 = ((const float*)(p.ws + WS_RSTD2))[row];
                float4* orow = (float4*)(p.out + (size_t)row * DM) + lane;
#pragma unroll
                for (int j = 0; j < 8; ++j) { const f32x4 g = gl[lane + 64 * j]; const uint2 xw = co[r][j]; float4 o;
                    o.x = bf2f(xw.x & 0xffffu) * rms2 + v[j].x * rstd * g[0]; o.y = bf2f(xw.x >> 16) * rms2 + v[j].y * rstd * g[1]; o.z = bf2f(xw.y & 0xffffu) * rms2 + v[j].z * rstd * g[2]; o.w = bf2f(xw.y >> 16) * rms2 + v[j].w * rstd * g[3];
                    __builtin_nontemporal_store(o.x, &((float*)(orow + 64 * j))[0]); __builtin_nontemporal_store(o.y, &((float*)(orow + 64 * j))[1]); __builtin_nontemporal_store(o.z, &((float*)(orow + 64 * j))[2]); __builtin_nontemporal_store(o.w, &((float*)(orow + 64 * j))[3]); }
            } }
    }
}

__device__ __forceinline__ int t5_bucket(int rel) {
    const int n = rel > 0 ? rel : 0;
    if (n < 16) return n;
    const float nf = (float)n;
    int large = 16 + (int)(logf(nf / 16.0f) / 2.0794415416798357f * 16.0f);
    return large < 31 ? large : 31;
}

typedef short v4s __attribute__((ext_vector_type(4)));
__device__ __forceinline__ f32x4 mfma16(bf16x8 a, bf16x8 b, f32x4 c) { return __builtin_amdgcn_mfma_f32_16x16x32_bf16(a, b, c, 0, 0, 0); }
__device__ __forceinline__ bf16x8 tr_frag(const LAS bf16_t* X, int ld, int c0, int n0, int lane) {
    const int fq = lane >> 4, q = (lane & 15) >> 2, pq = lane & 3;
    const LAS bf16_t* a0 = X + (c0 + 4 * fq + q) * ld + n0 + 4 * pq;
    const v4s lo = __builtin_amdgcn_ds_read_tr16_b64_v4i16((LAS v4s*)a0);
    const v4s hi = __builtin_amdgcn_ds_read_tr16_b64_v4i16((LAS v4s*)(a0 + 16 * ld));
    return (bf16x8){lo[0], lo[1], lo[2], lo[3], hi[0], hi[1], hi[2], hi[3]};
}
__device__ __forceinline__ bf16x8 pack8(f32x4 a, f32x4 b) {
    u32x4 w; w.x = cvt_pk_bf16(a[0], a[1]); w.y = cvt_pk_bf16(a[2], a[3]); w.z = cvt_pk_bf16(b[0], b[1]); w.w = cvt_pk_bf16(b[2], b[3]);
    return __builtin_bit_cast(bf16x8, w);
}
__device__ __forceinline__ void swap16(unsigned& a, unsigned& b) { const auto r = __builtin_amdgcn_permlane16_swap(a, b, false, false); a = r[0]; b = r[1]; }
__device__ __forceinline__ void swap16f(float& a, float& b) { unsigned x = __float_as_uint(a), y = __float_as_uint(b); swap16(x, y); a = __uint_as_float(x); b = __uint_as_float(y); }
constexpr int RLD = 272;

__device__ __forceinline__ void stage_128x256(const bf16_t* g, LAS bf16_t* X, int tid) {
#pragma unroll
    for (int k = 0; k < 8; ++k) { const int pc = tid + 512 * k, r = pc >> 5, c8 = pc & 31;
        const u32x4 v = ldnt16(g + (size_t)r * 1024 + 8 * c8);
        *(LAS u32x4*)(X + r * RLD + 8 * c8) = v; }
}
__device__ __forceinline__ void mf_ret_u_items(const Params& p, int first, int stride, LAS unsigned char* lds) {
    const int tid = opaque_tid(), lane = tid & 63, wave = __builtin_amdgcn_readfirstlane(tid >> 6);
    unsigned char* ws = p.ws;
    LAS bf16_t* Kl = (LAS bf16_t*)lds; LAS bf16_t* Vl = Kl + 128 * RLD;
    const int wr = wave >> 1, wc = wave & 1, fr = lane & 15, fq = lane >> 4;
    u32x4 kst[8], vst[8];
#define RU_LOAD(bhn_) do { const int n_ = (bhn_) & 63, bh_ = (bhn_) >> 6; const size_t row0_ = (size_t)(bh_ >> 2) * SEQ + n_ * 128; \
        const bf16_t* kg_ = (const bf16_t*)(ws + WS_KR) + row0_ * 1024 + (bh_ & 3) * 256; const bf16_t* vg_ = (const bf16_t*)(ws + WS_VR) + row0_ * 1024 + (bh_ & 3) * 256; \
        _Pragma("unroll") for (int k_ = 0; k_ < 8; ++k_) { const int pc_ = tid + 512 * k_, r_ = pc_ >> 5, c8_ = pc_ & 31; \
            kst[k_] = *(const u32x4*)(kg_ + (size_t)r_ * 1024 + 8 * c8_); vst[k_] = *(const u32x4*)(vg_ + (size_t)r_ * 1024 + 8 * c8_); } } while (0)
    if (first < 512) RU_LOAD(first);
#pragma unroll 1
    for (int bhn = first; bhn < 512; bhn += stride) {
#pragma unroll
        for (int k = 0; k < 8; ++k) { const int pc = tid + 512 * k, r = pc >> 5, c8 = pc & 31; *(LAS u32x4*)(Kl + r * RLD + 8 * c8) = kst[k]; *(LAS u32x4*)(Vl + r * RLD + 8 * c8) = vst[k]; }
        __syncthreads();
        if (bhn + stride < 512) RU_LOAD(bhn + stride);
        bf16_t* UT = (bf16_t*)p.out + (size_t)bhn * 65536;
#pragma unroll 1
        for (int hf = 0; hf < 2; ++hf) {
            const int dk0 = 128 * wc + 64 * hf;
            f32x4 acc[4][4];
#pragma unroll
            for (int m = 0; m < 4; ++m)
#pragma unroll
                for (int nn = 0; nn < 4; ++nn) acc[m][nn] = (f32x4){0.f, 0.f, 0.f, 0.f};
#pragma unroll
            for (int kc = 0; kc < 4; ++kc) {
                bf16x8 a[4], bb[4];
#pragma unroll
                for (int m = 0; m < 4; ++m) a[m] = tr_frag(Vl, RLD, 32 * kc, 64 * wr + 16 * m, lane);
#pragma unroll
                for (int nn = 0; nn < 4; ++nn) bb[nn] = tr_frag(Kl, RLD, 32 * kc, dk0 + 16 * nn, lane);
#pragma unroll
                for (int m = 0; m < 4; ++m)
#pragma unroll
                    for (int nn = 0; nn < 4; ++nn) acc[m][nn] = mfma16(bb[nn], a[m], acc[m][nn]);
            }
#pragma unroll
            for (int m = 0; m < 4; ++m)
#pragma unroll
                for (int P = 0; P < 2; ++P) {
                    unsigned ax = cvt_pk_bf16(acc[m][2 * P][0], acc[m][2 * P][1]), ay = cvt_pk_bf16(acc[m][2 * P][2], acc[m][2 * P][3]);
                    unsigned bx = cvt_pk_bf16(acc[m][2 * P + 1][0], acc[m][2 * P + 1][1]), by = cvt_pk_bf16(acc[m][2 * P + 1][2], acc[m][2 * P + 1][3]);
                    swap16(ax, bx); swap16(ay, by);
                    *(u32x4*)(UT + (size_t)(64 * wr + 16 * m + fr) * 256 + dk0 + 32 * P + 16 * (fq & 1) + 8 * (fq >> 1)) = (u32x4){ax, ay, bx, by};
                }
        }
        __syncthreads();
    }
#undef RU_LOAD
}
__device__ __forceinline__ void mf_ret_scan(const Params& p, int gtid, int gthreads) {
    const bf16_t* UT = (const bf16_t*)p.out; bf16_t* RT = (bf16_t*)(p.ws + WS_RT);
    for (int e4 = gtid; e4 < 8 * 16384; e4 += gthreads) {
        const int bh = e4 >> 14, el = (e4 & 16383) * 4, h = bh & 3;
        const float gc = __expf(128.0f * p.lg[h]);
        float4 r = make_float4(0.f, 0.f, 0.f, 0.f);
        const bf16_t* up = UT + (size_t)bh * 64 * 65536 + el; bf16_t* rp = RT + (size_t)bh * 64 * 65536 + el;
#pragma unroll 8
        for (int n = 0; n < 64; ++n) {
            const uint2 uw = ldnt8(up + (size_t)n * 65536);
            const float4 u = make_float4(bf2f(uw.x & 0xffffu), bf2f(uw.x >> 16), bf2f(uw.y & 0xffffu), bf2f(uw.y >> 16));
            uint2 w; w.x = cvt_pk_bf16(r.x, r.y); w.y = cvt_pk_bf16(r.z, r.w); *(uint2*)(rp + (size_t)n * 65536) = w;
            r.x = gc * (r.x + u.x); r.y = gc * (r.y + u.y); r.z = gc * (r.z + u.z); r.w = gc * (r.w + u.w);
        }
    }
}
constexpr int RO_RT = 128 * RLD * 2;
__device__ __forceinline__ void mf_ret_out(const Params& p, int bhn, LAS unsigned char* lds, int tid_, int wave_, int lane_) {
    const int tid = opaque_tid(), lane = tid & 63, wave = __builtin_amdgcn_readfirstlane(tid >> 6); (void)tid_; (void)wave_; (void)lane_;
    unsigned char* ws = p.ws;
    const int n = bhn & 63, bh = bhn >> 6, b = bh >> 2, h = bh & 3;
    const size_t row0 = (size_t)b * SEQ + n * 128;
    LAS bf16_t* Vl = (LAS bf16_t*)lds;
    const bf16_t* Rg = (const bf16_t*)(ws + WS_RT) + (size_t)bhn * 65536;
    const int srow = tid >> 4, sch = tid & 15;
    const int fr = lane & 15, fq = lane >> 4;
    const bf16_t* Qg = (const bf16_t*)(ws + WS_QR) + (row0 + 16 * wave + fr) * 1024 + h * 256 + 8 * fq;
    bf16x8 qf[8];
#pragma unroll
    for (int kc = 0; kc < 8; ++kc) qf[kc] = __builtin_bit_cast(bf16x8, ldnt16(Qg + 32 * kc));
    u32x4 rstg[8];
    { const bf16_t* Kt = (const bf16_t*)(ws + WS_KR) + row0 * 1024 + h * 256;
#pragma unroll
      for (int k = 0; k < 8; ++k) { const int pc = tid + 512 * k, r = pc >> 5, c8 = pc & 31; rstg[k] = ldnt16(Kt + (size_t)r * 1024 + 8 * c8); } }
    stage_128x256((const bf16_t*)(ws + WS_VR) + row0 * 1024 + h * 256, Vl, tid);
#pragma unroll
    for (int k = 0; k < 8; ++k) { const int pc = tid + 512 * k, r = pc >> 5, c8 = pc & 31; *(LAS u32x4*)(lds + RO_RT + r * 512 + (((c8 & 16) | ((c8 ^ r) & 15)) << 4)) = rstg[k]; }
#pragma unroll
    for (int k = 0; k < 8; ++k) rstg[k] = ldnt16(Rg + (size_t)(srow + 32 * k) * 256 + 8 * sch);
    __syncthreads();
    f32x4 st[8];
#pragma unroll
    for (int jt = 0; jt < 8; ++jt) {
        st[jt] = (f32x4){0.f, 0.f, 0.f, 0.f};
        if (jt <= wave) {
            bf16x8 kfr[8];
#pragma unroll
            for (int kc = 0; kc < 8; ++kc) { const int ch = 4 * kc + fq; kfr[kc] = *(const LAS bf16x8*)(lds + RO_RT + (16 * jt + fr) * 512 + (((ch & 16) | ((ch ^ fr) & 15)) << 4)); }
#pragma unroll
            for (int kc = 0; kc < 8; ++kc) st[jt] = mfma16(kfr[kc], qf[kc], st[jt]);
            if (jt == wave) {
#pragma unroll
                for (int r = 0; r < 4; ++r) if (4 * fq + r > fr) st[jt][r] = 0.f;
            }
        }
    }
    __syncthreads();
#pragma unroll
    for (int k = 0; k < 8; ++k) { const int r = srow + 32 * k; *(LAS u32x4*)(lds + RO_RT + r * 256 + ((sch ^ (r & 15)) << 4)) = rstg[k]; }
#pragma unroll
    for (int k = 0; k < 8; ++k) rstg[k] = ldnt16(Rg + (size_t)(srow + 32 * k) * 256 + 128 + 8 * sch);
    const bf16_t* Gg = (const bf16_t*)(ws + WS_GR) + (row0 + 16 * wave + fr) * 1024 + h * 256 + 8 * (fq >> 1) + 16 * (fq & 1);
    u32x4 gwv[8];
#pragma unroll
    for (int P = 0; P < 8; ++P) gwv[P] = ldnt16(Gg + 32 * P);
    f32x4 acc[16];
#pragma unroll
    for (int dt = 0; dt < 16; ++dt) acc[dt] = (f32x4){0.f, 0.f, 0.f, 0.f};
#pragma unroll
    for (int C = 0; C < 4; ++C) {
        if (2 * C <= wave) {
            const bf16x8 pb = pack8(st[2 * C], st[2 * C + 1]);
#pragma unroll
            for (int dt = 0; dt < 16; ++dt) acc[dt] = mfma16(tr_frag(Vl, RLD, 32 * C, 16 * dt, lane), pb, acc[dt]);
        }
    }
    __syncthreads();
    const unsigned rbase = (unsigned)(RO_RT + fr * 256);
#pragma unroll 1
    for (int hf = 0; hf < 2; ++hf) {
        if (hf == 1) {
            __syncthreads();
#pragma unroll
            for (int k = 0; k < 8; ++k) { const int r = srow + 32 * k; *(LAS u32x4*)(lds + RO_RT + r * 256 + ((sch ^ (r & 15)) << 4)) = rstg[k]; }
            __syncthreads();
        }
#pragma unroll
        for (int kc = 0; kc < 4; ++kc) {
            const unsigned coff = (unsigned)(((4 * kc + fq) ^ fr) << 4);
            const bf16x8 qv = hf ? qf[4 + kc] : qf[kc];
#pragma unroll
            for (int dt = 0; dt < 16; ++dt) acc[dt] = mfma16(*(const LAS bf16x8*)(lds + rbase + dt * 4096 + coff), qv, acc[dt]);
        }
    }
    float s = 0.f;
#pragma unroll
    for (int dt = 0; dt < 16; ++dt) s += (acc[dt][0] + acc[dt][1]) + (acc[dt][2] + acc[dt][3]);
    s += __shfl_xor(s, 16); s += __shfl_xor(s, 32);
    const float mu = s * (1.0f / 256.0f);
    float q = 0.f;
#pragma unroll
    for (int dt = 0; dt < 16; ++dt)
#pragma unroll
        for (int r = 0; r < 4; ++r) { const float d = acc[dt][r] - mu; q += d * d; }
    q += __shfl_xor(q, 16); q += __shfl_xor(q, 32);
    const float rstd = rsqrtf(q * (1.0f / 256.0f) + GN_EPS);
    bf16_t* Og = (bf16_t*)(ws + WS_H) + (row0 + 16 * wave + fr) * 2048 + 1024 + h * 256 + 8 * (fq >> 1) + 16 * (fq & 1);
#pragma unroll
    for (int P = 0; P < 8; ++P) {
        float v[8];
#pragma unroll
        for (int r = 0; r < 4; ++r) { float a_ = acc[2 * P][r], b_ = acc[2 * P + 1][r]; swap16f(a_, b_); v[r] = (a_ - mu) * rstd; v[4 + r] = (b_ - mu) * rstd; }
        const u32x4 gw = gwv[P];
        const unsigned gwd[4] = {gw.x, gw.y, gw.z, gw.w};
        unsigned wd[4];
#pragma unroll
        for (int k = 0; k < 4; ++k) {
            const float g0 = bf2f(gwd[k] & 0xffffu), g1 = bf2f(gwd[k] >> 16);
            wd[k] = cvt_pk_bf16(g0 * __builtin_amdgcn_rcpf(1.0f + __expf(-g0)) * v[2 * k], g1 * __builtin_amdgcn_rcpf(1.0f + __expf(-g1)) * v[2 * k + 1]);
        }
        *(u32x4*)(Og + 32 * P) = (u32x4){wd[0], wd[1], wd[2], wd[3]};
    }
    __syncthreads();
}
__device__ __forceinline__ void mf_compress(const Params& p, int item, LAS unsigned char* lds, int tid_, int wave_, int lane_) {
    const int tid = opaque_tid(), lane = tid & 63, wave = __builtin_amdgcn_readfirstlane(tid >> 6); (void)tid_; (void)wave_; (void)lane_;
    unsigned char* ws = p.ws;
    const int T = item & 31, g = (item >> 5) & 1, b = (item >> 6) & 1, kind = item >> 7;
    const int fr = lane & 15, fq = lane >> 4;
    const bf16_t* KV = (const bf16_t*)(ws + WS_KV6) + (size_t)kind * MTOK * 256;
    const bf16_t* W1T = (const bf16_t*)(ws + WS_CW1T) + (size_t)kind * 128 * 4096;
    const bf16_t* W2T = (const bf16_t*)(ws + WS_CW2T) + (size_t)kind * 128 * 128;
    const float* CB = (const float*)(ws + WS_CB) + kind * 128;
    LAS float* red = (LAS float*)lds;
    LAS bf16_t* hid = (LAS bf16_t*)(lds + 65536);
    f32x4 acc[8];
#pragma unroll
    for (int ct = 0; ct < 8; ++ct) acc[ct] = (f32x4){0.f, 0.f, 0.f, 0.f};
    const int nblk = 16 * T + fr;
#pragma unroll
    for (int ll = 0; ll < 4; ++ll) {
        const int l = 4 * wave + ll;
        int tok = 16 * nblk + l; tok = tok < SEQ ? tok : SEQ - 1;
        const bf16_t* Ag = KV + ((size_t)b * SEQ + tok) * 256 + g * 128 + 8 * fq;
#pragma unroll
        for (int kc = 0; kc < 4; ++kc) {
            const bf16x8 a = *(const bf16x8*)(Ag + 32 * kc);
#pragma unroll
            for (int ct = 0; ct < 8; ++ct) acc[ct] = mfma16(a, *(const bf16x8*)(W1T + (size_t)(16 * ct + fr) * 4096 + l * 128 + 32 * kc + 8 * fq), acc[ct]);
        }
    }
#pragma unroll
    for (int ct = 0; ct < 8; ++ct)
#pragma unroll
        for (int r = 0; r < 4; ++r) red[(wave * 16 + 4 * fq + r) * 128 + 16 * ct + fr] = acc[ct][r];
    __syncthreads();
    for (int idx = tid; idx < 2048; idx += 512) {
        const int nn = idx >> 7, c = idx & 127; float hsum = 0.f;
#pragma unroll
        for (int sl = 0; sl < 8; ++sl) hsum += CB[sl * 256 + c];
#pragma unroll
        for (int w = 0; w < 8; ++w) hsum += red[(w * 16 + nn) * 128 + c];
        const float x3 = hsum * hsum * hsum;
        hsum = 0.5f * hsum * (1.0f + tanhf(0.7978845608028654f * (hsum + 0.044715f * x3)));
        hid[nn * 136 + c] = (bf16_t)(cvt_pk_bf16(hsum, 0.f) & 0xffffu);
    }
    __syncthreads();
    f32x4 o = (f32x4){0.f, 0.f, 0.f, 0.f};
#pragma unroll
    for (int kc = 0; kc < 4; ++kc)
        o = mfma16(*(const LAS bf16x8*)(hid + fr * 136 + 32 * kc + 8 * fq), *(const bf16x8*)(W2T + (size_t)(16 * wave + fr) * 128 + 32 * kc + 8 * fq), o);
    {
        bf16_t* OC = (bf16_t*)(ws + (kind == 0 ? WS_KC : WS_VCT)) + ((size_t)(b * 2 + g) * NCMPP + 16 * T) * 128 + 16 * wave + fr;
#pragma unroll
        for (int r = 0; r < 4; ++r) OC[(4 * fq + r) * 128] = (bf16_t)(cvt_pk_bf16(o[r], 0.f) & 0xffffu);
    }
    __syncthreads();
}


constexpr int ALD = 144;
constexpr int A_KV = 0, A_KVBUF = 32768, A_VOFF = 16384, A_SEL = 98304, A_BIAS = 99328, A_IMP = 103424, IMPLD = 129;
constexpr float QK_SCALE = 0.08838834764831845f;

__device__ __forceinline__ u32x4 ldg16(const void* ubase, unsigned voff) { return *(const u32x4*)((const char*)ubase + voff); }
__device__ __forceinline__ bf16x8 ldg_frag(const void* ubase, unsigned voff) { return __builtin_bit_cast(bf16x8, *(const u32x4*)((const char*)ubase + voff)); }
__device__ __forceinline__ bf16x8 lds_frag(LAS unsigned char* lds, unsigned off) { return *(const LAS bf16x8*)(lds + off); }
__device__ __forceinline__ bf16x8 tr_frag_b(LAS unsigned char* lds, unsigned off, unsigned hi16) {
    const v4s lo = __builtin_amdgcn_ds_read_tr16_b64_v4i16((LAS v4s*)(lds + off));
    const v4s hi = __builtin_amdgcn_ds_read_tr16_b64_v4i16((LAS v4s*)(lds + off + hi16));
    return (bf16x8){lo[0], lo[1], lo[2], lo[3], hi[0], hi[1], hi[2], hi[3]};
}
constexpr float LOG2E = 1.4426950408889634f, C1 = QK_SCALE * LOG2E, RESCALE_THR = 8.0f;
__device__ __forceinline__ float ex2(float x) { return __builtin_amdgcn_exp2f(x); }
__device__ __forceinline__ void lds_addfix(LAS unsigned* pz, float v) { (void)__hip_atomic_fetch_add(pz, (unsigned)__float2uint_rn(v * 67108864.0f), __ATOMIC_RELAXED, __HIP_MEMORY_SCOPE_WORKGROUP); }
__device__ __forceinline__ int sum8_dpp(int v) {
    v += __builtin_amdgcn_mov_dpp(v, 0xB1, 0xf, 0xf, true);
    v += __builtin_amdgcn_mov_dpp(v, 0x4E, 0xf, 0xf, true);
    v += __builtin_amdgcn_mov_dpp(v, 0x141, 0xf, 0xf, true);
    return v;
}
__device__ __forceinline__ float max16(const f32x4& a, const f32x4& b, const f32x4& c, const f32x4& d) {
    return fmaxf(fmaxf(fmaxf(fmaxf(a[0], a[1]), fmaxf(a[2], a[3])), fmaxf(fmaxf(b[0], b[1]), fmaxf(b[2], b[3]))),
                 fmaxf(fmaxf(fmaxf(c[0], c[1]), fmaxf(c[2], c[3])), fmaxf(fmaxf(d[0], d[1]), fmaxf(d[2], d[3]))));
}
typedef int v2i __attribute__((ext_vector_type(2)));
#define TR_READ_ASM(dst, addr, off) asm volatile("ds_read_b64_tr_b16 %0, %1 offset:%2" : "=v"(dst) : "v"(addr), "i"(off))
__device__ __forceinline__ bf16x8 ldg_qfrag(const void* ubase, unsigned voff) {
    const u32x4 v = ldnt16((const char*)ubase + voff); u32x4 w;
    w.x = cvt_pk_bf16(bf2f(v.x & 0xffffu) * C1, bf2f(v.x >> 16) * C1); w.y = cvt_pk_bf16(bf2f(v.y & 0xffffu) * C1, bf2f(v.y >> 16) * C1);
    w.z = cvt_pk_bf16(bf2f(v.z & 0xffffu) * C1, bf2f(v.z >> 16) * C1); w.w = cvt_pk_bf16(bf2f(v.w & 0xffffu) * C1, bf2f(v.w >> 16) * C1);
    return __builtin_bit_cast(bf16x8, w);
}
__device__ __forceinline__ void mf_nsa(const Params& p, int bg, int c, LAS unsigned char* lds, int tid_, int wave_, int lane_) {
    const int tid = opaque_tid(), lane = tid & 63, wave = __builtin_amdgcn_readfirstlane(tid >> 6); (void)tid_; (void)wave_; (void)lane_;
    unsigned char* ws = p.ws;
    const int b = bg >> 1, g = bg & 1, fr = lane & 15, fq = lane >> 4, hg = wave >> 1, th = wave & 1, h = 4 * g + hg;
    LAS unsigned* imp = (LAS unsigned*)(lds + A_IMP); LAS unsigned* sel = (LAS unsigned*)(lds + A_SEL); LAS float* biasT = (LAS float*)(lds + A_BIAS);
    const float* t5 = p.in[11];
    for (int i = tid; i < 64 * IMPLD; i += 512) imp[i] = 0u;
    if (tid < 256) sel[tid] = 0u;
    const float b31 = t5[31 * 8 + h] * LOG2E;
    const int tl0 = 32 * th + fr;
    const size_t row0 = (size_t)b * SEQ + 64 * c;
    const bf16_t* Qu = (const bf16_t*)(ws + WS_QA) + row0 * 1024 + h * 128;     const unsigned qoff = (unsigned)(tl0 * 1024 + 8 * fq) * 2u;
    const float* Gu = (const float*)(ws + WS_GATES) + row0 * 24 + h * 3;          const unsigned goff = (unsigned)(tl0 * 24) * 4u;
    bf16_t* Ou = (bf16_t*)(ws + WS_H) + row0 * 2048 + h * 128;                    const unsigned ooffw = (unsigned)(tl0 * 2048 + 8 * (fq >> 1) + 16 * (fq & 1)) * 2u;
    __syncthreads();
    const bf16_t* KVs = (const bf16_t*)(ws + WS_KV6) + (size_t)b * SEQ * 256 + g * 128;
    const int dr0 = 8 * wave + (lane >> 4);
    unsigned dslot[4];
    { const int r1 = dr0 + 4, sl = lane & 15;
      dslot[0] = (unsigned)((sl ^ (dr0 & 15)) << 4); dslot[1] = (unsigned)((sl ^ (r1 & 15)) << 4);
      dslot[2] = (unsigned)((sl ^ ((dr0 & 7) << 1)) << 4); dslot[3] = (unsigned)((sl ^ ((r1 & 7) << 1)) << 4); }
#define NSA_DMA_T(kb_, vb_, rp_, bi_) do { const unsigned ro0_ = (unsigned)dr0 * (rp_), ro1_ = ro0_ + 4u * (rp_); \
        LAS unsigned char* d_ = lds + A_KV + (bi_) * A_KVBUF + wave * 2048; \
        __builtin_amdgcn_global_load_lds((const unsigned*)((kb_) + ro0_ + dslot[0]), (LAS unsigned*)(d_), 16, 0, 0); \
        __builtin_amdgcn_global_load_lds((const unsigned*)((kb_) + ro1_ + dslot[1]), (LAS unsigned*)(d_ + 1024), 16, 0, 0); \
        __builtin_amdgcn_global_load_lds((const unsigned*)((vb_) + ro0_ + dslot[2]), (LAS unsigned*)(d_ + A_VOFF), 16, 0, 0); \
        __builtin_amdgcn_global_load_lds((const unsigned*)((vb_) + ro1_ + dslot[3]), (LAS unsigned*)(d_ + A_VOFF + 1024), 16, 0, 0); } while (0)
    const int nslc_ = c + 1;
#define NSA_TILE_J(sn) ((sn) < nslc_ ? (sn) : (c < 8 ? (sn) - nslc_ : ((sn) - nslc_ == 8 ? c - 8 : c - 7 + ((sn) - nslc_))))
#define NSA_DMA(sn) do { const bool win_ = (sn) >= nslc_; const int j_ = NSA_TILE_J(sn); \
        const char* kbq_ = (const char*)(KVs + ((size_t)(win_ ? 4 : 2) * MTOK + 64 * j_) * 256); NSA_DMA_T(kbq_, kbq_ + (size_t)MTOK * 512, 512u, (sn) % 3); } while (0)
    const int vq = 4 * fq + ((lane & 15) >> 2), vp = lane & 3;
    const unsigned vrow = (unsigned)(A_VOFF + vq * 256 + (vp >> 1) * 16 + (vp & 1) * 8), vx = (unsigned)((vq & 7) << 5);

    bf16x8 qf[2][4];
#pragma unroll
    for (int qb = 0; qb < 2; ++qb)
#pragma unroll
        for (int kc = 0; kc < 4; ++kc) qf[qb][kc] = ldg_qfrag(Qu + (size_t)qb * 16 * 1024 + 32 * kc, qoff);
    {
        const int nmax = 4 * c + 2 < NCMP - 1 ? 4 * c + 2 : NCMP - 1, NCT = nmax / 64 + 1, CS = 2 * NCT;
        const char* KCb = (const char*)((const bf16_t*)(ws + WS_KC) + (size_t)(b * 2 + g) * NCMPP * 128);
        const char* VCb = (const char*)((const bf16_t*)(ws + WS_VCT) + (size_t)(b * 2 + g) * NCMPP * 128);
#define NSA_DMA_C(un) do { const int T_ = (un) < NCT ? (un) : (un) - NCT; NSA_DMA_T(KCb + (size_t)T_ * 64 * 256, VCb + (size_t)T_ * 64 * 256, 256u, (un) % 3); } while (0)
        NSA_DMA_C(0); NSA_DMA_C(1);
        f32x4 oc[2][8], lacc[2];
        float m2[2] = {0.f, 0.f}, inv_l[2] = {0.f, 0.f};
        const bf16x8 ones8 = (bf16x8){0x3f80, 0x3f80, 0x3f80, 0x3f80, 0x3f80, 0x3f80, 0x3f80, 0x3f80};
#pragma unroll
        for (int qb = 0; qb < 2; ++qb) { lacc[qb] = (f32x4){0.f, 0.f, 0.f, 0.f};
#pragma unroll
            for (int dt = 0; dt < 8; ++dt) oc[qb][dt] = (f32x4){0.f, 0.f, 0.f, 0.f}; }
        unsigned koff[4];
#pragma unroll
        for (int kc = 0; kc < 4; ++kc) koff[kc] = (unsigned)(fr * 256 + (((4 * kc + fq) ^ fr) << 4));
        asm volatile("s_waitcnt vmcnt(0)" ::: "memory");
#pragma unroll 1
        for (int u = 0; u < CS; ++u) {
            const bool p1 = u >= NCT; const int T = p1 ? u - NCT : u;
            if (u > 0) { if (u + 1 < CS) asm volatile("s_waitcnt vmcnt(4)" ::: "memory"); else asm volatile("s_waitcnt vmcnt(0)" ::: "memory"); }
            __builtin_amdgcn_s_barrier(); asm volatile("" ::: "memory");
            if (u + 2 < CS) NSA_DMA_C(u + 2);
            unsigned vxl = vx, vrowl = vrow; asm volatile("" : "+v"(vxl), "+v"(vrowl));
            const unsigned kbuf = (unsigned)(A_KV + (u % 3) * A_KVBUF);
#pragma unroll
            for (int C = 0; C < 2; ++C) {
                f32x4 st[2][2];
                if (64 * c - 1024 * T - 512 * C < 655) {
#pragma unroll
                    for (int qb = 0; qb < 2; ++qb) {
                        const int relb = 64 * c + tl0 + 16 * qb - 31 - 16 * (64 * T + 32 * C + 4 * fq);
#pragma unroll
                        for (int t = 0; t < 2; ++t)
#pragma unroll
                            for (int r = 0; r < 4; ++r) { int rel = relb - 256 * t - 16 * r; rel = rel > 191 ? 191 : (rel < -64 ? -64 : rel);
                                st[t][qb][r] = biasT[hg * 256 + 191 - rel] - m2[qb]; }
                    }
                } else {
                    const float bl0 = b31 - m2[0], bl1 = b31 - m2[1];
#pragma unroll
                    for (int t = 0; t < 2; ++t) { st[t][0] = (f32x4){bl0, bl0, bl0, bl0}; st[t][1] = (f32x4){bl1, bl1, bl1, bl1}; }
                }
#pragma unroll
                for (int t = 0; t < 2; ++t) {
                    bf16x8 kf[4];
#pragma unroll
                    for (int kc = 0; kc < 4; ++kc) kf[kc] = lds_frag(lds, kbuf + koff[kc] + (2 * C + t) * 4096);
#pragma unroll
                    for (int kc = 0; kc < 4; ++kc) { st[t][0] = mfma16(kf[kc], qf[0][kc], st[t][0]); st[t][1] = mfma16(kf[kc], qf[1][kc], st[t][1]); }
                }
                bf16x8 pb[2];
                if (!p1) {
                    int imx = __float_as_int(st[0][0][0]);
#pragma unroll
                    for (int qb = 0; qb < 2; ++qb)
#pragma unroll
                        for (int t = 0; t < 2; ++t)
#pragma unroll
                            for (int r = 0; r < 4; ++r) imx = max(imx, __float_as_int(st[t][qb][r]));
                    const bool first = u == 0 && C == 0;
                    if (first || __any(imx > __float_as_int(RESCALE_THR))) {
#pragma unroll
                        for (int qb = 0; qb < 2; ++qb) {
                            float mx = fmaxf(fmaxf(fmaxf(st[0][qb][0], st[0][qb][1]), fmaxf(st[0][qb][2], st[0][qb][3])), fmaxf(fmaxf(st[1][qb][0], st[1][qb][1]), fmaxf(st[1][qb][2], st[1][qb][3])));
                            mx = fmaxf(mx, __shfl_xor(mx, 16)); mx = fmaxf(mx, __shfl_xor(mx, 32));
                            const float d = first ? mx : fmaxf(mx, 0.f), al = first ? 1.0f : ex2(-d);
                            m2[qb] += d; lacc[qb] = lacc[qb] * al;
#pragma unroll
                            for (int t = 0; t < 2; ++t)
#pragma unroll
                                for (int r = 0; r < 4; ++r) st[t][qb][r] -= d;
                        }
                    }
#pragma unroll
                    for (int qb = 0; qb < 2; ++qb) {
#pragma unroll
                        for (int t = 0; t < 2; ++t)
#pragma unroll
                            for (int r = 0; r < 4; ++r) st[t][qb][r] = ex2(st[t][qb][r]);
                        pb[qb] = pack8(st[0][qb], st[1][qb]);
                    }
                    lacc[0] = mfma16(ones8, pb[0], lacc[0]); lacc[1] = mfma16(ones8, pb[1], lacc[1]);
                } else {
                    v2i vlo[8], vhi[8];
#pragma unroll
                    for (int dt = 0; dt < 8; ++dt) { const unsigned va = (unsigned)(size_t)lds + kbuf + vrowl + (((unsigned)(dt << 5)) ^ vxl);
                        if (C == 0) { TR_READ_ASM(vlo[dt], va, 0); TR_READ_ASM(vhi[dt], va, 4096); } else { TR_READ_ASM(vlo[dt], va, 8192); TR_READ_ASM(vhi[dt], va, 12288); } }
#pragma unroll
                    for (int qb = 0; qb < 2; ++qb) {
#pragma unroll
                        for (int t = 0; t < 2; ++t)
#pragma unroll
                            for (int r = 0; r < 4; ++r) st[t][qb][r] = ex2(st[t][qb][r]) * inv_l[qb];
                        LAS unsigned* ip = imp + (tl0 + 16 * qb) * IMPLD + 16 * T + 8 * C + fq;
#pragma unroll
                        for (int t = 0; t < 2; ++t) {
                            lds_addfix(ip + 4 * t, (st[t][qb][0] + st[t][qb][1]) + (st[t][qb][2] + st[t][qb][3]));
                            if (16 * T + 8 * C + 4 * t + fq + 1 < 128) lds_addfix(ip + 4 * t + 1, st[t][qb][3]);
                        }
                        pb[qb] = pack8(st[0][qb], st[1][qb]);
                    }
                    asm volatile("s_waitcnt lgkmcnt(0)" : "+v"(vlo[0]), "+v"(vlo[1]), "+v"(vlo[2]), "+v"(vlo[3]), "+v"(vlo[4]), "+v"(vlo[5]), "+v"(vlo[6]), "+v"(vlo[7]),
                                 "+v"(vhi[0]), "+v"(vhi[1]), "+v"(vhi[2]), "+v"(vhi[3]), "+v"(vhi[4]), "+v"(vhi[5]), "+v"(vhi[6]), "+v"(vhi[7]) :: "memory");
                    __builtin_amdgcn_sched_barrier(0);
#pragma unroll
                    for (int dt = 0; dt < 8; ++dt) { const bf16x8 vfr = __builtin_bit_cast(bf16x8, (u32x4){(unsigned)vlo[dt][0], (unsigned)vlo[dt][1], (unsigned)vhi[dt][0], (unsigned)vhi[dt][1]});
                        oc[0][dt] = mfma16(vfr, pb[0], oc[0][dt]); oc[1][dt] = mfma16(vfr, pb[1], oc[1][dt]); }
                }
            }
            if (u == NCT - 1) {
#pragma unroll
                for (int qb = 0; qb < 2; ++qb) inv_l[qb] = (64 * c + tl0 + 16 * qb >= 31) ? 1.0f / lacc[qb][0] : 0.f;
            }
        }
#undef NSA_DMA_C
#pragma unroll
        for (int qb = 0; qb < 2; ++qb) {
            const float gzr = *(const float*)((const char*)(Gu + qb * 16 * 24 + 0) + goff), gz = 1.0f / (1.0f + __expf(-gzr));
#pragma unroll
            for (int P = 0; P < 4; ++P) {
                unsigned ax = cvt_pk_bf16(oc[qb][2 * P][0] * gz, oc[qb][2 * P][1] * gz), ay = cvt_pk_bf16(oc[qb][2 * P][2] * gz, oc[qb][2 * P][3] * gz);
                unsigned bx = cvt_pk_bf16(oc[qb][2 * P + 1][0] * gz, oc[qb][2 * P + 1][1] * gz), by = cvt_pk_bf16(oc[qb][2 * P + 1][2] * gz, oc[qb][2 * P + 1][3] * gz);
                swap16(ax, bx); swap16(ay, by);
                *(u32x4*)((char*)(Ou + (size_t)qb * 16 * 2048 + 32 * P) + ooffw) = (u32x4){ax, ay, bx, by}; }
        }
    }
    __syncthreads();
    NSA_DMA(0); NSA_DMA(1);
    {
        const int tk = tid >> 3, k = tid & 7;
        unsigned bits = 0u;
        if (c < 16) {
#pragma unroll
            for (int jj = 0; jj < 16; ++jj) bits |= (16 * k + jj <= c ? 1u : 0u) << jj;
        } else {
            unsigned v[16];
#pragma unroll
            for (int jj = 0; jj < 16; ++jj) { const int j = 16 * k + jj; v[jj] = (j >= 1 && j <= c - 2) ? imp[tk * IMPLD + j] : 0u; }
            unsigned T = 0u;
#pragma unroll 1
            for (int bit = 30; bit >= 0; --bit) {
                const unsigned trial = T | (1u << bit);
                int cnt = 0;
#pragma unroll
                for (int jj = 0; jj < 16; ++jj) cnt += v[jj] >= trial ? 1 : 0;
                cnt = sum8_dpp(cnt);
                if (cnt >= 13) T = trial;
            }
            int ngt = 0, neq = 0;
#pragma unroll
            for (int jj = 0; jj < 16; ++jj) { const int j = 16 * k + jj; const bool cand = j >= 1 && j <= c - 2; ngt += (cand && v[jj] > T) ? 1 : 0; neq += (cand && v[jj] == T) ? 1 : 0; }
            const int tgt = sum8_dpp(ngt);
            int pre = 0;
#pragma unroll
            for (int kk = 0; kk < 8; ++kk) { const int o = __shfl(neq, (lane & ~7) | kk); pre += kk < k ? o : 0; }
            int room = 13 - tgt - pre;
#pragma unroll
            for (int jj = 0; jj < 16; ++jj) { const int j = 16 * k + jj; const bool cand = j >= 1 && j <= c - 2;
                bool s1 = (j == 0) || (j == c) || (j == c - 1) || (cand && v[jj] > T);
                if (cand && v[jj] == T) { if (room > 0) s1 = true; --room; }
                bits |= (s1 ? 1u : 0u) << jj; }
        }
        atomicOr((unsigned*)(sel + tk * 4 + (k >> 1)), bits << (16 * (k & 1)));
    }
    __syncthreads();
    {
        const int nslc = c + 1, nwin = (c < 8 ? c : 8) + 1, nsteps = nslc + nwin;
        f32x4 oacc[2][8], lacc[2];
        float m2[2];
        const bf16x8 ones8 = (bf16x8){0x3f80, 0x3f80, 0x3f80, 0x3f80, 0x3f80, 0x3f80, 0x3f80, 0x3f80};
#pragma unroll
        for (int qb = 0; qb < 2; ++qb) { m2[qb] = 0.f; lacc[qb] = (f32x4){0.f, 0.f, 0.f, 0.f};
#pragma unroll
            for (int dt = 0; dt < 8; ++dt) oacc[qb][dt] = (f32x4){0.f, 0.f, 0.f, 0.f}; }
        unsigned koff[4];
#pragma unroll
        for (int kc = 0; kc < 4; ++kc) koff[kc] = (unsigned)(fr * 256 + (((4 * kc + fq) ^ fr) << 4));
        asm volatile("s_waitcnt vmcnt(0)" ::: "memory");
#pragma unroll 1
        for (int s = 0; s < nsteps; ++s) {
            const bool win = s >= nslc; const int j = NSA_TILE_J(s), dlt = c - j;
            if (s > 0) { if (s + 1 < nsteps) asm volatile("s_waitcnt vmcnt(4)" ::: "memory"); else asm volatile("s_waitcnt vmcnt(0)" ::: "memory"); }
            __builtin_amdgcn_s_barrier(); asm volatile("" ::: "memory");
            if (s + 2 < nsteps) NSA_DMA(s + 2);
            unsigned selw[2] = {0xffffffffu, 0xffffffffu};
            if (!win) { selw[0] = sel[tl0 * 4 + (j >> 5)]; selw[1] = sel[(tl0 + 16) * 4 + (j >> 5)]; }
            const unsigned kbuf = (unsigned)(A_KV + (s % 3) * A_KVBUF);
            const bool on0 = ((selw[0] >> (j & 31)) & 1u) != 0u, on1 = ((selw[1] >> (j & 31)) & 1u) != 0u;
#pragma unroll
            for (int C = 0; C < 2; ++C) {
                bf16x8 kf[2][4];
#pragma unroll
                for (int t = 0; t < 2; ++t)
#pragma unroll
                    for (int kc = 0; kc < 4; ++kc) kf[t][kc] = lds_frag(lds, kbuf + koff[kc] + (2 * C + t) * 4096);
                f32x4 st[2][2];
                if (dlt <= 2) {
#pragma unroll
                    for (int qb = 0; qb < 2; ++qb) {
                        const int tlq = tl0 + 16 * qb; const bool on = qb ? on1 : on0;
                        const LAS float* bt = biasT + hg * 256 + (191 - 64 * dlt - tlq + 4 * fq) + 32 * C;
#pragma unroll
                        for (int t = 0; t < 2; ++t)
#pragma unroll
                            for (int r = 0; r < 4; ++r) { const float tv = bt[16 * t + r] - m2[qb]; st[t][qb][r] = on ? tv : -1e30f; }
                    }
                } else {
                    const float bl0 = on0 ? b31 - m2[0] : -1e30f, bl1 = on1 ? b31 - m2[1] : -1e30f;
#pragma unroll
                    for (int t = 0; t < 2; ++t) { st[t][0] = (f32x4){bl0, bl0, bl0, bl0}; st[t][1] = (f32x4){bl1, bl1, bl1, bl1}; }
                    if (win && dlt == 8) {
#pragma unroll
                        for (int qb = 0; qb < 2; ++qb)
#pragma unroll
                            for (int t = 0; t < 2; ++t)
#pragma unroll
                                for (int r = 0; r < 4; ++r) st[t][qb][r] = (32 * C + 16 * t + 4 * fq + r > tl0 + 16 * qb) ? st[t][qb][r] : -1e30f;
                    }
                }
#pragma unroll
                for (int t = 0; t < 2; ++t)
#pragma unroll
                    for (int kc = 0; kc < 4; ++kc) { st[t][0] = mfma16(kf[t][kc], qf[0][kc], st[t][0]); st[t][1] = mfma16(kf[t][kc], qf[1][kc], st[t][1]); }
                v2i vlo[8], vhi[8];
#pragma unroll
                for (int dt = 0; dt < 8; ++dt) { const unsigned va = (unsigned)(size_t)lds + kbuf + vrow + (((unsigned)(dt << 5)) ^ vx);
                    if (C == 0) { TR_READ_ASM(vlo[dt], va, 0); TR_READ_ASM(vhi[dt], va, 4096); } else { TR_READ_ASM(vlo[dt], va, 8192); TR_READ_ASM(vhi[dt], va, 12288); } }
                int imx = __float_as_int(st[0][0][0]);
#pragma unroll
                for (int qb = 0; qb < 2; ++qb)
#pragma unroll
                    for (int t = 0; t < 2; ++t)
#pragma unroll
                        for (int r = 0; r < 4; ++r) imx = max(imx, __float_as_int(st[t][qb][r]));
                const bool first = (s == 0 || s == nslc) && C == 0;
                if (first || __any(imx > __float_as_int(RESCALE_THR))) {
#pragma unroll
                    for (int qb = 0; qb < 2; ++qb) {
                        float mx = fmaxf(fmaxf(fmaxf(st[0][qb][0], st[0][qb][1]), fmaxf(st[0][qb][2], st[0][qb][3])), fmaxf(fmaxf(st[1][qb][0], st[1][qb][1]), fmaxf(st[1][qb][2], st[1][qb][3])));
                        mx = fmaxf(mx, __shfl_xor(mx, 16)); mx = fmaxf(mx, __shfl_xor(mx, 32));
                        const float d = first ? mx : fmaxf(mx, 0.f), al = first ? 1.0f : ex2(-d);
                        m2[qb] += d; lacc[qb] = lacc[qb] * al;
#pragma unroll
                        for (int dt = 0; dt < 8; ++dt) oacc[qb][dt] = oacc[qb][dt] * al;
#pragma unroll
                        for (int t = 0; t < 2; ++t)
#pragma unroll
                            for (int r = 0; r < 4; ++r) st[t][qb][r] -= d;
                    }
                }
                bf16x8 pb[2];
#pragma unroll
                for (int qb = 0; qb < 2; ++qb) {
#pragma unroll
                    for (int t = 0; t < 2; ++t)
#pragma unroll
                        for (int r = 0; r < 4; ++r) st[t][qb][r] = ex2(st[t][qb][r]);
                    pb[qb] = pack8(st[0][qb], st[1][qb]);
                }
                asm volatile("s_waitcnt lgkmcnt(0)" : "+v"(vlo[0]), "+v"(vlo[1]), "+v"(vlo[2]), "+v"(vlo[3]), "+v"(vlo[4]), "+v"(vlo[5]), "+v"(vlo[6]), "+v"(vlo[7]),
                             "+v"(vhi[0]), "+v"(vhi[1]), "+v"(vhi[2]), "+v"(vhi[3]), "+v"(vhi[4]), "+v"(vhi[5]), "+v"(vhi[6]), "+v"(vhi[7]) :: "memory");
                __builtin_amdgcn_sched_barrier(0);
#pragma unroll
                for (int dt = 0; dt < 8; ++dt) { const bf16x8 vfr = __builtin_bit_cast(bf16x8, (u32x4){(unsigned)vlo[dt][0], (unsigned)vlo[dt][1], (unsigned)vhi[dt][0], (unsigned)vhi[dt][1]});
                    oacc[0][dt] = mfma16(vfr, pb[0], oacc[0][dt]); oacc[1][dt] = mfma16(vfr, pb[1], oacc[1][dt]); }
                lacc[0] = mfma16(ones8, pb[0], lacc[0]); lacc[1] = mfma16(ones8, pb[1], lacc[1]);
            }
            if (s == nslc - 1 || s == nsteps - 1) {
                u32x4 old[2][4];
#pragma unroll
                for (int qb = 0; qb < 2; ++qb)
#pragma unroll
                    for (int P = 0; P < 4; ++P) old[qb][P] = *(const u32x4*)((const char*)(Ou + (size_t)qb * 16 * 2048 + 32 * P) + ooffw);
                const float g0r = *(const float*)((const char*)(Gu + (win ? 2 : 1)) + goff), g1r = *(const float*)((const char*)(Gu + 16 * 24 + (win ? 2 : 1)) + goff);
                const float g0 = 1.0f / (1.0f + __expf(-g0r)), g1 = 1.0f / (1.0f + __expf(-g1r));
#pragma unroll
                for (int qb = 0; qb < 2; ++qb)
#pragma unroll
                    for (int P = 0; P < 4; ++P)
#pragma unroll
                        for (int r = 0; r < 4; ++r) { float a_ = oacc[qb][2 * P][r], b_ = oacc[qb][2 * P + 1][r]; swap16f(a_, b_); oacc[qb][2 * P][r] = a_; oacc[qb][2 * P + 1][r] = b_; }
                asm volatile("s_waitcnt vmcnt(0)" ::: "memory");
#pragma unroll
                for (int qb = 0; qb < 2; ++qb) {
                    const float gz = (qb ? g1 : g0) / lacc[qb][0];
                    char* Op = (char*)(Ou + (size_t)qb * 16 * 2048) + ooffw;
#pragma unroll
                    for (int P = 0; P < 4; ++P) {
                        const u32x4 o4 = old[qb][P]; const f32x4 a = oacc[qb][2 * P], b = oacc[qb][2 * P + 1];
                        u32x4 w; w.x = cvt_pk_bf16(bf2f(o4.x & 0xffffu) + a[0] * gz, bf2f(o4.x >> 16) + a[1] * gz); w.y = cvt_pk_bf16(bf2f(o4.y & 0xffffu) + a[2] * gz, bf2f(o4.y >> 16) + a[3] * gz);
                        w.z = cvt_pk_bf16(bf2f(o4.z & 0xffffu) + b[0] * gz, bf2f(o4.z >> 16) + b[1] * gz); w.w = cvt_pk_bf16(bf2f(o4.w & 0xffffu) + b[2] * gz, bf2f(o4.w >> 16) + b[3] * gz);
                        *(u32x4*)(Op + 64 * P) = w;
                        oacc[qb][2 * P] = (f32x4){0.f, 0.f, 0.f, 0.f}; oacc[qb][2 * P + 1] = (f32x4){0.f, 0.f, 0.f, 0.f};
                    }
                    m2[qb] = 0.f; lacc[qb] = (f32x4){0.f, 0.f, 0.f, 0.f};
                }
                asm volatile("s_waitcnt vmcnt(0)" ::: "memory");
            }
        }
        __syncthreads();
    }
#undef NSA_DMA
#undef NSA_TILE_J
}

#define XB_TMO      128
#define XB_XCNT(j)  (256  + 64 * (j))
#define XB_XSUB(j)  (1280 + 64 * (j))
#define XB_XGEN(j)  (2304 + 64 * (j))
#define XB_TOP      3328
#define XB_TOPGEN   3392
#define XCD_BAR_WORDS 3456
#define XB_SPIN_CAP (1u << 18)

__device__ __forceinline__ unsigned xb_ld(unsigned* p)              { return __hip_atomic_load(p, __ATOMIC_RELAXED, __HIP_MEMORY_SCOPE_AGENT); }
__device__ __forceinline__ unsigned xb_add(unsigned* p, unsigned v) { return __hip_atomic_fetch_add(p, v, __ATOMIC_RELAXED, __HIP_MEMORY_SCOPE_AGENT); }
__device__ __forceinline__ unsigned xb_xcc_id() { return (unsigned)__builtin_amdgcn_s_getreg((3 << 11) | 20) & 0xFu; }
#define XB_SPIN(cond, bar) do { unsigned _sp = 0; while (cond) { __builtin_amdgcn_s_sleep(1); \
    if ((++_sp & 255u) == 0u) { if (xb_ld(&(bar)[XB_TMO])) break; if (_sp > XB_SPIN_CAP) { atomicAdd(&(bar)[XB_TMO], 1u); break; } } } } while (0)

struct XcdBarrier {
    unsigned* bar; unsigned x;
    volatile LAS unsigned* st;
};

__device__ __forceinline__ XcdBarrier xcd_barrier_post(unsigned* bar, volatile LAS unsigned* st) {
    XcdBarrier b; b.bar = bar; b.x = xb_xcc_id(); b.st = st;
    if (threadIdx.x == 0) (void)xb_add(&bar[XB_XCNT(b.x)], 1u);
    return b;
}
__device__ __forceinline__ void xcd_barrier_complete(unsigned* bar, unsigned x, unsigned& nloc, unsigned& nx) {
    const unsigned G = gridDim.x * gridDim.y * gridDim.z;
    unsigned sum, cnt, mine, sp = 0u;
    for (;;) {
        sum = 0u; cnt = 0u; mine = 0u;
#pragma unroll
        for (unsigned j = 0; j < 16; ++j) { const unsigned c = xb_ld(&bar[XB_XCNT(j)]); sum += c; cnt += (c > 0u) ? 1u : 0u; mine = (j == x) ? c : mine; }
        if (sum == G) break;
        __builtin_amdgcn_s_sleep(1);
        if ((++sp & 255u) == 0u) { if (xb_ld(&bar[XB_TMO])) break; if (sp > XB_SPIN_CAP) { atomicAdd(&bar[XB_TMO], 1u); break; } }
    }
    nloc = mine > 0u ? mine : 1u; nx = cnt > 0u ? cnt : 1u;
}

__device__ __forceinline__ void xcd_barrier(const XcdBarrier& b) {
    asm volatile("s_waitcnt vmcnt(0)" ::: "memory");
    __syncthreads();
    if (threadIdx.x == 0) {
        unsigned* bar = b.bar;
        __builtin_amdgcn_s_waitcnt(0);
        unsigned nloc = b.st[0], nx = b.st[1];
        if (nloc == 0u) { xcd_barrier_complete(bar, b.x, nloc, nx); b.st[0] = nloc; b.st[1] = nx; }
        const unsigned old = xb_add(&bar[XB_XSUB(b.x)], 1u);
        const unsigned gen = old / nloc;
        if (old + 1u == (gen + 1u) * nloc) {
            __builtin_amdgcn_fence(__ATOMIC_RELEASE, "agent");
            asm volatile("s_waitcnt vmcnt(0)" ::: "memory");
            const unsigned og = xb_add(&bar[XB_TOP], 1u);
            const unsigned tg = og / nx;
            if (og + 1u == (tg + 1u) * nx) xb_add(&bar[XB_TOPGEN], 1u);
            else XB_SPIN(xb_ld(&bar[XB_TOPGEN]) == tg, bar);
            __builtin_amdgcn_fence(__ATOMIC_ACQUIRE, "agent");
            xb_add(&bar[XB_XGEN(b.x)], 1u);
            asm volatile("s_waitcnt vmcnt(0)" ::: "memory");
        } else {
            XB_SPIN(xb_ld(&bar[XB_XGEN(b.x)]) == gen, bar);
            __builtin_amdgcn_fence(__ATOMIC_ACQUIRE, "agent");
            asm volatile("s_waitcnt vmcnt(0)" ::: "memory");
        }
    }
    __syncthreads();
}

__global__ void __launch_bounds__(512, 2) mega(Params p) {
    extern __shared__ __attribute__((aligned(16))) unsigned char lds_raw[];
    LAS unsigned char* lds = (LAS unsigned char*)lds_raw;
    cg::grid_group grid = cg::this_grid();
    const int tid = threadIdx.x, lane = tid & 63, wave = __builtin_amdgcn_readfirstlane(tid >> 6);
    const int G = gridDim.x, gw = blockIdx.x * 8 + wave, NGW = G * 8;
    unsigned char* ws = p.ws;
    const int lo = p.ph_lo, hi = p.ph_hi;
    volatile LAS unsigned* bst = (volatile LAS unsigned*)(lds + LDS_BYTES - 64);
    if (tid < 2) bst[tid] = 0u;
    __syncthreads();
    const XcdBarrier xbar = xcd_barrier_post((unsigned*)(ws + WS_BAR), bst);
#define IN(k) (lo <= (k) && (k) < hi)
#define SEAM(k) do { if (IN(k) && IN((k) + 1)) { if (hi > 1000) grid.sync(); else xcd_barrier(xbar); } } while (0)
    if (IN(0)) { p0_prologue(p, lds, wave, lane, gw, NGW); }
    SEAM(0);
    if (IN(1)) {
        pg8::Gemm g{(const bf16_t*)((const unsigned char*)p.out + XB_OFF), (const bf16_t*)(ws + WS_WINT), MTOK, NIN, DM}; pg8::StaticOrder S; S.init(MTOK, NIN, G, (int)blockIdx.x, WGM_IN);
        EpiInProj E{(bf16_t*)(ws + WS_QA), (bf16_t*)(ws + WS_KV6), (bf16_t*)(ws + WS_QR), (bf16_t*)(ws + WS_KR), (bf16_t*)(ws + WS_VR), (bf16_t*)(ws + WS_GR), (float*)(ws + WS_GATES), (const float2*)(ws + WS_ROPE), p.lg[0], p.lg[1], p.lg[2], p.lg[3]};
        pg8::gemm_phase<EpiInProj, pg8::StaticOrder, GEMM_ALIGN, GEMM_SP2>(lds, g, S, E);
        { const int U = (MTOK / 256) * (NIN / 256), rounds = (U + G - 1) / G, nfull = U - (rounds - 1) * G, nidle = G - nfull;
          __syncthreads();
          if (nidle == 0) p1_tail_weights(p, lds, gw, NGW);
          else if ((int)blockIdx.x >= nfull) p1_tail_weights(p, lds, ((int)blockIdx.x - nfull) * 8 + wave, nidle * 8); }
    }
    SEAM(1);
    if (IN(2)) {
        for (int it = blockIdx.x; it < 256; it += G) mf_compress(p, it, lds, tid, wave, lane);
        mf_ret_u_items(p, (int)blockIdx.x, G, lds);
    }
    SEAM(2);
    if (IN(3)) { mf_ret_scan(p, blockIdx.x * 512 + opaque_tid(), G * 512); }
    SEAM(3);
    if (IN(4)) {
        for (int it = blockIdx.x; it < 256; it += G) { const int bgi = it & 3, pr = it >> 2;
            __syncthreads();
            for (int i = tid; i < 4 * 256; i += 512) { const int hh = i >> 8, rel = 191 - (i & 255);
                ((LAS float*)(lds + A_BIAS))[i] = rel >= 0 ? p.in[11][t5_bucket(rel) * 8 + 4 * (bgi & 1) + hh] * LOG2E : -1e30f; }
            mf_nsa(p, bgi, 127 - pr, lds, tid, wave, lane); mf_nsa(p, bgi, pr, lds, tid, wave, lane); }
        for (int it = blockIdx.x; it < 512; it += G) mf_ret_out(p, it, lds, tid, wave, lane);
    }
    SEAM(4);
    if (IN(5)) {
        pg8::Gemm g{(const bf16_t*)(ws + WS_H), (const bf16_t*)(ws + WS_WOUTT), MTOK, DM, DM}; pg8::StaticOrder S; S.init(MTOK, DM, G, (int)blockIdx.x, WGM_OUT);
        EpiBf16Plain E{(bf16_t*)(ws + WS_MIX), DM};
        pg8::gemm_phase<EpiBf16Plain, pg8::StaticOrder, GEMM_ALIGN, GEMM_SP2>(lds, g, S, E);
    }
    SEAM(5);
    if (IN(6)) { p6_resnorm(p, lds, NGW); }
    SEAM(6);
    if (IN(7)) {
        pg8::Gemm g{(const bf16_t*)(ws + WS_X1), (const bf16_t*)(ws + WS_WUPT), MTOK, DFF, DM}; pg8::StaticOrder S; S.init(MTOK, DFF, G, (int)blockIdx.x, WGM_UP);
        EpiRelu2 E{(bf16_t*)(ws + WS_UM), DFF};
        pg8::gemm_phase<EpiRelu2, pg8::StaticOrder, GEMM_ALIGN, GEMM_SP2>(lds, g, S, E);
    }
    SEAM(7);
    if (IN(8)) {
        pg8::Gemm g{(const bf16_t*)(ws + WS_UM), (const bf16_t*)(ws + WS_WDNT), MTOK, DM, DFF}; RevOrder S; S.init(MTOK, DM, G, (int)blockIdx.x, WGM_DN);
        EpiBf16Plain E{(bf16_t*)(ws + WS_Y), DM};
        pg8::gemm_phase<EpiBf16Plain, RevOrder, GEMM_ALIGN, GEMM_SP2>(lds, g, S, E);
    }
    SEAM(8);
    if (IN(9)) { p9_final(p, lds, NGW); }
#undef IN
#undef SEAM
}
}

extern "C" void kernel_launch(void* const* d_in, const int* in_sizes, int n_in, void* d_out, int out_size, void* d_ws, size_t ws_size, hipStream_t stream) {
    using namespace mk;
    static int grid = 0;
    if (n_in != 18 || out_size != MTOK * DM || ws_size < WS_NEED) { fprintf(stderr, "kernel_launch: unexpected shapes (n_in %d out %d ws %zu)\n", n_in, out_size, ws_size); return; }
    if (!grid) {
        int dev = 0, cus = 0, per_cu = 0;
        hipGetDevice(&dev); hipDeviceGetAttribute(&cus, hipDeviceAttributeMultiprocessorCount, dev);
        hipFuncSetAttribute((const void*)mega, hipFuncAttributeMaxDynamicSharedMemorySize, LDS_BYTES);
        hipOccupancyMaxActiveBlocksPerMultiprocessor(&per_cu, (const void*)mega, 512, LDS_BYTES);
        if (per_cu < 1) { fprintf(stderr, "kernel_launch: occupancy query says %d blocks per CU\n", per_cu); per_cu = 1; }
        grid = cus * per_cu;
        fprintf(stderr, "kernel_launch: grid %d (%d CUs x %d)\n", grid, cus, per_cu);
    }
    Params p{};
    for (int i = 0; i < 18; ++i) p.in[i] = (const float*)d_in[i];
    p.out = (float*)d_out; p.ws = (unsigned char*)d_ws;
    for (int h = 0; h < 4; ++h) p.lg[h] = (float)std::log(1.0 - std::exp2(-5.0 - (double)h));
    for (int i = 0; i < 128; ++i) p.invf[i] = (double)std::pow(10000.0f, -(float)(2 * i) / 256.0f);
    auto launch = [&](int lo, int hi) {
        Params q = p; q.ph_lo = lo; q.ph_hi = hi; void* args[] = {&q};
        hipError_t e = hipLaunchCooperativeKernel((const void*)mega, dim3(grid), dim3(512), args, LDS_BYTES, stream);
        if (e != hipSuccess) fprintf(stderr, "cooperative launch [%d,%d) failed: %s (grid %d)\n", lo, hi, hipGetErrorString(e), grid);
    };
    if (hipMemsetAsync(d_ws, 0, 65536, stream) != hipSuccess) fprintf(stderr, "kernel_launch: memset of the control words failed\n");
    launch(0, 10);
}
```

```cpp
#include <hip/hip_runtime.h>
#include <hip/hip_cooperative_groups.h>
#include <cstdio>
#include <cmath>
namespace pg8 {
#define PG8_LAS __attribute__((address_space(3)))
typedef unsigned short bf16_t;
typedef short bf16x8 __attribute__((ext_vector_type(8)));
typedef float f32x4 __attribute__((ext_vector_type(4)));
typedef unsigned u32x4 __attribute__((ext_vector_type(4)));
constexpr int BM = 256, BK = 64, HALF = 128, HTB = HALF * BK * 2  , STAGE_BYTES = 8 * HTB, NXCD = 8, WGM = 8;

__host__ __device__ __forceinline__ int lds_byte(int r, int c) { const int st = (r >> 4) * 2 + (c >> 5), rr = r & 15, cc = c & 31, ob = rr * 64 + cc * 2; return st * 1024 + (ob ^ (((ob >> 9) & 1) << 5)); }
__host__ __device__ __forceinline__ void stage_rc(int b, int& R, int& C) { const int st = b / 1024, sb = b % 1024, swz = sb ^ (((sb >> 9) & 1) << 5); R = (st >> 1) * 16 + swz / 64; C = (st & 1) * 32 + (swz % 64) / 2; }
__host__ __device__ __forceinline__ int perm32(int rho) { const int n = rho >> 4, i = rho & 15; return 8 * (i >> 2) + 4 * n + (i & 3); }

struct Unit { int pm, pn; };
struct Gemm { const bf16_t* A; const bf16_t* Bt; int M, N, K; };

struct StaticOrder {
    int nM, nN, nwg, G, c, wgm;
    __host__ __device__ void init(int M, int N, int G_, int c_, int wgm_ = WGM) { nM = M / BM; nN = N / BM; nwg = nM * nN; G = G_; c = c_; wgm = wgm_; }
    __host__ __device__ bool next(int i, Unit& u) const {
        const long L = (long)i * G + c; if (L >= nwg) return false;
        int wgid = (int)L; { const int q = nwg / NXCD, r = nwg % NXCD, xcd = wgid % NXCD, off = wgid / NXCD; wgid = (xcd < r ? xcd * (q + 1) : r * (q + 1) + (xcd - r) * q) + off; }
        const int nig = wgm * nN, gid = wgid / nig, fm = gid * wgm, gsz = (nM - fm) < wgm ? (nM - fm) : wgm;
        u.pm = fm + ((wgid % nig) % gsz); u.pn = (wgid % nig) / gsz; return true;
    }
    __device__ __forceinline__ void a_ready(const Unit&) const {}
    __device__ __forceinline__ void done(const Unit&) const {}
};
typedef float f32x2 __attribute__((ext_vector_type(2)));
typedef __bf16 bf16x2_nat __attribute__((ext_vector_type(2)));
__device__ __forceinline__ unsigned cvt_pk_bf16(float lo, float hi) { const f32x2 v = {lo, hi}; return __builtin_bit_cast(unsigned, __builtin_convertvector(v, bf16x2_nat)); }
struct EpiF32 {
    static constexpr bool PERM = false, AFTER_DRAIN = false;
    float* C; int ldc; const float* bias;
    __device__ __forceinline__ void operator()(const f32x4 (&acc)[2][2][4][2], const Unit& u, int wr, int wc, int fr, int fq) const {
        const int row0 = u.pm * BM + wr * 64 + fr, col0 = u.pn * BM + wc * 32 + 4 * fq;
        f32x4 bv[2][2];
#pragma unroll
        for (int bj = 0; bj < 2; ++bj)
#pragma unroll
            for (int n = 0; n < 2; ++n) bv[bj][n] = bias ? *(const f32x4*)(bias + col0 + bj * HALF + n * 16) : (f32x4){0.f, 0.f, 0.f, 0.f};
#pragma unroll
        for (int ai = 0; ai < 2; ++ai)
#pragma unroll
            for (int m = 0; m < 4; ++m) { float* rowp = C + (size_t)(row0 + ai * HALF + m * 16) * ldc + col0;
#pragma unroll
                for (int bj = 0; bj < 2; ++bj)
#pragma unroll
                    for (int n = 0; n < 2; ++n) *(f32x4*)(rowp + bj * HALF + n * 16) = acc[ai][bj][m][n] + bv[bj][n]; }
    }
};
template <class Epi, class Sched, bool ALIGN_EPI = false, bool SP2 = false>
__device__ __forceinline__ void gemm_phase(PG8_LAS unsigned char* lds, const Gemm g, const Sched& S, const Epi& E) {
    int tid_o = threadIdx.x; asm volatile("" : "+v"(tid_o));
    const int tid = tid_o, wid = __builtin_amdgcn_readfirstlane(tid >> 6), lane = tid & 63, wr = wid >> 2, wc = wid & 3, fr = lane & 15, fq = lane >> 4;
    const int K = g.K, nt = K / BK;
    unsigned voffA[2], voffB[2];
#pragma unroll
    for (int i = 0; i < 2; ++i) { int R, C; stage_rc(tid * 16 + i * 8192, R, C); const int Rb = Epi::PERM ? ((R & ~31) + perm32(R & 31)) : R;
        voffA[i] = (unsigned)(R * K + C) * 2u; voffB[i] = (unsigned)(Rb * K + C) * 2u; }
    const size_t kstep = (size_t)(BK * 2);
    const size_t hstep = (size_t)HALF * K * 2;
    const size_t tstep = 2 * hstep;
    const unsigned ldsw = (unsigned)wid * 1024u;
    const int aoff = lds_byte(wr * 64 + fr, fq * 8), boff = lds_byte(wc * 32 + fr, fq * 8);
#define PG8_SA(b, h) (((b) * 2 + (h)) * HTB)
#define PG8_SB(b, h) ((4 + (b) * 2 + (h)) * HTB)
#define PG8_STAGE(bufoff, gbase, voff) do { _Pragma("unroll") for (int _i = 0; _i < 2; ++_i) \
        __builtin_amdgcn_global_load_lds((const unsigned*)((const char*)(gbase) + (voff)[_i]), (PG8_LAS unsigned*)(lds + (bufoff) + ldsw + _i * 8192), 16, 0, 0); } while (0)
#define PG8_LDA(dst, b, h) do { _Pragma("unroll") for (int m = 0; m < 4; ++m) _Pragma("unroll") for (int k = 0; k < 2; ++k) dst[m][k] = *(const PG8_LAS bf16x8*)(lds + PG8_SA(b, h) + aoff + m * 2048 + k * 1024); } while (0)
#define PG8_LDB(dst, b, h) do { _Pragma("unroll") for (int n = 0; n < 2; ++n) _Pragma("unroll") for (int k = 0; k < 2; ++k) dst[n][k] = *(const PG8_LAS bf16x8*)(lds + PG8_SB(b, h) + boff + n * 2048 + k * 1024); } while (0)
#define PG8_MMA(ai, bj, At, Bt) do { __builtin_amdgcn_s_setprio(1); _Pragma("unroll") for (int m = 0; m < 4; ++m) _Pragma("unroll") for (int n = 0; n < 2; ++n) _Pragma("unroll") for (int k = 0; k < 2; ++k) \
        acc[ai][bj][m][n] = __builtin_amdgcn_mfma_f32_16x16x32_bf16(Bt[n][k], At[m][k], acc[ai][bj][m][n], 0, 0, 0); __builtin_amdgcn_s_setprio(0); } while (0)
#define PG8_WAIT_V(n) asm volatile("s_waitcnt vmcnt(" #n ")" ::: "memory")
#define PG8_WAIT_L(n) asm volatile("s_waitcnt lgkmcnt(" #n ")" ::: "memory")
#define PG8_BAR __builtin_amdgcn_s_barrier()
#define PG8_SCHED __builtin_amdgcn_sched_barrier(0)
    Unit cur, nxt; int ui = 0;
    if (!S.next(0, cur)) return;
    f32x4 acc[2][2][4][2];
#pragma unroll
    for (int a = 0; a < 2; ++a)
#pragma unroll
        for (int b = 0; b < 2; ++b)
#pragma unroll
            for (int m = 0; m < 4; ++m)
#pragma unroll
                for (int n = 0; n < 2; ++n) acc[a][b][m][n] = (f32x4){0.f, 0.f, 0.f, 0.f};
    bf16x8 At[4][2], B0[2][2], B1[2][2];
    const char* cA = (const char*)g.A + (size_t)cur.pm * tstep; const char* cB = (const char*)g.Bt + (size_t)cur.pn * tstep;
    S.a_ready(cur);
    if constexpr (SP2) {
        PG8_STAGE(PG8_SB(0, 0), cB, voffB); PG8_STAGE(PG8_SB(0, 1), cB + hstep, voffB); PG8_STAGE(PG8_SA(0, 0), cA, voffA); PG8_STAGE(PG8_SA(0, 1), cA + hstep, voffA);
        if (wr == 1) PG8_BAR;
        PG8_WAIT_V(2); PG8_BAR;
        PG8_STAGE(PG8_SB(1, 0), cB + kstep, voffB); PG8_STAGE(PG8_SA(1, 0), cA + kstep, voffA); PG8_STAGE(PG8_SB(1, 1), cB + hstep + kstep, voffB);
        PG8_WAIT_V(6); PG8_BAR;
    } else {
        PG8_STAGE(PG8_SB(0, 0), cB, voffB); PG8_STAGE(PG8_SA(0, 0), cA, voffA); PG8_STAGE(PG8_SB(0, 1), cB + hstep, voffB); PG8_STAGE(PG8_SA(0, 1), cA + hstep, voffA);
        if (wr == 1) PG8_BAR;
        PG8_WAIT_V(4); PG8_BAR;
        PG8_STAGE(PG8_SB(1, 0), cB + kstep, voffB); PG8_STAGE(PG8_SA(1, 0), cA + kstep, voffA); PG8_STAGE(PG8_SB(1, 1), cB + hstep + kstep, voffB);
        PG8_WAIT_V(6); PG8_BAR;
    }
    for (;;) {
        const bool has_next = S.next(ui + 1, nxt);
        const char* nA = has_next ? (const char*)g.A + (size_t)nxt.pm * tstep : cA; const char* nB = has_next ? (const char*)g.Bt + (size_t)nxt.pn * tstep : cB;
        for (int t = 0; t < nt; t += 2) {
            const bool last = (t == nt - 2);
            const char* a1 = cA + (size_t)(t + 1) * kstep;
            const char* a2 = last ? nA : cA + (size_t)(t + 2) * kstep; const char* b2 = last ? nB : cB + (size_t)(t + 2) * kstep;
            const char* a3 = a2 + kstep; const char* b3 = b2 + kstep;
            if (last && has_next) S.a_ready(nxt);
            if constexpr (SP2) {
            PG8_LDB(B0, 0, 0); PG8_LDB(B1, 0, 1); PG8_SCHED; PG8_LDA(At, 0, 0); PG8_STAGE(PG8_SA(1, 1), a1 + hstep, voffA);
            PG8_WAIT_V(8); PG8_WAIT_L(0); PG8_BAR; PG8_MMA(0, 0, At, B0); PG8_MMA(0, 1, At, B1); PG8_BAR; PG8_SCHED;
            PG8_LDA(At, 0, 1); PG8_STAGE(PG8_SB(0, 0), b2, voffB); PG8_STAGE(PG8_SB(0, 1), b2 + hstep, voffB); PG8_STAGE(PG8_SA(0, 0), a2, voffA);
            PG8_WAIT_V(8); PG8_WAIT_L(0); PG8_BAR; PG8_MMA(1, 0, At, B0); PG8_MMA(1, 1, At, B1); PG8_BAR; PG8_SCHED;
            PG8_LDB(B0, 1, 0); PG8_LDB(B1, 1, 1); PG8_SCHED; PG8_LDA(At, 1, 0); PG8_STAGE(PG8_SA(0, 1), a2 + hstep, voffA);
            PG8_WAIT_V(8); PG8_WAIT_L(0); PG8_BAR; PG8_MMA(0, 0, At, B0); PG8_MMA(0, 1, At, B1); PG8_BAR; PG8_SCHED;
            PG8_LDA(At, 1, 1); PG8_STAGE(PG8_SB(1, 0), b3, voffB); PG8_STAGE(PG8_SB(1, 1), b3 + hstep, voffB); PG8_STAGE(PG8_SA(1, 0), a3, voffA);
            PG8_WAIT_V(8); PG8_WAIT_L(0); PG8_BAR; PG8_MMA(1, 0, At, B0); PG8_MMA(1, 1, At, B1); PG8_BAR; PG8_SCHED;
            } else {
            PG8_LDB(B0, 0, 0); PG8_SCHED; PG8_LDA(At, 0, 0); PG8_STAGE(PG8_SA(1, 1), a1 + hstep, voffA);
            PG8_WAIT_L(8); PG8_BAR; PG8_WAIT_L(0); PG8_MMA(0, 0, At, B0); PG8_BAR; PG8_SCHED;
            PG8_LDB(B1, 0, 1); PG8_STAGE(PG8_SB(0, 0), b2, voffB);
            PG8_BAR; PG8_WAIT_L(0); PG8_MMA(0, 1, At, B1); PG8_BAR;
            PG8_LDA(At, 0, 1); PG8_STAGE(PG8_SA(0, 0), a2, voffA);
            PG8_BAR; PG8_WAIT_L(0); PG8_MMA(1, 0, At, B0); PG8_BAR; PG8_SCHED;
            PG8_STAGE(PG8_SB(0, 1), b2 + hstep, voffB);
            PG8_WAIT_V(6); PG8_BAR; PG8_MMA(1, 1, At, B1); PG8_BAR;
            PG8_LDB(B0, 1, 0); PG8_SCHED; PG8_LDA(At, 1, 0); PG8_STAGE(PG8_SA(0, 1), a2 + hstep, voffA);
            PG8_WAIT_L(8); PG8_BAR; PG8_WAIT_L(0); PG8_MMA(0, 0, At, B0); PG8_BAR; PG8_SCHED;
            PG8_LDB(B1, 1, 1); PG8_STAGE(PG8_SB(1, 0), b3, voffB);
            PG8_BAR; PG8_WAIT_L(0); PG8_MMA(0, 1, At, B1); PG8_BAR;
            PG8_LDA(At, 1, 1); PG8_STAGE(PG8_SA(1, 0), a3, voffA);
            PG8_BAR; PG8_WAIT_L(0); PG8_MMA(1, 0, At, B0); PG8_BAR; PG8_SCHED;
            PG8_STAGE(PG8_SB(1, 1), b3 + hstep, voffB);
            PG8_WAIT_V(6); PG8_BAR; PG8_MMA(1, 1, At, B1); PG8_BAR;
            }
        }
        if constexpr (ALIGN_EPI) { if (wr == 0) PG8_BAR; }
        if constexpr (!Epi::AFTER_DRAIN) { E(acc, cur, wr, wc, fr, fq); S.done(cur); }
        if (!has_next) break;
#pragma unroll
        for (int a = 0; a < 2; ++a)
#pragma unroll
            for (int b = 0; b < 2; ++b)
#pragma unroll
                for (int m = 0; m < 4; ++m)
#pragma unroll
                    for (int n = 0; n < 2; ++n) acc[a][b][m][n] = (f32x4){0.f, 0.f, 0.f, 0.f};
        cur = nxt; cA = nA; cB = nB; ++ui;
        if constexpr (ALIGN_EPI) { if (wr == 1) PG8_BAR; }
    }
    PG8_WAIT_V(0);
    if constexpr (!ALIGN_EPI) { if (wr == 0) PG8_BAR; }
    PG8_BAR;
    if constexpr (Epi::AFTER_DRAIN) { E.fused(acc, cur, wr, wc, fr, fq, lds, wid, lane); S.done(cur); }
#undef PG8_SA
#undef PG8_SB
#undef PG8_STAGE
#undef PG8_LDA
#undef PG8_LDB
#undef PG8_MMA
#undef PG8_WAIT_V
#undef PG8_WAIT_L
#undef PG8_BAR
#undef PG8_SCHED
}
}
constexpr int T_DN_TAIL = 2696;

namespace mk {
namespace cg = cooperative_groups;
using pg8::bf16_t; using pg8::bf16x8; using pg8::f32x4; using pg8::u32x4; using pg8::cvt_pk_bf16;
#define LAS __attribute__((address_space(3)))
constexpr int BATCH = 2, SEQ = 8192, DM = 2048, MTOK = BATCH * SEQ, DFF = 8192;
constexpr int DIN = 6680, NIN = 6912;
constexpr int C_GATE = 2560, C_QR = 2584;
constexpr int NCMP = 511, NCMPP = 512;
constexpr float NORM_EPS = 1e-6f, GN_EPS = 1e-6f, NEGV = -1e30f;
constexpr size_t MiB = 1u << 20;
constexpr size_t WS_BAR = 16384;
constexpr size_t WS_RSTD0 = 256 * 1024;
constexpr size_t WS_RSTD2 = 384 * 1024;
constexpr size_t XB_OFF = 64 * MiB;
constexpr size_t WS_CB = 1 * MiB - 8192;
constexpr size_t WS_CW2T = 1 * MiB + 4096;
constexpr size_t WS_CW1T = 2 * MiB;
constexpr size_t WS_KC = 4 * MiB;
constexpr size_t WS_VCT = 5 * MiB;
constexpr size_t WS_GATES = 6 * MiB;
constexpr size_t WS_ROPE = 8 * MiB;
constexpr size_t WS_WDNT = 16 * MiB;
constexpr size_t WS_WINT = 48 * MiB;
constexpr size_t WS_WOUTT = 76 * MiB;
constexpr size_t WS_WUPT = 84 * MiB;
constexpr size_t WS_H = 116 * MiB;
constexpr size_t WS_QA = 180 * MiB;
constexpr size_t WS_KV6 = 212 * MiB;
constexpr size_t WS_QR = 260 * MiB;
constexpr size_t WS_KR = 292 * MiB;
constexpr size_t WS_VR = 324 * MiB;
constexpr size_t WS_GR = 356 * MiB;
constexpr size_t WS_MIX = 180 * MiB;
constexpr size_t WS_UM = 180 * MiB;
constexpr size_t WS_Y = 48 * MiB;
constexpr size_t WS_RT = 436 * MiB;
constexpr size_t WS_X1 = 436 * MiB;
constexpr size_t WS_NEED = 500 * MiB;
#ifndef GEMM_SP2
#define GEMM_SP2 true
#endif
#ifndef GEMM_ALIGN
#define GEMM_ALIGN true
#endif
#ifndef WGM_IN
#define WGM_IN 4
#endif
#ifndef WGM_OUT
#define WGM_OUT 4
#endif
#ifndef WGM_UP
#define WGM_UP 4
#endif
#ifndef WGM_DN
#define WGM_DN 4
#endif
constexpr int LDS_BYTES = 147456;

struct Params { const float* in[18]; float* out; unsigned char* ws; int ph_lo, ph_hi; float lg[4]; double invf[128]; };

__device__ __forceinline__ float bf2f(unsigned v) { return __uint_as_float(v << 16); }
typedef unsigned u32x2_t __attribute__((ext_vector_type(2)));
__device__ __forceinline__ u32x4 ldnt16(const void* p) { return __builtin_nontemporal_load((const u32x4*)p); }
__device__ __forceinline__ uint2 ldnt8(const void* p) { const u32x2_t t = __builtin_nontemporal_load((const u32x2_t*)p); return make_uint2(t[0], t[1]); }
__device__ __forceinline__ float wave_sum(float v) {
#pragma unroll
    for (int o = 1; o < 64; o <<= 1) v += __shfl_xor(v, o);
    return v;
}
__device__ __forceinline__ float wave_max(float v) {
#pragma unroll
    for (int o = 1; o < 64; o <<= 1) v = fmaxf(v, __shfl_xor(v, o));
    return v;
}
#define LDS_WAIT() asm volatile("s_waitcnt lgkmcnt(0)" ::: "memory")
__device__ __forceinline__ int opaque_tid() { int x = threadIdx.x; asm volatile("" : "+v"(x)); return x; }

__device__ __forceinline__ int win_src(int n) { return n < 2560 ? n : (n < 6656 ? n + 24 : (n < 6680 ? n - 4096 : -1)); }
template <bool WIN, bool GAIN = false, bool FRAG = false>
__device__ __forceinline__ void transpose_pair(const float* W, int ld, int K, int Nout, bf16_t* WT, LAS float* scr, int q, int lane, const float* G = nullptr) {
    const int nblk = Nout / 32, item = 2 * q, kb = item / nblk, nb = item % nblk, k0 = 64 * kb, n0 = 32 * nb;
    const int np0 = n0 + (lane & 31), np1 = np0 + 32, src0 = WIN ? win_src(np0) : np0, src1 = WIN ? win_src(np1) : np1;
    float va[32], vb[32];
#pragma unroll
    for (int i = 0; i < 32; ++i) { const int kk = 2 * i + (lane >> 5); const float* rowp = W + (size_t)(k0 + kk) * ld;
        va[i] = src0 >= 0 ? __builtin_nontemporal_load(rowp + src0) : 0.f; vb[i] = src1 >= 0 ? __builtin_nontemporal_load(rowp + src1) : 0.f;
        if (GAIN) { const float gk = G[k0 + kk]; va[i] *= gk; vb[i] *= gk; } }
    const int c = lane & 7;
#pragma unroll
    for (int half = 0; half < 2; ++half) {
#pragma unroll
        for (int i = 0; i < 32; ++i) { const int kk = 2 * i + (lane >> 5); scr[kk * 33 + (lane & 31)] = half ? vb[i] : va[i]; }
        LDS_WAIT();
#pragma unroll
        for (int j = 0; j < 4; ++j) { const int n = (lane >> 3) + 8 * j; const LAS float* sp = scr + (8 * c) * 33 + n;
            u32x4 o; o.x = cvt_pk_bf16(sp[0 * 33], sp[1 * 33]); o.y = cvt_pk_bf16(sp[2 * 33], sp[3 * 33]); o.z = cvt_pk_bf16(sp[4 * 33], sp[5 * 33]); o.w = cvt_pk_bf16(sp[6 * 33], sp[7 * 33]);
            const int nn = n0 + 32 * half + n, kb8 = k0 + 8 * c;
            if (FRAG) *(u32x4*)(WT + ((size_t)((((kb8 >> 7) * 4 + ((kb8 >> 5) & 3)) * 8 + (nn >> 4)) * 64 + ((kb8 >> 3) & 3) * 16 + (nn & 15))) * 8) = o;
            else *(u32x4*)(WT + (size_t)nn * K + kb8) = o; }
        LDS_WAIT();
    }
}
__device__ __forceinline__ void sincos_d(double r, double& s, double& c) {
    const double r2 = r * r;
    double ts = 1.0, tc = 1.0, term_s = 1.0, term_c = 1.0;
#pragma unroll
    for (int k = 1; k <= 13; ++k) {
        constexpr double one = 1.0;
        const double ic = -one / (double)((2 * k - 1) * (2 * k)), is = -one / (double)((2 * k) * (2 * k + 1));
        term_c *= r2 * ic; tc += term_c;
        term_s *= r2 * is; ts += term_s;
    }
    s = r * ts; c = tc;
}
__device__ __forceinline__ void p0_prologue(const Params& p, LAS unsigned char* lds, int wave_, int lane_, int gw_, int NGW) {
    const int tid = opaque_tid(), lane = tid & 63, wave = __builtin_amdgcn_readfirstlane(tid >> 6), gw = blockIdx.x * 8 + wave; (void)wave_; (void)lane_; (void)gw_;
    unsigned char* ws = p.ws;
    LAS float* scr = (LAS float*)(lds + wave * 16384);
    constexpr int T_IN = (DM / 64) * (NIN / 32) / 2, T_OUT = (DM / 64) * (DM / 32) / 2, T_UP = (DM / 64) * (DFF / 32) / 2, T_DN = (DFF / 64) * (DM / 32) / 2, T_C1 = (4096 / 64) * (128 / 32) / 2, T_C2 = (128 / 64) * (128 / 32) / 2;
    constexpr int T_DN0 = T_DN - T_DN_TAIL;
    constexpr int NT = T_IN + T_OUT + T_UP + T_DN0 + 2 * T_C1 + 2 * T_C2;
    for (int it = gw; it < NT; it += NGW) {
        int r = it;
        if (r < T_IN) { transpose_pair<true, true>(p.in[2], DIN, DM, NIN, (bf16_t*)(ws + WS_WINT), scr, r, lane, p.in[1]); continue; } r -= T_IN;
        if (r < T_OUT) { transpose_pair<false>(p.in[12], DM, DM, DM, (bf16_t*)(ws + WS_WOUTT), scr, r, lane); continue; } r -= T_OUT;
        if (r < T_UP) { transpose_pair<false, true>(p.in[15], DFF, DM, DFF, (bf16_t*)(ws + WS_WUPT), scr, r, lane, p.in[14]); continue; } r -= T_UP;
        if (r < T_DN0) { transpose_pair<false>(p.in[16], DM, DFF, DM, (bf16_t*)(ws + WS_WDNT), scr, r, lane); continue; } r -= T_DN0;
        if (r < T_C1) { transpose_pair<false, false, true>(p.in[4], 128, 4096, 128, (bf16_t*)(ws + WS_CW1T), scr, r, lane); continue; } r -= T_C1;
        if (r < T_C1) { transpose_pair<false, false, true>(p.in[8], 128, 4096, 128, (bf16_t*)(ws + WS_CW1T) + 128 * 4096, scr, r, lane); continue; } r -= T_C1;
        if (r < T_C2) { transpose_pair<false>(p.in[6], 128, 128, 128, (bf16_t*)(ws + WS_CW2T), scr, r, lane); continue; } r -= T_C2;
        transpose_pair<false>(p.in[10], 128, 128, 128, (bf16_t*)(ws + WS_CW2T) + 128 * 128, scr, r, lane);
    }
    const float* x = p.in[0]; bf16_t* XB = (bf16_t*)((unsigned char*)p.out + XB_OFF); float* RS0 = (float*)(ws + WS_RSTD0);
    {
        for (int row0 = gw; row0 < MTOK; row0 += 4 * NGW) {
            float4 v[4][8];
#pragma unroll
            for (int r = 0; r < 4; ++r) { const int row = row0 + r * NGW;
                if (row < MTOK) {
#pragma unroll
                    for (int j = 0; j < 8; ++j) { const f32x4 t_ = __builtin_nontemporal_load((const f32x4*)(x + (size_t)row * DM) + lane + 64 * j); v[r][j] = make_float4(t_[0], t_[1], t_[2], t_[3]); }
                } }
#pragma unroll
            for (int r = 0; r < 4; ++r) { const int row = row0 + r * NGW;
                if (row < MTOK) {
                    float s = 0.f;
#pragma unroll
                    for (int j = 0; j < 8; ++j) s += v[r][j].x * v[r][j].x + v[r][j].y * v[r][j].y + v[r][j].z * v[r][j].z + v[r][j].w * v[r][j].w;
                    const float rstd = rsqrtf(wave_sum(s) * (1.0f / DM) + NORM_EPS);
                    if (lane == 0) RS0[row] = 1.0f / rstd;
                    uint2* o = (uint2*)(XB + (size_t)row * DM) + lane;
#pragma unroll
                    for (int j = 0; j < 8; ++j) { uint2 w; w.x = cvt_pk_bf16(v[r][j].x * rstd, v[r][j].y * rstd); w.y = cvt_pk_bf16(v[r][j].z * rstd, v[r][j].w * rstd); o[64 * j] = w; }
                } }
        }
    }
    float2* tab = (float2*)(ws + WS_ROPE);
    for (int idx = gw * 64 + lane; idx < SEQ * 128; idx += NGW * 64) {
        const int pos = idx >> 7, i = idx & 127;
        const float angf = (float)pos * (float)p.invf[i];
        const double ang = (double)angf, twopi = 6.283185307179586476925286766559;
        const double k = rint(ang * 0.15915494309189533576888376337251), r = ang - k * twopi;
        double s, c; sincos_d(r, s, c);
        tab[idx] = make_float2((float)c, (float)s);
    }
    float* CB = (float*)(ws + WS_CB);
    for (int o = gw; o < 8 * 256; o += NGW) {
        const int sl = o >> 8, oc = o & 255, kind = oc >> 7, c = oc & 127;
        const float* pe = kind ? p.in[7] : p.in[3]; const float* w1 = kind ? p.in[8] : p.in[4]; const float* b1 = kind ? p.in[9] : p.in[5];
        float s = 0.f;
#pragma unroll
        for (int i = 0; i < 8; ++i) { const int k = 512 * sl + 64 * i + lane; s += pe[k] * w1[(size_t)k * 128 + c]; }
        s = wave_sum(s);
        if (lane == 0) CB[o] = s + (sl == 0 ? b1[c] : 0.f);
    }
}

__device__ __forceinline__ void p1_tail_weights(const Params& p, LAS unsigned char* lds, int tw, int ntw) {
    const int tid = opaque_tid(), lane = tid & 63, wave = __builtin_amdgcn_readfirstlane(tid >> 6);
    LAS float* scr = (LAS float*)(lds + wave * 16384);
    constexpr int T_DN = (DFF / 64) * (DM / 32) / 2;
    for (int it = T_DN - T_DN_TAIL + tw; it < T_DN; it += ntw) transpose_pair<false>(p.in[16], DM, DFF, DM, (bf16_t*)(p.ws + WS_WDNT), scr, it, lane);
}

struct EpiInProj {
    static constexpr bool PERM = true, AFTER_DRAIN = false;
    bf16_t *QA, *KV6, *QR, *KR, *VR, *GR; float* GATES; const float2* rope; float lg0, lg1, lg2, lg3;
    __device__ __forceinline__ void operator()(const f32x4 (&acc)[2][2][4][2], const pg8::Unit& u, int wr, int wc, int fr, int fq) const {
        const int pn = u.pn, row0 = u.pm * 256 + wr * 64 + fr, cl0 = wc * 32 + 8 * fq;
        if (pn < 10 || (pn >= 18 && pn < 26)) {
            bf16_t* base; int ld;
            if (pn < 4) { base = QA + pn * 256; ld = 1024; }
            else if (pn < 10) { base = KV6 + (size_t)(pn - 4) * MTOK * 256; ld = 256; }
            else if (pn < 22) { base = VR + (pn - 18) * 256; ld = 1024; }
            else { base = GR + (pn - 22) * 256; ld = 1024; }
#pragma unroll
            for (int ai = 0; ai < 2; ++ai)
#pragma unroll
                for (int m = 0; m < 4; ++m) { bf16_t* rowp = base + (size_t)(row0 + ai * 128 + m * 16) * ld + cl0;
#pragma unroll
                    for (int bj = 0; bj < 2; ++bj) { f32x4 v0 = acc[ai][bj][m][0], v1 = acc[ai][bj][m][1];
                        u32x4 w; w.x = cvt_pk_bf16(v0[0], v0[1]); w.y = cvt_pk_bf16(v0[2], v0[3]); w.z = cvt_pk_bf16(v1[0], v1[1]); w.w = cvt_pk_bf16(v1[2], v1[3]);
                        *(u32x4*)(rowp + bj * 128) = w; } }
        } else if (pn < 18) {
            const bool isk = pn >= 14; const int hh = (pn - 10) & 3; bf16_t* base = (isk ? KR : QR) + hh * 256;
            const float lgh = hh == 0 ? lg0 : (hh == 1 ? lg1 : (hh == 2 ? lg2 : lg3));
            float4 TA[1][4], TB[1][4];
#define ROPE_LOAD(T_, q_) do { _Pragma("unroll") for (int j_ = 0; j_ < 1; ++j_) { const int idx_ = (q_) + j_, ai_ = idx_ >> 2, m_ = idx_ & 3; const int pos_ = (row0 + ai_ * 128 + m_ * 16) & (SEQ - 1); \
                const float4* t4_ = (const float4*)(rope + (size_t)pos_ * 128 + cl0); T_[j_][0] = t4_[0]; T_[j_][1] = t4_[1]; T_[j_][2] = t4_[2]; T_[j_][3] = t4_[3]; } } while (0)
#define ROPE_DO(T_, q_) do { _Pragma("unroll") for (int j_ = 0; j_ < 1; ++j_) { const int idx_ = (q_) + j_, ai = idx_ >> 2, m = idx_ & 3; const int row = row0 + ai * 128 + m * 16, pos = row & (SEQ - 1); \
                  \
                const float ef = (float)((pos & 127) + 1) * lgh; const float sc = isk ? 0.0625f * __expf(-ef) : __expf(ef); \
                const float4 ta = T_[j_][0], tb = T_[j_][1], tc = T_[j_][2], td = T_[j_][3];     \
                const f32x4 a0 = acc[ai][0][m][0], a1 = acc[ai][0][m][1], b0 = acc[ai][1][m][0], b1 = acc[ai][1][m][1]; \
                float o1[8], o2[8]; \
                o1[0] = a0[0] * ta.x - b0[0] * ta.y; o2[0] = b0[0] * ta.x + a0[0] * ta.y; \
                o1[1] = a0[1] * ta.z - b0[1] * ta.w; o2[1] = b0[1] * ta.z + a0[1] * ta.w; \
                o1[2] = a0[2] * tb.x - b0[2] * tb.y; o2[2] = b0[2] * tb.x + a0[2] * tb.y; \
                o1[3] = a0[3] * tb.z - b0[3] * tb.w; o2[3] = b0[3] * tb.z + a0[3] * tb.w; \
                o1[4] = a1[0] * tc.x - b1[0] * tc.y; o2[4] = b1[0] * tc.x + a1[0] * tc.y; \
                o1[5] = a1[1] * tc.z - b1[1] * tc.w; o2[5] = b1[1] * tc.z + a1[1] * tc.w; \
                o1[6] = a1[2] * td.x - b1[2] * td.y; o2[6] = b1[2] * td.x + a1[2] * td.y; \
                o1[7] = a1[3] * td.z - b1[3] * td.w; o2[7] = b1[3] * td.z + a1[3] * td.w; \
                u32x4 w1, w2; \
                w1.x = cvt_pk_bf16(o1[0] * sc, o1[1] * sc); w1.y = cvt_pk_bf16(o1[2] * sc, o1[3] * sc); w1.z = cvt_pk_bf16(o1[4] * sc, o1[5] * sc); w1.w = cvt_pk_bf16(o1[6] * sc, o1[7] * sc); \
                w2.x = cvt_pk_bf16(o2[0] * sc, o2[1] * sc); w2.y = cvt_pk_bf16(o2[2] * sc, o2[3] * sc); w2.z = cvt_pk_bf16(o2[4] * sc, o2[5] * sc); w2.w = cvt_pk_bf16(o2[6] * sc, o2[7] * sc); \
                bf16_t* rowp = base + (size_t)row * 1024 + cl0; \
                *(u32x4*)(rowp) = w1; *(u32x4*)(rowp + 128) = w2; } } while (0)
            ROPE_LOAD(TA, 0); ROPE_LOAD(TB, 1);
            ROPE_DO(TA, 0); ROPE_LOAD(TA, 2);
            ROPE_DO(TB, 1); ROPE_LOAD(TB, 3);
            ROPE_DO(TA, 2); ROPE_LOAD(TA, 4);
            ROPE_DO(TB, 3); ROPE_LOAD(TB, 5);
            ROPE_DO(TA, 4); ROPE_LOAD(TA, 6);
            ROPE_DO(TB, 5); ROPE_LOAD(TB, 7);
            ROPE_DO(TA, 6); ROPE_DO(TB, 7);
#undef ROPE_LOAD
#undef ROPE_DO
        } else {
            if (wc == 0 && fq < 3) {
#pragma unroll
                for (int ai = 0; ai < 2; ++ai)
#pragma unroll
                    for (int m = 0; m < 4; ++m) { const int row = row0 + ai * 128 + m * 16; float* gp = GATES + (size_t)row * 24 + 8 * fq;
                        f32x4 v0 = acc[ai][0][m][0], v1 = acc[ai][0][m][1];
                        *(f32x4*)gp = v0; *(f32x4*)(gp + 4) = v1; }
            }
        }
    }
};
struct RevOrder : pg8::StaticOrder {
    __device__ bool next(int i, pg8::Unit& u) const { const bool ok = pg8::StaticOrder::next(i, u); if (ok) u.pm = nM - 1 - u.pm; return ok; }
};
struct EpiBf16Plain {
    static constexpr bool PERM = true, AFTER_DRAIN = false;
    bf16_t* O; int ldc;
    __device__ __forceinline__ void operator()(const f32x4 (&acc)[2][2][4][2], const pg8::Unit& u, int wr, int wc, int fr, int fq) const {
        const int row0 = u.pm * 256 + wr * 64 + fr, col0 = u.pn * 256 + wc * 32 + 8 * fq;
#pragma unroll
        for (int ai = 0; ai < 2; ++ai)
#pragma unroll
            for (int m = 0; m < 4; ++m) { bf16_t* rowp = O + (size_t)(row0 + ai * 128 + m * 16) * ldc + col0;
#pragma unroll
                for (int bj = 0; bj < 2; ++bj) { const f32x4 v0 = acc[ai][bj][m][0], v1 = acc[ai][bj][m][1];
                    u32x4 w; w.x = cvt_pk_bf16(v0[0], v0[1]); w.y = cvt_pk_bf16(v0[2], v0[3]); w.z = cvt_pk_bf16(v1[0], v1[1]); w.w = cvt_pk_bf16(v1[2], v1[3]);
                    *(u32x4*)(rowp + bj * 128) = w; } }
    }
};
struct EpiRelu2 {
    static constexpr bool PERM = true, AFTER_DRAIN = false;
    bf16_t* O; int ldc;
    __device__ __forceinline__ void operator()(const f32x4 (&acc)[2][2][4][2], const pg8::Unit& u, int wr, int wc, int fr, int fq) const {
        const int row0 = u.pm * 256 + wr * 64 + fr, col0 = u.pn * 256 + wc * 32 + 8 * fq;
#pragma unroll
        for (int ai = 0; ai < 2; ++ai)
#pragma unroll
            for (int m = 0; m < 4; ++m) { bf16_t* rowp = O + (size_t)(row0 + ai * 128 + m * 16) * ldc + col0;
#pragma unroll
                for (int bj = 0; bj < 2; ++bj) { f32x4 v0 = acc[ai][bj][m][0], v1 = acc[ai][bj][m][1];
#pragma unroll
                    for (int e = 0; e < 4; ++e) { const float a = fmaxf(v0[e], 0.f), b = fmaxf(v1[e], 0.f); v0[e] = a * a; v1[e] = b * b; }
                    u32x4 w; w.x = cvt_pk_bf16(v0[0], v0[1]); w.y = cvt_pk_bf16(v0[2], v0[3]); w.z = cvt_pk_bf16(v1[0], v1[1]); w.w = cvt_pk_bf16(v1[2], v1[3]);
                    *(u32x4*)(rowp + bj * 128) = w; } }
    }
};

__device__ __forceinline__ void p6_resnorm(const Params& p, LAS unsigned char* lds, int NGW) {
    const int tid = opaque_tid(), lane = tid & 63, gw = blockIdx.x * 8 + __builtin_amdgcn_readfirstlane(tid >> 6);
    const bf16_t* xb = (const bf16_t*)((const unsigned char*)p.out + XB_OFF); const bf16_t* mix = (const bf16_t*)(p.ws + WS_MIX);
    float* RS2 = (float*)(p.ws + WS_RSTD2); const float* RS0 = (const float*)(p.ws + WS_RSTD0);
    LAS f32x4* gl1 = (LAS f32x4*)lds;
    __syncthreads();
    gl1[tid] = ((const f32x4*)p.in[13])[tid];
    __syncthreads();
    for (int row0 = gw; row0 < MTOK; row0 += 4 * NGW) {
        uint2 cm[4][8], cx[4][8];
#pragma unroll
        for (int r = 0; r < 4; ++r) { const int row = row0 + r * NGW;
            if (row < MTOK) {
#pragma unroll
                for (int j = 0; j < 8; ++j) { cm[r][j] = ldnt8((const uint2*)(mix + (size_t)row * DM) + lane + 64 * j); cx[r][j] = ldnt8((const uint2*)(xb + (size_t)row * DM) + lane + 64 * j); }
            } }
#pragma unroll
        for (int r = 0; r < 4; ++r) { const int row = row0 + r * NGW;
            if (row < MTOK) {
                float4 v[8]; float s = 0.f;
#pragma unroll
                for (int j = 0; j < 8; ++j) { v[j] = make_float4(bf2f(cm[r][j].x & 0xffffu), bf2f(cm[r][j].x >> 16), bf2f(cm[r][j].y & 0xffffu), bf2f(cm[r][j].y >> 16));
                    s += v[j].x * v[j].x + v[j].y * v[j].y + v[j].z * v[j].z + v[j].w * v[j].w; }
                const float rstd = rsqrtf(wave_sum(s) * (1.0f / DM) + NORM_EPS), rms0 = RS0[row];
                float s2 = 0.f; uint2* orow = (uint2*)((bf16_t*)(p.ws + WS_X1) + (size_t)row * DM) + lane;
#pragma unroll
                for (int j = 0; j < 8; ++j) { const f32x4 g = gl1[lane + 64 * j]; const uint2 xw0 = cx[r][j];
                    v[j].x = bf2f(xw0.x & 0xffffu) * rms0 + v[j].x * rstd * g[0]; v[j].y = bf2f(xw0.x >> 16) * rms0 + v[j].y * rstd * g[1]; v[j].z = bf2f(xw0.y & 0xffffu) * rms0 + v[j].z * rstd * g[2]; v[j].w = bf2f(xw0.y >> 16) * rms0 + v[j].w * rstd * g[3];
                    s2 += v[j].x * v[j].x + v[j].y * v[j].y + v[j].z * v[j].z + v[j].w * v[j].w; }
                const float rstd2 = rsqrtf(wave_sum(s2) * (1.0f / DM) + NORM_EPS);
                if (lane == 0) RS2[row] = 1.0f / rstd2;
#pragma unroll
                for (int j = 0; j < 8; ++j) { uint2 xw; xw.x = cvt_pk_bf16(v[j].x * rstd2, v[j].y * rstd2); xw.y = cvt_pk_bf16(v[j].z * rstd2, v[j].w * rstd2); orow[64 * j] = xw; }
            } }
    }
}
__device__ __forceinline__ void p9_final(const Params& p, LAS unsigned char* lds, int NGW) {
    const int tid = opaque_tid(), lane = tid & 63, gw = blockIdx.x * 8 + __builtin_amdgcn_readfirstlane(tid >> 6);
    const bf16_t* y = (const bf16_t*)(p.ws + WS_Y);
    LAS f32x4* gl = (LAS f32x4*)lds;
    __syncthreads();
    gl[tid] = ((const f32x4*)p.in[17])[tid];
    __syncthreads();
    for (int row0 = gw; row0 < MTOK; row0 += 3 * NGW) {
        uint2 cy[3][8], co[3][8];
#pragma unroll
        for (int r = 0; r < 3; ++r) { const int row = row0 + r * NGW;
            if (row < MTOK) {
#pragma unroll
                for (int j = 0; j < 8; ++j) { cy[r][j] = ldnt8((const uint2*)(y + (size_t)row * DM) + lane + 64 * j); co[r][j] = ldnt8((const uint2*)((const bf16_t*)(p.ws + WS_X1) + (size_t)row * DM) + lane + 64 * j); }
            } }
#pragma unroll
        for (int r = 0; r < 3; ++r) { const int row = row0 + r * NGW;
            if (row < MTOK) {
                float4 v[8]; float s = 0.f;
#pragma unroll
                for (int j = 0; j < 8; ++j) { v[j] = make_float4(bf2f(cy[r][j].x & 0xffffu), bf2f(cy[r][j].x >> 16), bf2f(cy[r][j].y & 0xffffu), bf2f(cy[r][j].y >> 16));
                    s += v[j].x * v[j].x + v[j].y * v[j].y + v[j].z * v[j].z + v[j].w * v[j].w; }
                const float rstd = rsqrtf(wave_sum(s) * (1.0f / DM) + NORM_EPS), rms2 = ((const float*)(p.ws + WS_RSTD2))[row];
                float4* orow = (float4*)(p.out + (size_t)row * DM) + lane;
#pragma unroll
                for (int j = 0; j < 8; ++j) { const f32x4 g = gl[lane + 64 * j]; const uint2 xw = co[r][j]; float4 o;
                    o.x = bf2f(xw.x & 0xffffu) * rms2 + v[j].x * rstd * g[0]; o.y = bf2f(xw.x >> 16) * rms2 + v[j].y * rstd * g[1]; o.z = bf2f(xw.y & 0xffffu) * rms2 + v[j].z * rstd * g[2]; o.w = bf2f(xw.y >> 16) * rms2 + v[j].w * rstd * g[3];
                    __builtin_nontemporal_store(o.x, &((float*)(orow + 64 * j))[0]); __builtin_nontemporal_store(o.y, &((float*)(orow + 64 * j))[1]); __builtin_nontemporal_store(o.z, &((float*)(orow + 64 * j))[2]); __builtin_nontemporal_store(o.w, &((float*)(orow + 64 * j))[3]); }
            } }
    }
}

__device__ __forceinline__ int t5_bucket(int rel) {
    const int n = rel > 0 ? rel : 0;
    if (n < 16) return n;
    const float nf = (float)n;
    int large = 16 + (int)(logf(nf / 16.0f) / 2.0794415416798357f * 16.0f);
    return large < 31 ? large : 31;
}

typedef short v4s __attribute__((ext_vector_type(4)));
__device__ __forceinline__ f32x4 mfma16(bf16x8 a, bf16x8 b, f32x4 c) { return __builtin_amdgcn_mfma_f32_16x16x32_bf16(a, b, c, 0, 0, 0); }
__device__ __forceinline__ bf16x8 tr_frag(const LAS bf16_t* X, int ld, int c0, int n0, int lane) {
    const int fq = lane >> 4, q = (lane & 15) >> 2, pq = lane & 3;
    const LAS bf16_t* a0 = X + (c0 + 4 * fq + q) * ld + n0 + 4 * pq;
    const v4s lo = __builtin_amdgcn_ds_read_tr16_b64_v4i16((LAS v4s*)a0);
    const v4s hi = __builtin_amdgcn_ds_read_tr16_b64_v4i16((LAS v4s*)(a0 + 16 * ld));
    return (bf16x8){lo[0], lo[1], lo[2], lo[3], hi[0], hi[1], hi[2], hi[3]};
}
__device__ __forceinline__ bf16x8 pack8(f32x4 a, f32x4 b) {
    u32x4 w; w.x = cvt_pk_bf16(a[0], a[1]); w.y = cvt_pk_bf16(a[2], a[3]); w.z = cvt_pk_bf16(b[0], b[1]); w.w = cvt_pk_bf16(b[2], b[3]);
    return __builtin_bit_cast(bf16x8, w);
}
__device__ __forceinline__ void swap16(unsigned& a, unsigned& b) { const auto r = __builtin_amdgcn_permlane16_swap(a, b, false, false); a = r[0]; b = r[1]; }
__device__ __forceinline__ void swap16f(float& a, float& b) { unsigned x = __float_as_uint(a), y = __float_as_uint(b); swap16(x, y); a = __uint_as_float(x); b = __uint_as_float(y); }
constexpr int RLD = 272;

__device__ __forceinline__ void stage_128x256(const bf16_t* g, LAS bf16_t* X, int tid) {
#pragma unroll
    for (int k = 0; k < 8; ++k) { const int pc = tid + 512 * k, r = pc >> 5, c8 = pc & 31;
        const u32x4 v = ldnt16(g + (size_t)r * 1024 + 8 * c8);
        *(LAS u32x4*)(X + r * RLD + 8 * c8) = v; }
}
__device__ __forceinline__ void mf_ret_u_items(const Params& p, int first, int stride, LAS unsigned char* lds) {
    const int tid = opaque_tid(), lane = tid & 63, wave = __builtin_amdgcn_readfirstlane(tid >> 6);
    unsigned char* ws = p.ws;
    LAS bf16_t* Kl = (LAS bf16_t*)lds; LAS bf16_t* Vl = Kl + 128 * RLD;
    const int wr = wave >> 1, wc = wave & 1, fr = lane & 15, fq = lane >> 4;
    u32x4 kst[8], vst[8];
#define RU_LOAD(bhn_) do { const int n_ = (bhn_) & 63, bh_ = (bhn_) >> 6; const size_t row0_ = (size_t)(bh_ >> 2) * SEQ + n_ * 128; \
        const bf16_t* kg_ = (const bf16_t*)(ws + WS_KR) + row0_ * 1024 + (bh_ & 3) * 256; const bf16_t* vg_ = (const bf16_t*)(ws + WS_VR) + row0_ * 1024 + (bh_ & 3) * 256; \
        _Pragma("unroll") for (int k_ = 0; k_ < 8; ++k_) { const int pc_ = tid + 512 * k_, r_ = pc_ >> 5, c8_ = pc_ & 31; \
            kst[k_] = *(const u32x4*)(kg_ + (size_t)r_ * 1024 + 8 * c8_); vst[k_] = *(const u32x4*)(vg_ + (size_t)r_ * 1024 + 8 * c8_); } } while (0)
    if (first < 512) RU_LOAD(first);
#pragma unroll 1
    for (int bhn = first; bhn < 512; bhn += stride) {
#pragma unroll
        for (int k = 0; k < 8; ++k) { const int pc = tid + 512 * k, r = pc >> 5, c8 = pc & 31; *(LAS u32x4*)(Kl + r * RLD + 8 * c8) = kst[k]; *(LAS u32x4*)(Vl + r * RLD + 8 * c8) = vst[k]; }
        __syncthreads();
        if (bhn + stride < 512) RU_LOAD(bhn + stride);
        bf16_t* UT = (bf16_t*)p.out + (size_t)bhn * 65536;
#pragma unroll 1
        for (int hf = 0; hf < 2; ++hf) {
            const int dk0 = 128 * wc + 64 * hf;
            f32x4 acc[4][4];
#pragma unroll
            for (int m = 0; m < 4; ++m)
#pragma unroll
                for (int nn = 0; nn < 4; ++nn) acc[m][nn] = (f32x4){0.f, 0.f, 0.f, 0.f};
#pragma unroll
            for (int kc = 0; kc < 4; ++kc) {
                bf16x8 a[4], bb[4];
#pragma unroll
                for (int m = 0; m < 4; ++m) a[m] = tr_frag(Vl, RLD, 32 * kc, 64 * wr + 16 * m, lane);
#pragma unroll
                for (int nn = 0; nn < 4; ++nn) bb[nn] = tr_frag(Kl, RLD, 32 * kc, dk0 + 16 * nn, lane);
#pragma unroll
                for (int m = 0; m < 4; ++m)
#pragma unroll
                    for (int nn = 0; nn < 4; ++nn) acc[m][nn] = mfma16(bb[nn], a[m], acc[m][nn]);
            }
#pragma unroll
            for (int m = 0; m < 4; ++m)
#pragma unroll
                for (int P = 0; P < 2; ++P) {
                    unsigned ax = cvt_pk_bf16(acc[m][2 * P][0], acc[m][2 * P][1]), ay = cvt_pk_bf16(acc[m][2 * P][2], acc[m][2 * P][3]);
                    unsigned bx = cvt_pk_bf16(acc[m][2 * P + 1][0], acc[m][2 * P + 1][1]), by = cvt_pk_bf16(acc[m][2 * P + 1][2], acc[m][2 * P + 1][3]);
                    swap16(ax, bx); swap16(ay, by);
                    *(u32x4*)(UT + (size_t)(64 * wr + 16 * m + fr) * 256 + dk0 + 32 * P + 16 * (fq & 1) + 8 * (fq >> 1)) = (u32x4){ax, ay, bx, by};
                }
        }
        __syncthreads();
    }
#undef RU_LOAD
}
__device__ __forceinline__ void mf_ret_scan(const Params& p, int gtid, int gthreads) {
    const bf16_t* UT = (const bf16_t*)p.out; bf16_t* RT = (bf16_t*)(p.ws + WS_RT);
    for (int e4 = gtid; e4 < 8 * 16384; e4 += gthreads) {
        const int bh = e4 >> 14, el = (e4 & 16383) * 4, h = bh & 3;
        const float gc = __expf(128.0f * p.lg[h]);
        float4 r = make_float4(0.f, 0.f, 0.f, 0.f);
        const bf16_t* up = UT + (size_t)bh * 64 * 65536 + el; bf16_t* rp = RT + (size_t)bh * 64 * 65536 + el;
        uint2 ua[8], ub[8];
#define SC_LOAD(U_, n0_) do { _Pragma("unroll") for (int k_ = 0; k_ < 8; ++k_) U_[k_] = ldnt8(up + (size_t)((n0_) + k_) * 65536); } while (0)
#define SC_STEP(U_, n0_) do { _Pragma("unroll") for (int k_ = 0; k_ < 8; ++k_) { const uint2 uw = U_[k_]; \
            const float4 u = make_float4(bf2f(uw.x & 0xffffu), bf2f(uw.x >> 16), bf2f(uw.y & 0xffffu), bf2f(uw.y >> 16)); \
            uint2 w; w.x = cvt_pk_bf16(r.x, r.y); w.y = cvt_pk_bf16(r.z, r.w); *(uint2*)(rp + (size_t)((n0_) + k_) * 65536) = w; \
            r.x = gc * (r.x + u.x); r.y = gc * (r.y + u.y); r.z = gc * (r.z + u.z); r.w = gc * (r.w + u.w); } } while (0)
        SC_LOAD(ua, 0); SC_LOAD(ub, 8);
#pragma unroll
        for (int n0 = 0; n0 < 64; n0 += 16) {
            SC_STEP(ua, n0); if (n0 + 16 < 64) SC_LOAD(ua, n0 + 16);
            SC_STEP(ub, n0 + 8); if (n0 + 24 < 64) SC_LOAD(ub, n0 + 24);
        }
#undef SC_LOAD
#undef SC_STEP
    }
}
constexpr int RO_RT = 128 * RLD * 2;
__device__ __forceinline__ void mf_ret_out(const Params& p, int bhn, LAS unsigned char* lds, int tid_, int wave_, int lane_) {
    const int tid = opaque_tid(), lane = tid & 63, wave = __builtin_amdgcn_readfirstlane(tid >> 6); (void)tid_; (void)wave_; (void)lane_;
    unsigned char* ws = p.ws;
    const int n = bhn & 63, bh = bhn >> 6, b = bh >> 2, h = bh & 3;
    const size_t row0 = (size_t)b * SEQ + n * 128;
    LAS bf16_t* Vl = (LAS bf16_t*)lds;
    const bf16_t* Rg = (const bf16_t*)(ws + WS_RT) + (size_t)bhn * 65536;
    const int srow = tid >> 4, sch = tid & 15;
    const int fr = lane & 15, fq = lane >> 4;
    const bf16_t* Qg = (const bf16_t*)(ws + WS_QR) + (row0 + 16 * wave + fr) * 1024 + h * 256 + 8 * fq;
    bf16x8 qf[8];
#pragma unroll
    for (int kc = 0; kc < 8; ++kc) qf[kc] = __builtin_bit_cast(bf16x8, ldnt16(Qg + 32 * kc));
    u32x4 rstg[8], rt0[8], rt1[8];
    { const bf16_t* Kt = (const bf16_t*)(ws + WS_KR) + row0 * 1024 + h * 256;
#pragma unroll
      for (int k = 0; k < 8; ++k) { const int pc = tid + 512 * k, r = pc >> 5, c8 = pc & 31; rstg[k] = ldnt16(Kt + (size_t)r * 1024 + 8 * c8); } }
#pragma unroll
    for (int k = 0; k < 8; ++k) { rt0[k] = ldnt16(Rg + (size_t)(srow + 32 * k) * 256 + 8 * sch); rt1[k] = ldnt16(Rg + (size_t)(srow + 32 * k) * 256 + 128 + 8 * sch); }
    stage_128x256((const bf16_t*)(ws + WS_VR) + row0 * 1024 + h * 256, Vl, tid);
#pragma unroll
    for (int k = 0; k < 8; ++k) { const int pc = tid + 512 * k, r = pc >> 5, c8 = pc & 31; *(LAS u32x4*)(lds + RO_RT + r * 512 + (((c8 & 16) | ((c8 ^ r) & 15)) << 4)) = rstg[k]; }
    __syncthreads();
    f32x4 st[8];
#pragma unroll
    for (int jt = 0; jt < 8; ++jt) {
        st[jt] = (f32x4){0.f, 0.f, 0.f, 0.f};
        if (jt <= wave) {
            bf16x8 kfr[8];
#pragma unroll
            for (int kc = 0; kc < 8; ++kc) { const int ch = 4 * kc + fq; kfr[kc] = *(const LAS bf16x8*)(lds + RO_RT + (16 * jt + fr) * 512 + (((ch & 16) | ((ch ^ fr) & 15)) << 4)); }
#pragma unroll
            for (int kc = 0; kc < 8; ++kc) st[jt] = mfma16(kfr[kc], qf[kc], st[jt]);
            if (jt == wave) {
#pragma unroll
                for (int r = 0; r < 4; ++r) if (4 * fq + r > fr) st[jt][r] = 0.f;
            }
        }
    }
    __syncthreads();
#pragma unroll
    for (int k = 0; k < 8; ++k) { const int r = srow + 32 * k; *(LAS u32x4*)(lds + RO_RT + r * 256 + ((sch ^ (r & 15)) << 4)) = rt0[k]; }
    const bf16_t* Gg = (const bf16_t*)(ws + WS_GR) + (row0 + 16 * wave + fr) * 1024 + h * 256 + 8 * (fq >> 1) + 16 * (fq & 1);
    u32x4 gwv[8];
#pragma unroll
    for (int P = 0; P < 8; ++P) gwv[P] = ldnt16(Gg + 32 * P);
    f32x4 acc[16];
#pragma unroll
    for (int dt = 0; dt < 16; ++dt) acc[dt] = (f32x4){0.f, 0.f, 0.f, 0.f};
#pragma unroll
    for (int C = 0; C < 4; ++C) {
        if (2 * C <= wave) {
            const bf16x8 pb = pack8(st[2 * C], st[2 * C + 1]);
#pragma unroll
            for (int dt = 0; dt < 16; ++dt) acc[dt] = mfma16(tr_frag(Vl, RLD, 32 * C, 16 * dt, lane), pb, acc[dt]);
        }
    }
    __syncthreads();
    const unsigned rbase = (unsigned)(RO_RT + fr * 256);
#pragma unroll 1
    for (int hf = 0; hf < 2; ++hf) {
        if (hf == 1) {
            __syncthreads();
#pragma unroll
            for (int k = 0; k < 8; ++k) { const int r = srow + 32 * k; *(LAS u32x4*)(lds + RO_RT + r * 256 + ((sch ^ (r & 15)) << 4)) = rt1[k]; }
            __syncthreads();
        }
        bf16x8 rfA[8], rfB[8];
#define RO_RD(RF, grp_) do { const int kc_ = (grp_) >> 1, d8_ = ((grp_) & 1) * 8; const unsigned coff_ = (unsigned)(((4 * kc_ + fq) ^ fr) << 4); \
            _Pragma("unroll") for (int i_ = 0; i_ < 8; ++i_) RF[i_] = *(const LAS bf16x8*)(lds + rbase + (d8_ + i_) * 4096 + coff_); } while (0)
#define RO_MM(RF, grp_) do { const int kc_ = (grp_) >> 1, d8_ = ((grp_) & 1) * 8; const bf16x8 qv_ = hf ? qf[4 + kc_] : qf[kc_]; \
            _Pragma("unroll") for (int i_ = 0; i_ < 8; ++i_) acc[d8_ + i_] = mfma16(RF[i_], qv_, acc[d8_ + i_]); } while (0)
        RO_RD(rfA, 0);
#pragma unroll
        for (int g2 = 0; g2 < 8; g2 += 2) {
            RO_RD(rfB, g2 + 1); RO_MM(rfA, g2);
            if (g2 + 2 < 8) RO_RD(rfA, g2 + 2);
            RO_MM(rfB, g2 + 1);
        }
#undef RO_RD
#undef RO_MM
    }
    float s = 0.f;
#pragma unroll
    for (int dt = 0; dt < 16; ++dt) s += (acc[dt][0] + acc[dt][1]) + (acc[dt][2] + acc[dt][3]);
    s += __shfl_xor(s, 16); s += __shfl_xor(s, 32);
    const float mu = s * (1.0f / 256.0f);
    float q = 0.f;
#pragma unroll
    for (int dt = 0; dt < 16; ++dt)
#pragma unroll
        for (int r = 0; r < 4; ++r) { const float d = acc[dt][r] - mu; q += d * d; }
    q += __shfl_xor(q, 16); q += __shfl_xor(q, 32);
    const float rstd = rsqrtf(q * (1.0f / 256.0f) + GN_EPS);
    bf16_t* Og = (bf16_t*)(ws + WS_H) + (row0 + 16 * wave + fr) * 2048 + 1024 + h * 256 + 8 * (fq >> 1) + 16 * (fq & 1);
#pragma unroll
    for (int P = 0; P < 8; ++P) {
        float v[8];
#pragma unroll
        for (int r = 0; r < 4; ++r) { float a_ = acc[2 * P][r], b_ = acc[2 * P + 1][r]; swap16f(a_, b_); v[r] = (a_ - mu) * rstd; v[4 + r] = (b_ - mu) * rstd; }
        const u32x4 gw = gwv[P];
        const unsigned gwd[4] = {gw.x, gw.y, gw.z, gw.w};
        unsigned wd[4];
#pragma unroll
        for (int k = 0; k < 4; ++k) {
            const float g0 = bf2f(gwd[k] & 0xffffu), g1 = bf2f(gwd[k] >> 16);
            wd[k] = cvt_pk_bf16(g0 * __builtin_amdgcn_rcpf(1.0f + __expf(-g0)) * v[2 * k], g1 * __builtin_amdgcn_rcpf(1.0f + __expf(-g1)) * v[2 * k + 1]);
        }
        *(u32x4*)(Og + 32 * P) = (u32x4){wd[0], wd[1], wd[2], wd[3]};
    }
    __syncthreads();
}
__device__ __forceinline__ void mf_compress(const Params& p, int item, LAS unsigned char* lds, int tid_, int wave_, int lane_) {
    const int tid = opaque_tid(), lane = tid & 63, wave = __builtin_amdgcn_readfirstlane(tid >> 6); (void)tid_; (void)wave_; (void)lane_;
    unsigned char* ws = p.ws;
    const int Tp = item & 15, g = (item >> 4) & 1, b = (item >> 5) & 1, kind = item >> 6;
    const int fr = lane & 15, fq = lane >> 4;
    const bf16_t* KV = (const bf16_t*)(ws + WS_KV6) + (size_t)kind * MTOK * 256;
    const bf16_t* W1T = (const bf16_t*)(ws + WS_CW1T) + (size_t)kind * 128 * 4096;
    const bf16_t* W2T = (const bf16_t*)(ws + WS_CW2T) + (size_t)kind * 128 * 128;
    const float* CB = (const float*)(ws + WS_CB) + kind * 128;
    LAS float* red = (LAS float*)lds;
    LAS bf16_t* hid = (LAS bf16_t*)(lds + 131072);
    f32x4 acc[2][8];
#pragma unroll
    for (int rg = 0; rg < 2; ++rg)
#pragma unroll
        for (int ct = 0; ct < 8; ++ct) acc[rg][ct] = (f32x4){0.f, 0.f, 0.f, 0.f};
    const int nblk = 32 * Tp + fr;
    bf16x8 afA[2], afB[2], bfA[8], bfB[8];
#define CMP_LOAD(AF, BF, step_) do { const int ll_ = (step_) >> 2, kc_ = (step_) & 3, l_ = 4 * wave + ll_; \
        _Pragma("unroll") for (int rg_ = 0; rg_ < 2; ++rg_) { int tok_ = 16 * (nblk + 16 * rg_) + l_; tok_ = tok_ < SEQ ? tok_ : SEQ - 1; \
            AF[rg_] = *(const bf16x8*)(KV + ((size_t)b * SEQ + tok_) * 256 + g * 128 + 8 * fq + 32 * kc_); } \
        _Pragma("unroll") for (int ct_ = 0; ct_ < 8; ++ct_) BF[ct_] = *(const bf16x8*)(W1T + ((size_t)(((l_ * 4 + kc_) * 8 + ct_) * 64 + lane)) * 8); } while (0)
#define CMP_MMA(AF, BF) do { _Pragma("unroll") for (int ct_ = 0; ct_ < 8; ++ct_) { acc[0][ct_] = mfma16(AF[0], BF[ct_], acc[0][ct_]); acc[1][ct_] = mfma16(AF[1], BF[ct_], acc[1][ct_]); } } while (0)
    CMP_LOAD(afA, bfA, 0);
#pragma unroll
    for (int st2 = 0; st2 < 16; st2 += 2) {
        CMP_LOAD(afB, bfB, st2 + 1);
        CMP_MMA(afA, bfA);
        if (st2 + 2 < 16) CMP_LOAD(afA, bfA, st2 + 2);
        CMP_MMA(afB, bfB);
    }
#undef CMP_LOAD
#undef CMP_MMA
#pragma unroll
    for (int rg = 0; rg < 2; ++rg)
#pragma unroll
        for (int ct = 0; ct < 8; ++ct)
#pragma unroll
            for (int r = 0; r < 4; ++r) red[(wave * 32 + 16 * rg + 4 * fq + r) * 128 + 16 * ct + fr] = acc[rg][ct][r];
    __syncthreads();
    float cbs = 0.f;
#pragma unroll
    for (int sl = 0; sl < 8; ++sl) cbs += CB[sl * 256 + (tid & 127)];
    for (int idx = tid; idx < 4096; idx += 512) {
        const int nn = idx >> 7, c = idx & 127; float hsum = cbs;
#pragma unroll
        for (int w = 0; w < 8; ++w) hsum += red[(w * 32 + nn) * 128 + c];
        const float x3 = hsum * hsum * hsum;
        hsum = 0.5f * hsum * (1.0f + tanhf(0.7978845608028654f * (hsum + 0.044715f * x3)));
        hid[nn * 136 + c] = (bf16_t)(cvt_pk_bf16(hsum, 0.f) & 0xffffu);
    }
    __syncthreads();
    f32x4 o[2] = {(f32x4){0.f, 0.f, 0.f, 0.f}, (f32x4){0.f, 0.f, 0.f, 0.f}};
#pragma unroll
    for (int kc = 0; kc < 4; ++kc) { const bf16x8 wf = *(const bf16x8*)(W2T + (size_t)(16 * wave + fr) * 128 + 32 * kc + 8 * fq);
        o[0] = mfma16(*(const LAS bf16x8*)(hid + fr * 136 + 32 * kc + 8 * fq), wf, o[0]); o[1] = mfma16(*(const LAS bf16x8*)(hid + (16 + fr) * 136 + 32 * kc + 8 * fq), wf, o[1]); }
    {
        bf16_t* OC = (bf16_t*)(ws + (kind == 0 ? WS_KC : WS_VCT)) + ((size_t)(b * 2 + g) * NCMPP + 32 * Tp) * 128 + 16 * wave + fr;
#pragma unroll
        for (int rg = 0; rg < 2; ++rg)
#pragma unroll
            for (int r = 0; r < 4; ++r) OC[(16 * rg + 4 * fq + r) * 128] = (bf16_t)(cvt_pk_bf16(o[rg][r], 0.f) & 0xffffu);
    }
    __syncthreads();
}


constexpr int ALD = 144;
constexpr int A_KV = 0, A_KVBUF = 32768, A_VOFF = 16384, A_SEL = 98304, A_BIAS = 99328, A_IMP = 103424, IMPLD = 129;
constexpr float QK_SCALE = 0.08838834764831845f;

__device__ __forceinline__ u32x4 ldg16(const void* ubase, unsigned voff) { return *(const u32x4*)((const char*)ubase + voff); }
__device__ __forceinline__ bf16x8 ldg_frag(const void* ubase, unsigned voff) { return __builtin_bit_cast(bf16x8, *(const u32x4*)((const char*)ubase + voff)); }
__device__ __forceinline__ bf16x8 lds_frag(LAS unsigned char* lds, unsigned off) { return *(const LAS bf16x8*)(lds + off); }
__device__ __forceinline__ bf16x8 tr_frag_b(LAS unsigned char* lds, unsigned off, unsigned hi16) {
    const v4s lo = __builtin_amdgcn_ds_read_tr16_b64_v4i16((LAS v4s*)(lds + off));
    const v4s hi = __builtin_amdgcn_ds_read_tr16_b64_v4i16((LAS v4s*)(lds + off + hi16));
    return (bf16x8){lo[0], lo[1], lo[2], lo[3], hi[0], hi[1], hi[2], hi[3]};
}
constexpr float LOG2E = 1.4426950408889634f, C1 = QK_SCALE * LOG2E, RESCALE_THR = 8.0f;
__device__ __forceinline__ float ex2(float x) { return __builtin_amdgcn_exp2f(x); }
__device__ __forceinline__ void lds_addfix(LAS unsigned* pz, float v) { (void)__hip_atomic_fetch_add(pz, (unsigned)__float2uint_rn(v * 67108864.0f), __ATOMIC_RELAXED, __HIP_MEMORY_SCOPE_WORKGROUP); }
__device__ __forceinline__ int sum8_dpp(int v) {
    v += __builtin_amdgcn_mov_dpp(v, 0xB1, 0xf, 0xf, true);
    v += __builtin_amdgcn_mov_dpp(v, 0x4E, 0xf, 0xf, true);
    v += __builtin_amdgcn_mov_dpp(v, 0x141, 0xf, 0xf, true);
    return v;
}
__device__ __forceinline__ float max16(const f32x4& a, const f32x4& b, const f32x4& c, const f32x4& d) {
    return fmaxf(fmaxf(fmaxf(fmaxf(a[0], a[1]), fmaxf(a[2], a[3])), fmaxf(fmaxf(b[0], b[1]), fmaxf(b[2], b[3]))),
                 fmaxf(fmaxf(fmaxf(c[0], c[1]), fmaxf(c[2], c[3])), fmaxf(fmaxf(d[0], d[1]), fmaxf(d[2], d[3]))));
}
typedef int v2i __attribute__((ext_vector_type(2)));
#define TR_READ_ASM(dst, addr, off) asm volatile("ds_read_b64_tr_b16 %0, %1 offset:%2" : "=v"(dst) : "v"(addr), "i"(off))
__device__ __forceinline__ bf16x8 ldg_qfrag(const void* ubase, unsigned voff) {
    const u32x4 v = ldnt16((const char*)ubase + voff); u32x4 w;
    w.x = cvt_pk_bf16(bf2f(v.x & 0xffffu) * C1, bf2f(v.x >> 16) * C1); w.y = cvt_pk_bf16(bf2f(v.y & 0xffffu) * C1, bf2f(v.y >> 16) * C1);
    w.z = cvt_pk_bf16(bf2f(v.z & 0xffffu) * C1, bf2f(v.z >> 16) * C1); w.w = cvt_pk_bf16(bf2f(v.w & 0xffffu) * C1, bf2f(v.w >> 16) * C1);
    return __builtin_bit_cast(bf16x8, w);
}
__device__ __forceinline__ void mf_nsa(const Params& p, int bg, int c, LAS unsigned char* lds, int tid_, int wave_, int lane_) {
    const int tid = opaque_tid(), lane = tid & 63, wave = __builtin_amdgcn_readfirstlane(tid >> 6); (void)tid_; (void)wave_; (void)lane_;
    unsigned char* ws = p.ws;
    const int b = bg >> 1, g = bg & 1, fr = lane & 15, fq = lane >> 4, hg = wave >> 1, th = wave & 1, h = 4 * g + hg;
    LAS unsigned* imp = (LAS unsigned*)(lds + A_IMP); LAS unsigned* sel = (LAS unsigned*)(lds + A_SEL); LAS float* biasT = (LAS float*)(lds + A_BIAS);
    const float* t5 = p.in[11];
    for (int i = tid; i < 64 * IMPLD; i += 512) imp[i] = 0u;
    if (tid < 256) sel[tid] = 0u;
    const float b31 = t5[31 * 8 + h] * LOG2E;
    const int tl0 = 32 * th + fr;
    const size_t row0 = (size_t)b * SEQ + 64 * c;
    const bf16_t* Qu = (const bf16_t*)(ws + WS_QA) + row0 * 1024 + h * 128;     const unsigned qoff = (unsigned)(tl0 * 1024 + 8 * fq) * 2u;
    const float* Gu = (const float*)(ws + WS_GATES) + row0 * 24 + h * 3;          const unsigned goff = (unsigned)(tl0 * 24) * 4u;
    bf16_t* Ou = (bf16_t*)(ws + WS_H) + row0 * 2048 + h * 128;                    const unsigned ooffw = (unsigned)(tl0 * 2048 + 8 * (fq >> 1) + 16 * (fq & 1)) * 2u;
    __syncthreads();
    const bf16_t* KVs = (const bf16_t*)(ws + WS_KV6) + (size_t)b * SEQ * 256 + g * 128;
    const int dr0 = 16 * (wave & 3) + (lane >> 4);
    unsigned dslot[6];
    { const int sl = lane & 15, rq = lane >> 4;
#pragma unroll
      for (int i = 0; i < 4; ++i) dslot[i] = (unsigned)((sl ^ (rq + 4 * i)) << 4);
      dslot[4] = (unsigned)((sl ^ (rq << 1)) << 4); dslot[5] = (unsigned)((sl ^ ((rq + 4) << 1)) << 4); }
#define NSA_DMA_T(kb_, vb_, rp_, boff_) do { if (wave < 4) { const unsigned ro0_ = (unsigned)dr0 * (rp_); \
        LAS unsigned char* d_ = lds + (boff_) + wave * 4096; \
        __builtin_amdgcn_global_load_lds((const unsigned*)((kb_) + ro0_ + dslot[0]), (LAS unsigned*)(d_), 16, 0, 0); \
        __builtin_amdgcn_global_load_lds((const unsigned*)((kb_) + ro0_ + 4u * (rp_) + dslot[1]), (LAS unsigned*)(d_ + 1024), 16, 0, 0); \
        __builtin_amdgcn_global_load_lds((const unsigned*)((kb_) + ro0_ + 8u * (rp_) + dslot[2]), (LAS unsigned*)(d_ + 2048), 16, 0, 0); \
        __builtin_amdgcn_global_load_lds((const unsigned*)((kb_) + ro0_ + 12u * (rp_) + dslot[3]), (LAS unsigned*)(d_ + 3072), 16, 0, 0); \
        __builtin_amdgcn_global_load_lds((const unsigned*)((vb_) + ro0_ + dslot[4]), (LAS unsigned*)(d_ + A_VOFF), 16, 0, 0); \
        __builtin_amdgcn_global_load_lds((const unsigned*)((vb_) + ro0_ + 4u * (rp_) + dslot[5]), (LAS unsigned*)(d_ + A_VOFF + 1024), 16, 0, 0); \
        __builtin_amdgcn_global_load_lds((const unsigned*)((vb_) + ro0_ + 8u * (rp_) + dslot[4]), (LAS unsigned*)(d_ + A_VOFF + 2048), 16, 0, 0); \
        __builtin_amdgcn_global_load_lds((const unsigned*)((vb_) + ro0_ + 12u * (rp_) + dslot[5]), (LAS unsigned*)(d_ + A_VOFF + 3072), 16, 0, 0); } } while (0)
    const int nslc_ = c + 1;
#define NSA_TILE_J(sn) ((sn) < nslc_ ? (sn) : (c < 8 ? (sn) - nslc_ : ((sn) - nslc_ == 8 ? c - 8 : c - 7 + ((sn) - nslc_))))
#define NSA_BUF(sn) ((((sn) & 3) == 3) ? A_IMP : A_KV + ((sn) & 3) * A_KVBUF)
#define NSA_DMA(sn) do { const bool win_ = (sn) >= nslc_; const int j_ = NSA_TILE_J(sn); \
        const char* kbq_ = (const char*)(KVs + ((size_t)(win_ ? 4 : 2) * MTOK + 64 * j_) * 256); NSA_DMA_T(kbq_, kbq_ + (size_t)MTOK * 512, 512u, NSA_BUF(sn)); } while (0)
    const int vq = 4 * fq + ((lane & 15) >> 2), vp = lane & 3;
    const unsigned vrow = (unsigned)(A_VOFF + vq * 256 + (vp >> 1) * 16 + (vp & 1) * 8), vx = (unsigned)((vq & 7) << 5);

    bf16x8 qf[2][4];
#pragma unroll
    for (int qb = 0; qb < 2; ++qb)
#pragma unroll
        for (int kc = 0; kc < 4; ++kc) qf[qb][kc] = ldg_qfrag(Qu + (size_t)qb * 16 * 1024 + 32 * kc, qoff);
    {
        const int nmax = 4 * c + 2 < NCMP - 1 ? 4 * c + 2 : NCMP - 1, NCT = nmax / 64 + 1, CS = 2 * NCT;
        const char* KCb = (const char*)((const bf16_t*)(ws + WS_KC) + (size_t)(b * 2 + g) * NCMPP * 128);
        const char* VCb = (const char*)((const bf16_t*)(ws + WS_VCT) + (size_t)(b * 2 + g) * NCMPP * 128);
#define NSA_DMA_C(un) do { const int T_ = (un) < NCT ? (un) : (un) - NCT; NSA_DMA_T(KCb + (size_t)T_ * 64 * 256, VCb + (size_t)T_ * 64 * 256, 256u, A_KV + ((un) % 3) * A_KVBUF); } while (0)
        NSA_DMA_C(0); NSA_DMA_C(1);
        f32x4 oc[2][8], lacc[2];
        float m2[2] = {0.f, 0.f}, inv_l[2] = {0.f, 0.f};
        const bf16x8 ones8 = (bf16x8){0x3f80, 0x3f80, 0x3f80, 0x3f80, 0x3f80, 0x3f80, 0x3f80, 0x3f80};
#pragma unroll
        for (int qb = 0; qb < 2; ++qb) { lacc[qb] = (f32x4){0.f, 0.f, 0.f, 0.f};
#pragma unroll
            for (int dt = 0; dt < 8; ++dt) oc[qb][dt] = (f32x4){0.f, 0.f, 0.f, 0.f}; }
        unsigned koff[4];
#pragma unroll
        for (int kc = 0; kc < 4; ++kc) koff[kc] = (unsigned)(fr * 256 + (((4 * kc + fq) ^ fr) << 4));
        asm volatile("s_waitcnt vmcnt(0)" ::: "memory");
#pragma unroll 1
        for (int u = 0; u < CS; ++u) {
            const bool p1 = u >= NCT; const int T = p1 ? u - NCT : u;
            if (u > 0) { if (u + 1 < CS) asm volatile("s_waitcnt vmcnt(8)" ::: "memory"); else asm volatile("s_waitcnt vmcnt(0)" ::: "memory"); }
            __builtin_amdgcn_s_barrier(); asm volatile("" ::: "memory");
            unsigned vxl = vx, vrowl = vrow; asm volatile("" : "+v"(vxl), "+v"(vrowl));
            const unsigned kbuf = (unsigned)(A_KV + (u % 3) * A_KVBUF);
#pragma unroll
            for (int C = 0; C < 2; ++C) {
                f32x4 st[2][2];
                if (64 * c - 1024 * T - 512 * C < 655) {
#pragma unroll
                    for (int qb = 0; qb < 2; ++qb) {
                        const int relb = 64 * c + tl0 + 16 * qb - 31 - 16 * (64 * T + 32 * C + 4 * fq);
#pragma unroll
                        for (int t = 0; t < 2; ++t)
#pragma unroll
                            for (int r = 0; r < 4; ++r) { int rel = relb - 256 * t - 16 * r; rel = rel > 191 ? 191 : (rel < -64 ? -64 : rel);
                                st[t][qb][r] = biasT[hg * 256 + 191 - rel] - m2[qb]; }
                    }
                } else {
                    const float bl0 = b31 - m2[0], bl1 = b31 - m2[1];
#pragma unroll
                    for (int t = 0; t < 2; ++t) { st[t][0] = (f32x4){bl0, bl0, bl0, bl0}; st[t][1] = (f32x4){bl1, bl1, bl1, bl1}; }
                }
                {
                    bf16x8 kf[2][4];
#pragma unroll
                    for (int t = 0; t < 2; ++t)
#pragma unroll
                        for (int kc = 0; kc < 4; ++kc) kf[t][kc] = lds_frag(lds, kbuf + koff[kc] + (2 * C + t) * 4096);
                    asm volatile("" : "+v"(kf[0][0]), "+v"(kf[0][1]), "+v"(kf[0][2]), "+v"(kf[0][3]), "+v"(kf[1][0]), "+v"(kf[1][1]), "+v"(kf[1][2]), "+v"(kf[1][3]));
#pragma unroll
                    for (int t = 0; t < 2; ++t)
#pragma unroll
                        for (int kc = 0; kc < 4; ++kc) { st[t][0] = mfma16(kf[t][kc], qf[0][kc], st[t][0]); st[t][1] = mfma16(kf[t][kc], qf[1][kc], st[t][1]); }
                }
                bf16x8 pb[2];
                if (!p1) {
                    int imx = __float_as_int(st[0][0][0]);
#pragma unroll
                    for (int qb = 0; qb < 2; ++qb)
#pragma unroll
                        for (int t = 0; t < 2; ++t)
#pragma unroll
                            for (int r = 0; r < 4; ++r) imx = max(imx, __float_as_int(st[t][qb][r]));
                    const bool first = u == 0 && C == 0;
                    if (first || __any(imx > __float_as_int(RESCALE_THR))) {
#pragma unroll
                        for (int qb = 0; qb < 2; ++qb) {
                            float mx = fmaxf(fmaxf(fmaxf(st[0][qb][0], st[0][qb][1]), fmaxf(st[0][qb][2], st[0][qb][3])), fmaxf(fmaxf(st[1][qb][0], st[1][qb][1]), fmaxf(st[1][qb][2], st[1][qb][3])));
                            mx = fmaxf(mx, __shfl_xor(mx, 16)); mx = fmaxf(mx, __shfl_xor(mx, 32));
                            const float d = first ? mx : fmaxf(mx, 0.f), al = first ? 1.0f : ex2(-d);
                            m2[qb] += d; lacc[qb] = lacc[qb] * al;
#pragma unroll
                            for (int t = 0; t < 2; ++t)
#pragma unroll
                                for (int r = 0; r < 4; ++r) st[t][qb][r] -= d;
                        }
                    }
#pragma unroll
                    for (int qb = 0; qb < 2; ++qb) {
#pragma unroll
                        for (int t = 0; t < 2; ++t)
#pragma unroll
                            for (int r = 0; r < 4; ++r) st[t][qb][r] = ex2(st[t][qb][r]);
                        pb[qb] = pack8(st[0][qb], st[1][qb]);
                    }
                    lacc[0] = mfma16(ones8, pb[0], lacc[0]); lacc[1] = mfma16(ones8, pb[1], lacc[1]);
                } else {
                    v2i vlo[8], vhi[8];
#pragma unroll
                    for (int dt = 0; dt < 8; ++dt) { const unsigned va = (unsigned)(size_t)lds + kbuf + vrowl + (((unsigned)(dt << 5)) ^ vxl);
                        if (C == 0) { TR_READ_ASM(vlo[dt], va, 0); TR_READ_ASM(vhi[dt], va, 4096); } else { TR_READ_ASM(vlo[dt], va, 8192); TR_READ_ASM(vhi[dt], va, 12288); } }
#pragma unroll
                    for (int qb = 0; qb < 2; ++qb) {
#pragma unroll
                        for (int t = 0; t < 2; ++t)
#pragma unroll
                            for (int r = 0; r < 4; ++r) st[t][qb][r] = ex2(st[t][qb][r]) * inv_l[qb];
                        LAS unsigned* ip = imp + (tl0 + 16 * qb) * IMPLD + 16 * T + 8 * C + fq;
#pragma unroll
                        for (int t = 0; t < 2; ++t) {
                            lds_addfix(ip + 4 * t, (st[t][qb][0] + st[t][qb][1]) + (st[t][qb][2] + st[t][qb][3]));
                            if (16 * T + 8 * C + 4 * t + fq + 1 < 128) lds_addfix(ip + 4 * t + 1, st[t][qb][3]);
                        }
                        pb[qb] = pack8(st[0][qb], st[1][qb]);
                    }
                    asm volatile("s_waitcnt lgkmcnt(0)" : "+v"(vlo[0]), "+v"(vlo[1]), "+v"(vlo[2]), "+v"(vlo[3]), "+v"(vlo[4]), "+v"(vlo[5]), "+v"(vlo[6]), "+v"(vlo[7]),
                                 "+v"(vhi[0]), "+v"(vhi[1]), "+v"(vhi[2]), "+v"(vhi[3]), "+v"(vhi[4]), "+v"(vhi[5]), "+v"(vhi[6]), "+v"(vhi[7]) :: "memory");
                    __builtin_amdgcn_sched_barrier(0);
#pragma unroll
                    for (int dt = 0; dt < 8; ++dt) { const bf16x8 vfr = __builtin_bit_cast(bf16x8, (u32x4){(unsigned)vlo[dt][0], (unsigned)vlo[dt][1], (unsigned)vhi[dt][0], (unsigned)vhi[dt][1]});
                        oc[0][dt] = mfma16(vfr, pb[0], oc[0][dt]); oc[1][dt] = mfma16(vfr, pb[1], oc[1][dt]); }
                }
            }
            if (u + 2 < CS) NSA_DMA_C(u + 2);
            if (u == NCT - 1) {
#pragma unroll
                for (int qb = 0; qb < 2; ++qb) inv_l[qb] = (64 * c + tl0 + 16 * qb >= 31) ? 1.0f / lacc[qb][0] : 0.f;
            }
        }
#undef NSA_DMA_C
#pragma unroll
        for (int qb = 0; qb < 2; ++qb) {
            const float gzr = *(const float*)((const char*)(Gu + qb * 16 * 24 + 0) + goff), gz = 1.0f / (1.0f + __expf(-gzr));
#pragma unroll
            for (int P = 0; P < 4; ++P) {
                unsigned ax = cvt_pk_bf16(oc[qb][2 * P][0] * gz, oc[qb][2 * P][1] * gz), ay = cvt_pk_bf16(oc[qb][2 * P][2] * gz, oc[qb][2 * P][3] * gz);
                unsigned bx = cvt_pk_bf16(oc[qb][2 * P + 1][0] * gz, oc[qb][2 * P + 1][1] * gz), by = cvt_pk_bf16(oc[qb][2 * P + 1][2] * gz, oc[qb][2 * P + 1][3] * gz);
                swap16(ax, bx); swap16(ay, by);
                *(u32x4*)((char*)(Ou + (size_t)qb * 16 * 2048 + 32 * P) + ooffw) = (u32x4){ax, ay, bx, by}; }
        }
    }
    __syncthreads();
    NSA_DMA(0); NSA_DMA(1);
    {
        const int tk = tid >> 3, k = tid & 7;
        unsigned bits = 0u;
        if (c < 16) {
#pragma unroll
            for (int jj = 0; jj < 16; ++jj) bits |= (16 * k + jj <= c ? 1u : 0u) << jj;
        } else {
            unsigned v[16];
#pragma unroll
            for (int jj = 0; jj < 16; ++jj) { const int j = 16 * k + jj; v[jj] = (j >= 1 && j <= c - 2) ? imp[tk * IMPLD + j] : 0u; }
            unsigned T = 0u;
#pragma unroll 1
            for (int bit = 30; bit >= 0; --bit) {
                const unsigned trial = T | (1u << bit);
                int cnt = 0;
#pragma unroll
                for (int jj = 0; jj < 16; ++jj) cnt += v[jj] >= trial ? 1 : 0;
                cnt = sum8_dpp(cnt);
                if (cnt >= 13) T = trial;
            }
            int ngt = 0, neq = 0;
#pragma unroll
            for (int jj = 0; jj < 16; ++jj) { const int j = 16 * k + jj; const bool cand = j >= 1 && j <= c - 2; ngt += (cand && v[jj] > T) ? 1 : 0; neq += (cand && v[jj] == T) ? 1 : 0; }
            const int tgt = sum8_dpp(ngt);
            int pre = 0;
#pragma unroll
            for (int kk = 0; kk < 8; ++kk) { const int o = __shfl(neq, (lane & ~7) | kk); pre += kk < k ? o : 0; }
            int room = 13 - tgt - pre;
#pragma unroll
            for (int jj = 0; jj < 16; ++jj) { const int j = 16 * k + jj; const bool cand = j >= 1 && j <= c - 2;
                bool s1 = (j == 0) || (j == c) || (j == c - 1) || (cand && v[jj] > T);
                if (cand && v[jj] == T) { if (room > 0) s1 = true; --room; }
                bits |= (s1 ? 1u : 0u) << jj; }
        }
        atomicOr((unsigned*)(sel + tk * 4 + (k >> 1)), bits << (16 * (k & 1)));
    }
    __syncthreads();
    {
        const int nslc = c + 1, nwin = (c < 8 ? c : 8) + 1, nsteps = nslc + nwin;
        f32x4 oacc[2][8], lacc[2];
        float m2[2];
        const bf16x8 ones8 = (bf16x8){0x3f80, 0x3f80, 0x3f80, 0x3f80, 0x3f80, 0x3f80, 0x3f80, 0x3f80};
#pragma unroll
        for (int qb = 0; qb < 2; ++qb) { m2[qb] = 0.f; lacc[qb] = (f32x4){0.f, 0.f, 0.f, 0.f};
#pragma unroll
            for (int dt = 0; dt < 8; ++dt) oacc[qb][dt] = (f32x4){0.f, 0.f, 0.f, 0.f}; }
        unsigned koff[4];
#pragma unroll
        for (int kc = 0; kc < 4; ++kc) koff[kc] = (unsigned)(fr * 256 + (((4 * kc + fq) ^ fr) << 4));
        asm volatile("s_waitcnt vmcnt(0)" ::: "memory");
#pragma unroll 1
        for (int s = 0; s < nsteps; ++s) {
            const bool win = s >= nslc; const int j = NSA_TILE_J(s), dlt = c - j;
            if ((s & 1) == 0) {
                asm volatile("s_waitcnt vmcnt(0)" ::: "memory");
                __builtin_amdgcn_s_barrier(); asm volatile("" ::: "memory");
            }
            const unsigned kbuf = (unsigned)NSA_BUF(s);
            bf16x8 kf[2][4];
#pragma unroll
            for (int t = 0; t < 2; ++t)
#pragma unroll
                for (int kc = 0; kc < 4; ++kc) kf[t][kc] = lds_frag(lds, kbuf + koff[kc] + t * 4096);
            unsigned selw[2] = {0xffffffffu, 0xffffffffu};
            if (!win) { selw[0] = sel[tl0 * 4 + (j >> 5)]; selw[1] = sel[(tl0 + 16) * 4 + (j >> 5)]; }
            const bool on0 = ((selw[0] >> (j & 31)) & 1u) != 0u, on1 = ((selw[1] >> (j & 31)) & 1u) != 0u;
#pragma unroll
            for (int C = 0; C < 2; ++C) {
                if (C == 1) {
#pragma unroll
                    for (int t = 0; t < 2; ++t)
#pragma unroll
                        for (int kc = 0; kc < 4; ++kc) kf[t][kc] = lds_frag(lds, kbuf + koff[kc] + (2 + t) * 4096);
                }
                f32x4 st[2][2];
                if (dlt <= 2) {
#pragma unroll
                    for (int qb = 0; qb < 2; ++qb) {
                        const int tlq = tl0 + 16 * qb; const bool on = qb ? on1 : on0;
                        const LAS float* bt = biasT + hg * 256 + (191 - 64 * dlt - tlq + 4 * fq) + 32 * C;
#pragma unroll
                        for (int t = 0; t < 2; ++t)
#pragma unroll
                            for (int r = 0; r < 4; ++r) { const float tv = bt[16 * t + r] - m2[qb]; st[t][qb][r] = on ? tv : -1e30f; }
                    }
                } else {
                    const float bl0 = on0 ? b31 - m2[0] : -1e30f, bl1 = on1 ? b31 - m2[1] : -1e30f;
#pragma unroll
                    for (int t = 0; t < 2; ++t) { st[t][0] = (f32x4){bl0, bl0, bl0, bl0}; st[t][1] = (f32x4){bl1, bl1, bl1, bl1}; }
                    if (win && dlt == 8) {
#pragma unroll
                        for (int qb = 0; qb < 2; ++qb)
#pragma unroll
                            for (int t = 0; t < 2; ++t)
#pragma unroll
                                for (int r = 0; r < 4; ++r) st[t][qb][r] = (32 * C + 16 * t + 4 * fq + r > tl0 + 16 * qb) ? st[t][qb][r] : -1e30f;
                    }
                }
#pragma unroll
                for (int t = 0; t < 2; ++t)
#pragma unroll
                    for (int kc = 0; kc < 4; ++kc) { st[t][0] = mfma16(kf[t][kc], qf[0][kc], st[t][0]); st[t][1] = mfma16(kf[t][kc], qf[1][kc], st[t][1]); }
                v2i vlo[8], vhi[8];
#pragma unroll
                for (int dt = 0; dt < 8; ++dt) { const unsigned va = (unsigned)(size_t)lds + kbuf + vrow + (((unsigned)(dt << 5)) ^ vx);
                    if (C == 0) { TR_READ_ASM(vlo[dt], va, 0); TR_READ_ASM(vhi[dt], va, 4096); } else { TR_READ_ASM(vlo[dt], va, 8192); TR_READ_ASM(vhi[dt], va, 12288); } }
                int imx = __float_as_int(st[0][0][0]);
#pragma unroll
                for (int qb = 0; qb < 2; ++qb)
#pragma unroll
                    for (int t = 0; t < 2; ++t)
#pragma unroll
                        for (int r = 0; r < 4; ++r) imx = max(imx, __float_as_int(st[t][qb][r]));
                const bool first = (s == 0 || s == nslc) && C == 0;
                if (first || __any(imx > __float_as_int(RESCALE_THR))) {
#pragma unroll
                    for (int qb = 0; qb < 2; ++qb) {
                        float mx = fmaxf(fmaxf(fmaxf(st[0][qb][0], st[0][qb][1]), fmaxf(st[0][qb][2], st[0][qb][3])), fmaxf(fmaxf(st[1][qb][0], st[1][qb][1]), fmaxf(st[1][qb][2], st[1][qb][3])));
                        mx = fmaxf(mx, __shfl_xor(mx, 16)); mx = fmaxf(mx, __shfl_xor(mx, 32));
                        const float d = first ? mx : fmaxf(mx, 0.f), al = first ? 1.0f : ex2(-d);
                        m2[qb] += d; lacc[qb] = lacc[qb] * al;
#pragma unroll
                        for (int dt = 0; dt < 8; ++dt) oacc[qb][dt] = oacc[qb][dt] * al;
#pragma unroll
                        for (int t = 0; t < 2; ++t)
#pragma unroll
                            for (int r = 0; r < 4; ++r) st[t][qb][r] -= d;
                    }
                }
                bf16x8 pb[2];
#pragma unroll
                for (int qb = 0; qb < 2; ++qb) {
#pragma unroll
                    for (int t = 0; t < 2; ++t)
#pragma unroll
                        for (int r = 0; r < 4; ++r) st[t][qb][r] = ex2(st[t][qb][r]);
                    pb[qb] = pack8(st[0][qb], st[1][qb]);
                }
                asm volatile("s_waitcnt lgkmcnt(0)" : "+v"(vlo[0]), "+v"(vlo[1]), "+v"(vlo[2]), "+v"(vlo[3]), "+v"(vlo[4]), "+v"(vlo[5]), "+v"(vlo[6]), "+v"(vlo[7]),
                             "+v"(vhi[0]), "+v"(vhi[1]), "+v"(vhi[2]), "+v"(vhi[3]), "+v"(vhi[4]), "+v"(vhi[5]), "+v"(vhi[6]), "+v"(vhi[7]) :: "memory");
                __builtin_amdgcn_sched_barrier(0);
#pragma unroll
                for (int dt = 0; dt < 8; ++dt) { const bf16x8 vfr = __builtin_bit_cast(bf16x8, (u32x4){(unsigned)vlo[dt][0], (unsigned)vlo[dt][1], (unsigned)vhi[dt][0], (unsigned)vhi[dt][1]});
                    oacc[0][dt] = mfma16(vfr, pb[0], oacc[0][dt]); oacc[1][dt] = mfma16(vfr, pb[1], oacc[1][dt]); }
                lacc[0] = mfma16(ones8, pb[0], lacc[0]); lacc[1] = mfma16(ones8, pb[1], lacc[1]);
            }
            if (s == nslc - 1 || s == nsteps - 1) {
                u32x4 old[2][4];
#pragma unroll
                for (int qb = 0; qb < 2; ++qb)
#pragma unroll
                    for (int P = 0; P < 4; ++P) old[qb][P] = *(const u32x4*)((const char*)(Ou + (size_t)qb * 16 * 2048 + 32 * P) + ooffw);
                const float g0r = *(const float*)((const char*)(Gu + (win ? 2 : 1)) + goff), g1r = *(const float*)((const char*)(Gu + 16 * 24 + (win ? 2 : 1)) + goff);
                const float g0 = 1.0f / (1.0f + __expf(-g0r)), g1 = 1.0f / (1.0f + __expf(-g1r));
#pragma unroll
                for (int qb = 0; qb < 2; ++qb)
#pragma unroll
                    for (int P = 0; P < 4; ++P)
#pragma unroll
                        for (int r = 0; r < 4; ++r) { float a_ = oacc[qb][2 * P][r], b_ = oacc[qb][2 * P + 1][r]; swap16f(a_, b_); oacc[qb][2 * P][r] = a_; oacc[qb][2 * P + 1][r] = b_; }
                asm volatile("s_waitcnt vmcnt(0)" ::: "memory");
#pragma unroll
                for (int qb = 0; qb < 2; ++qb) {
                    const float gz = (qb ? g1 : g0) / lacc[qb][0];
                    char* Op = (char*)(Ou + (size_t)qb * 16 * 2048) + ooffw;
#pragma unroll
                    for (int P = 0; P < 4; ++P) {
                        const u32x4 o4 = old[qb][P]; const f32x4 a = oacc[qb][2 * P], b = oacc[qb][2 * P + 1];
                        u32x4 w; w.x = cvt_pk_bf16(bf2f(o4.x & 0xffffu) + a[0] * gz, bf2f(o4.x >> 16) + a[1] * gz); w.y = cvt_pk_bf16(bf2f(o4.y & 0xffffu) + a[2] * gz, bf2f(o4.y >> 16) + a[3] * gz);
                        w.z = cvt_pk_bf16(bf2f(o4.z & 0xffffu) + b[0] * gz, bf2f(o4.z >> 16) + b[1] * gz); w.w = cvt_pk_bf16(bf2f(o4.w & 0xffffu) + b[2] * gz, bf2f(o4.w >> 16) + b[3] * gz);
                        *(u32x4*)(Op + 64 * P) = w;
                        oacc[qb][2 * P] = (f32x4){0.f, 0.f, 0.f, 0.f}; oacc[qb][2 * P + 1] = (f32x4){0.f, 0.f, 0.f, 0.f};
                    }
                    m2[qb] = 0.f; lacc[qb] = (f32x4){0.f, 0.f, 0.f, 0.f};
                }
            }
            if ((s & 1) == 0) { if (s + 2 < nsteps) NSA_DMA(s + 2); if (s + 3 < nsteps) NSA_DMA(s + 3); }
        }
        __syncthreads();
    }
#undef NSA_DMA
#undef NSA_BUF
#undef NSA_TILE_J
}

#define XB_TMO      128
#define XB_XCNT(j)  (256  + 64 * (j))
#define XB_XSUB(j)  (1280 + 64 * (j))
#define XB_XGEN(j)  (2304 + 64 * (j))
#define XB_TOP      3328
#define XB_TOPGEN   3392
#define XCD_BAR_WORDS 3456
#define XB_SPIN_CAP (1u << 18)

__device__ __forceinline__ unsigned xb_ld(unsigned* p)              { return __hip_atomic_load(p, __ATOMIC_RELAXED, __HIP_MEMORY_SCOPE_AGENT); }
__device__ __forceinline__ unsigned xb_add(unsigned* p, unsigned v) { return __hip_atomic_fetch_add(p, v, __ATOMIC_RELAXED, __HIP_MEMORY_SCOPE_AGENT); }
__device__ __forceinline__ unsigned xb_xcc_id() { return (unsigned)__builtin_amdgcn_s_getreg((3 << 11) | 20) & 0xFu; }
#define XB_SPIN(cond, bar) do { unsigned _sp = 0; while (cond) { __builtin_amdgcn_s_sleep(1); \
    if ((++_sp & 255u) == 0u) { if (xb_ld(&(bar)[XB_TMO])) break; if (_sp > XB_SPIN_CAP) { atomicAdd(&(bar)[XB_TMO], 1u); break; } } } } while (0)

struct XcdBarrier {
    unsigned* bar; unsigned x;
    volatile LAS unsigned* st;
};

__device__ __forceinline__ XcdBarrier xcd_barrier_post(unsigned* bar, volatile LAS unsigned* st) {
    XcdBarrier b; b.bar = bar; b.x = xb_xcc_id(); b.st = st;
    if (threadIdx.x == 0) (void)xb_add(&bar[XB_XCNT(b.x)], 1u);
    return b;
}
__device__ __forceinline__ void xcd_barrier_complete(unsigned* bar, unsigned x, unsigned& nloc, unsigned& nx) {
    const unsigned G = gridDim.x * gridDim.y * gridDim.z;
    unsigned sum, cnt, mine, sp = 0u;
    for (;;) {
        sum = 0u; cnt = 0u; mine = 0u;
#pragma unroll
        for (unsigned j = 0; j < 16; ++j) { const unsigned c = xb_ld(&bar[XB_XCNT(j)]); sum += c; cnt += (c > 0u) ? 1u : 0u; mine = (j == x) ? c : mine; }
        if (sum == G) break;
        __builtin_amdgcn_s_sleep(1);
        if ((++sp & 255u) == 0u) { if (xb_ld(&bar[XB_TMO])) break; if (sp > XB_SPIN_CAP) { atomicAdd(&bar[XB_TMO], 1u); break; } }
    }
    nloc = mine > 0u ? mine : 1u; nx = cnt > 0u ? cnt : 1u;
}

__device__ __forceinline__ void xcd_barrier(const XcdBarrier& b) {
    asm volatile("s_waitcnt vmcnt(0)" ::: "memory");
    __syncthreads();
    if (threadIdx.x == 0) {
        unsigned* bar = b.bar;
        __builtin_amdgcn_s_waitcnt(0);
        unsigned nloc = b.st[0], nx = b.st[1];
        if (nloc == 0u) { xcd_barrier_complete(bar, b.x, nloc, nx); b.st[0] = nloc; b.st[1] = nx; }
        const unsigned old = xb_add(&bar[XB_XSUB(b.x)], 1u);
        const unsigned gen = old / nloc;
        if (old + 1u == (gen + 1u) * nloc) {
            __builtin_amdgcn_fence(__ATOMIC_RELEASE, "agent");
            asm volatile("s_waitcnt vmcnt(0)" ::: "memory");
            const unsigned og = xb_add(&bar[XB_TOP], 1u);
            const unsigned tg = og / nx;
            if (og + 1u == (tg + 1u) * nx) xb_add(&bar[XB_TOPGEN], 1u);
            else XB_SPIN(xb_ld(&bar[XB_TOPGEN]) == tg, bar);
            __builtin_amdgcn_fence(__ATOMIC_ACQUIRE, "agent");
            xb_add(&bar[XB_XGEN(b.x)], 1u);
            asm volatile("s_waitcnt vmcnt(0)" ::: "memory");
        } else {
            XB_SPIN(xb_ld(&bar[XB_XGEN(b.x)]) == gen, bar);
            __builtin_amdgcn_fence(__ATOMIC_ACQUIRE, "agent");
            asm volatile("s_waitcnt vmcnt(0)" ::: "memory");
        }
    }
    __syncthreads();
}

__global__ void __launch_bounds__(512, 2) mega(Params p) {
    extern __shared__ __attribute__((aligned(16))) unsigned char lds_raw[];
    LAS unsigned char* lds = (LAS unsigned char*)lds_raw;
    cg::grid_group grid = cg::this_grid();
    const int tid = threadIdx.x, lane = tid & 63, wave = __builtin_amdgcn_readfirstlane(tid >> 6);
    const int G = gridDim.x, gw = blockIdx.x * 8 + wave, NGW = G * 8;
    unsigned char* ws = p.ws;
    const int lo = p.ph_lo, hi = p.ph_hi;
    volatile LAS unsigned* bst = (volatile LAS unsigned*)(lds + LDS_BYTES - 64);
    if (tid < 2) bst[tid] = 0u;
    __syncthreads();
    const XcdBarrier xbar = xcd_barrier_post((unsigned*)(ws + WS_BAR), bst);
#define IN(k) (lo <= (k) && (k) < hi)
#define SEAM(k) do { if (IN(k) && IN((k) + 1)) { if (hi > 1000) grid.sync(); else xcd_barrier(xbar); } } while (0)
    if (IN(0)) { p0_prologue(p, lds, wave, lane, gw, NGW); }
    SEAM(0);
    if (IN(1)) {
        pg8::Gemm g{(const bf16_t*)((const unsigned char*)p.out + XB_OFF), (const bf16_t*)(ws + WS_WINT), MTOK, NIN, DM}; pg8::StaticOrder S; S.init(MTOK, NIN, G, (int)blockIdx.x, WGM_IN);
        EpiInProj E{(bf16_t*)(ws + WS_QA), (bf16_t*)(ws + WS_KV6), (bf16_t*)(ws + WS_QR), (bf16_t*)(ws + WS_KR), (bf16_t*)(ws + WS_VR), (bf16_t*)(ws + WS_GR), (float*)(ws + WS_GATES), (const float2*)(ws + WS_ROPE), p.lg[0], p.lg[1], p.lg[2], p.lg[3]};
        pg8::gemm_phase<EpiInProj, pg8::StaticOrder, GEMM_ALIGN, GEMM_SP2>(lds, g, S, E);
        { const int U = (MTOK / 256) * (NIN / 256), rounds = (U + G - 1) / G, nfull = U - (rounds - 1) * G, nidle = G - nfull;
          __syncthreads();
          if (nidle == 0) p1_tail_weights(p, lds, gw, NGW);
          else if ((int)blockIdx.x >= nfull) p1_tail_weights(p, lds, ((int)blockIdx.x - nfull) * 8 + wave, nidle * 8); }
    }
    SEAM(1);
    if (IN(2)) {
        const bool split = G == 256, typeA = ((blockIdx.x >> 3) & 1) == 0; const int idx = (int)(((blockIdx.x >> 4) << 3) | (blockIdx.x & 7));
        const int c0 = split ? idx : (int)blockIdx.x, c1 = split ? (typeA ? idx + 1 : 0) : 128, cs = split ? 1 : G;
        for (int it = c0; it < c1; it += cs) mf_compress(p, it, lds, tid, wave, lane);
        mf_ret_u_items(p, split ? (typeA ? idx : 128 + idx) : (int)blockIdx.x, split ? (typeA ? 512 : 128) : G, lds);
    }
    SEAM(2);
    if (IN(3)) { mf_ret_scan(p, blockIdx.x * 512 + opaque_tid(), G * 512); }
    SEAM(3);
    if (IN(4)) {
        for (int it = blockIdx.x; it < 256; it += G) { const int bgi = it & 3, pr = it >> 2;
            __syncthreads();
            for (int i = tid; i < 4 * 256; i += 512) { const int hh = i >> 8, rel = 191 - (i & 255);
                ((LAS float*)(lds + A_BIAS))[i] = rel >= 0 ? p.in[11][t5_bucket(rel) * 8 + 4 * (bgi & 1) + hh] * LOG2E : -1e30f; }
            mf_nsa(p, bgi, 127 - pr, lds, tid, wave, lane); mf_nsa(p, bgi, pr, lds, tid, wave, lane); }
        for (int it = blockIdx.x; it < 512; it += G) mf_ret_out(p, it, lds, tid, wave, lane);
    }
    SEAM(4);
    if (IN(5)) {
        pg8::Gemm g{(const bf16_t*)(ws + WS_H), (const bf16_t*)(ws + WS_WOUTT), MTOK, DM, DM}; pg8::StaticOrder S; S.init(MTOK, DM, G, (int)blockIdx.x, WGM_OUT);
        EpiBf16Plain E{(bf16_t*)(ws + WS_MIX), DM};
        pg8::gemm_phase<EpiBf16Plain, pg8::StaticOrder, GEMM_ALIGN, GEMM_SP2>(lds, g, S, E);
    }
    SEAM(5);
    if (IN(6)) { p6_resnorm(p, lds, NGW); }
    SEAM(6);
    if (IN(7)) {
        pg8::Gemm g{(const bf16_t*)(ws + WS_X1), (const bf16_t*)(ws + WS_WUPT), MTOK, DFF, DM}; pg8::StaticOrder S; S.init(MTOK, DFF, G, (int)blockIdx.x, WGM_UP);
        EpiRelu2 E{(bf16_t*)(ws + WS_UM), DFF};
        pg8::gemm_phase<EpiRelu2, pg8::StaticOrder, GEMM_ALIGN, GEMM_SP2>(lds, g, S, E);
    }
    SEAM(7);
    if (IN(8)) {
        pg8::Gemm g{(const bf16_t*)(ws + WS_UM), (const bf16_t*)(ws + WS_WDNT), MTOK, DM, DFF}; RevOrder S; S.init(MTOK, DM, G, (int)blockIdx.x, WGM_DN);
        EpiBf16Plain E{(bf16_t*)(ws + WS_Y), DM};
        pg8::gemm_phase<EpiBf16Plain, RevOrder, GEMM_ALIGN, GEMM_SP2>(lds, g, S, E);
    }
    SEAM(8);
    if (IN(9)) { p9_final(p, lds, NGW); }
#undef IN
#undef SEAM
}
}

extern "C" void kernel_launch(void* const* d_in, const int* in_sizes, int n_in, void* d_out, int out_size, void* d_ws, size_t ws_size, hipStream_t stream) {
    using namespace mk;
    static int grid = 0;
    if (n_in != 18 || out_size != MTOK * DM || ws_size < WS_NEED) { fprintf(stderr, "kernel_launch: unexpected shapes (n_in %d out %d ws %zu)\n", n_in, out_size, ws_size); return; }
    if (!grid) {
        int dev = 0, cus = 0, per_cu = 0;
        hipGetDevice(&dev); hipDeviceGetAttribute(&cus, hipDeviceAttributeMultiprocessorCount, dev);
        hipFuncSetAttribute((const void*)mega, hipFuncAttributeMaxDynamicSharedMemorySize, LDS_BYTES);
        hipOccupancyMaxActiveBlocksPerMultiprocessor(&per_cu, (const void*)mega, 512, LDS_BYTES);
        if (per_cu < 1) { fprintf(stderr, "kernel_launch: occupancy query says %d blocks per CU\n", per_cu); per_cu = 1; }
        grid = cus * per_cu;
        fprintf(stderr, "kernel_launch: grid %d (%d CUs x %d)\n", grid, cus, per_cu);
    }
    Params p{};
    for (int i = 0; i < 18; ++i) p.in[i] = (const float*)d_in[i];
    p.out = (float*)d_out; p.ws = (unsigned char*)d_ws;
    for (int h = 0; h < 4; ++h) p.lg[h] = (float)std::log(1.0 - std::exp2(-5.0 - (double)h));
    for (int i = 0; i < 128; ++i) p.invf[i] = (double)std::pow(10000.0f, -(float)(2 * i) / 256.0f);
    auto launch = [&](int lo, int hi) {
        Params q = p; q.ph_lo = lo; q.ph_hi = hi; void* args[] = {&q};
        hipError_t e = hipLaunchCooperativeKernel((const void*)mega, dim3(grid), dim3(512), args, LDS_BYTES, stream);
        if (e != hipSuccess) fprintf(stderr, "cooperative launch [%d,%d) failed: %s (grid %d)\n", lo, hi, hipGetErrorString(e), grid);
    };
    if (hipMemsetAsync(d_ws, 0, 65536, stream) != hipSuccess) fprintf(stderr, "kernel_launch: memset of the control words failed\n");
    launch(0, 10);
}
```
